# Optimizing an MI355X kernel written in HIP

```python
import jax, jax.numpy as jnp
from jax import lax
import numpy as np


D_MODEL = 1024
BATCH = 4
SEQ = 8192
DEPTH = 1

CHUNK = 64
N_META = 16
CONV_CH = D_MODEL
CONV_WIDTH = 31
FOX_HEADS = 16
FOX_HEAD_DIM = 64
FOX_WIDTH = FOX_HEADS * FOX_HEAD_DIM
Q_BLOCK = 128
N_EXPERTS = 32
TOP_K = 4
D_EXPERT = D_MODEL
SWIGLU_ALPHA = 1.702
SWIGLU_LIMIT = 7.0
MOE_BLOCK = 256
RMS_EPS = 1e-5
LN_EPS = 1e-5
FORGET_BIAS_INIT = 3.0

OFF_GLU = 0
OFF_Q = OFF_GLU + 2 * CONV_CH
OFF_K = OFF_Q + FOX_WIDTH
OFF_V = OFF_K + FOX_WIDTH
OFF_F = OFF_V + FOX_WIDTH
OFF_GA = OFF_F + FOX_HEADS
OFF_GB = OFF_GA + D_MODEL
IN_COLS = OFF_GB + D_MODEL

kernel_name = 'hybrid_conv_fox_moe_streaming_block'


def rms_norm(x, g):
    xf = x.astype(jnp.float32)
    y = xf * lax.rsqrt(jnp.mean(xf * xf, axis=-1, keepdims=True) + RMS_EPS)
    return (y * g.astype(jnp.float32)).astype(x.dtype)


def layer_norm(x, g, b):
    xf = x.astype(jnp.float32)
    mu = jnp.mean(xf, axis=-1, keepdims=True)
    xc = xf - mu
    y = xc * lax.rsqrt(jnp.mean(xc * xc, axis=-1, keepdims=True) + LN_EPS)
    return (y * g.astype(jnp.float32) + b.astype(jnp.float32)).astype(x.dtype)


def fox_attention(q, k, v, log_f):
    b, l, h, dh = q.shape
    lp = -(-l // Q_BLOCK) * Q_BLOCK
    pad = ((0, 0), (0, lp - l), (0, 0), (0, 0))
    q = jnp.pad(q, pad)
    k = jnp.pad(k, pad)
    v = jnp.pad(v, pad)
    cum = jnp.cumsum(jnp.pad(log_f, ((0, 0), (0, lp - l), (0, 0))), axis=1).transpose(0, 2, 1)
    kpos = jnp.arange(lp)
    scale = FOX_HEAD_DIM ** -0.5

    def block(i):
        q0 = i * Q_BLOCK
        qb = lax.dynamic_slice_in_dim(q, q0, Q_BLOCK, axis=1)
        cq = lax.dynamic_slice_in_dim(cum, q0, Q_BLOCK, axis=2)
        s = jnp.einsum('bqhd,bkhd->bhqk', qb, k, preferred_element_type=jnp.float32) * scale
        s = s + cq[..., :, None] - cum[..., None, :]
        qpos = q0 + jnp.arange(Q_BLOCK)
        s = jnp.where(kpos[None, :] <= qpos[:, None], s, -jnp.inf)
        p = jax.nn.softmax(s, axis=-1).astype(v.dtype)
        return jnp.einsum('bhqk,bkhd->bqhd', p, v)

    out = lax.map(block, jnp.arange(lp // Q_BLOCK))
    out = out.transpose(1, 0, 2, 3, 4).reshape(b, lp, h, dh)
    return out[:, :l]


def hybrid_mixer(xn, w_in, b_in, conv_w, conv_b, ln_g, ln_b, w_conv_out, w_attn_out, w_mix_out):
    b, l, _ = xn.shape
    proj = xn @ w_in + b_in
    glu = proj[..., OFF_GLU:OFF_GLU + CONV_CH] * jax.nn.sigmoid(proj[..., OFF_GLU + CONV_CH:OFF_Q])
    u = lax.conv_general_dilated(glu, conv_w[:, None, :], window_strides=(1,),
                                 padding=[(CONV_WIDTH - 1, 0)],
                                 dimension_numbers=('NWC', 'WIO', 'NWC'),
                                 feature_group_count=CONV_CH) + conv_b
    u = jax.nn.silu(layer_norm(u, ln_g, ln_b))
    branch_a = u @ w_conv_out
    q = proj[..., OFF_Q:OFF_K].reshape(b, l, FOX_HEADS, FOX_HEAD_DIM)
    k = proj[..., OFF_K:OFF_V].reshape(b, l, FOX_HEADS, FOX_HEAD_DIM)
    v = proj[..., OFF_V:OFF_F].reshape(b, l, FOX_HEADS, FOX_HEAD_DIM)
    log_f = jax.nn.log_sigmoid(proj[..., OFF_F:OFF_GA].astype(jnp.float32))
    attn = fox_attention(q, k, v, log_f).reshape(b, l, FOX_WIDTH)
    branch_b = attn @ w_attn_out
    merged = (jax.nn.sigmoid(proj[..., OFF_GA:OFF_GB]) * branch_a
              + jax.nn.sigmoid(proj[..., OFF_GB:IN_COLS]) * branch_b)
    return merged @ w_mix_out


def moe_ffn(h, router_w, router_b, w_gu, b_gu, w_down, b_down):
    n, d = h.shape
    logits = jnp.dot(h, router_w, preferred_element_type=jnp.float32) + router_b.astype(jnp.float32)
    top_val, top_idx = lax.top_k(logits, TOP_K)
    gate = jax.nn.softmax(top_val, axis=-1).reshape(-1)
    n_assign = n * TOP_K
    flat_e = top_idx.reshape(-1)
    order = jnp.argsort(flat_e)
    sorted_e = flat_e[order]
    sorted_tok = order // TOP_K
    counts = jnp.bincount(flat_e, length=N_EXPERTS)
    blocks_per_e = (counts + MOE_BLOCK - 1) // MOE_BLOCK
    blk_end = jnp.cumsum(blocks_per_e)
    blk_start = blk_end - blocks_per_e
    grp_start = jnp.cumsum(counts) - counts
    slot = blk_start[sorted_e] * MOE_BLOCK + (jnp.arange(n_assign) - grp_start[sorted_e])
    n_blocks = -(-n_assign // MOE_BLOCK) + N_EXPERTS
    slot_tok = jnp.zeros((n_blocks * MOE_BLOCK,), jnp.int32).at[slot].set(sorted_tok.astype(jnp.int32))
    block_e = jnp.minimum(jnp.searchsorted(blk_end, jnp.arange(n_blocks), side='right'), N_EXPERTS - 1)

    def expert_block(args):
        tok, e = args
        xb = h[tok]
        gu = xb @ w_gu[e] + b_gu[e]
        g = jnp.minimum(gu[:, :D_EXPERT], SWIGLU_LIMIT)
        up = jnp.clip(gu[:, D_EXPERT:], -SWIGLU_LIMIT, SWIGLU_LIMIT)
        act = (g * jax.nn.sigmoid(SWIGLU_ALPHA * g)) * (up + 1)
        return act @ w_down[e] + b_down[e]

    y_slots = lax.map(expert_block, (slot_tok.reshape(n_blocks, MOE_BLOCK), block_e)).reshape(-1, d)
    y_assign = y_slots[slot] * gate[order][:, None].astype(h.dtype)
    return jax.ops.segment_sum(y_assign, sorted_tok, num_segments=n)


def setup_inputs(seed: int = 0) -> dict:
    key = jax.random.key(seed)
    ks = jax.random.split(key, 24)
    f32 = jnp.float32
    nrm = lambda k, shape, s: jax.random.normal(k, shape, f32) * s
    b_in = nrm(ks[4], (DEPTH, IN_COLS), 0.02).at[:, OFF_F:OFF_GA].add(FORGET_BIAS_INIT)
    return {
        'x': nrm(ks[0], (BATCH, SEQ, D_MODEL), 1.0),
        'meta_tokens': nrm(ks[1], (N_META, D_MODEL), 1.0),
        'attn_norm_g': 1.0 + nrm(ks[2], (DEPTH, D_MODEL), 0.05),
        'w_in': nrm(ks[3], (DEPTH, D_MODEL, IN_COLS), D_MODEL ** -0.5),
        'b_in': b_in,
        'conv_w': nrm(ks[5], (DEPTH, CONV_WIDTH, CONV_CH), CONV_WIDTH ** -0.5),
        'conv_b': nrm(ks[6], (DEPTH, CONV_CH), 0.02),
        'conv_ln_g': 1.0 + nrm(ks[7], (DEPTH, CONV_CH), 0.05),
        'conv_ln_b': nrm(ks[8], (DEPTH, CONV_CH), 0.02),
        'w_conv_out': nrm(ks[9], (DEPTH, CONV_CH, D_MODEL), CONV_CH ** -0.5),
        'w_attn_out': nrm(ks[10], (DEPTH, FOX_WIDTH, D_MODEL), FOX_WIDTH ** -0.5),
        'w_mix_out': nrm(ks[11], (DEPTH, D_MODEL, D_MODEL), D_MODEL ** -0.5),
        'ffn_norm_g': 1.0 + nrm(ks[12], (DEPTH, D_MODEL), 0.05),
        'router_w': nrm(ks[13], (DEPTH, D_MODEL, N_EXPERTS), D_MODEL ** -0.5),
        'router_b': nrm(ks[14], (DEPTH, N_EXPERTS), 0.01),
        'w_gu': nrm(ks[15], (DEPTH, N_EXPERTS, D_MODEL, 2 * D_EXPERT), D_MODEL ** -0.5),
        'b_gu': nrm(ks[16], (DEPTH, N_EXPERTS, 2 * D_EXPERT), 0.01),
        'w_down': nrm(ks[17], (DEPTH, N_EXPERTS, D_EXPERT, D_MODEL), D_EXPERT ** -0.5),
        'b_down': nrm(ks[18], (DEPTH, N_EXPERTS, D_MODEL), 0.01),
        'final_norm_g': 1.0 + nrm(ks[19], (D_MODEL,), 0.05),
    }


def reference(x, meta_tokens, attn_norm_g, w_in, b_in, conv_w, conv_b, conv_ln_g, conv_ln_b,
              w_conv_out, w_attn_out, w_mix_out, ffn_norm_g, router_w, router_b, w_gu, b_gu,
              w_down, b_down, final_norm_g):
    b = x.shape[0]
    meta = jnp.broadcast_to(meta_tokens[None].astype(x.dtype), (b, N_META, D_MODEL))
    h = jnp.concatenate([meta, x], axis=1)
    for i in range(DEPTH):
        h = h + hybrid_mixer(rms_norm(h, attn_norm_g[i]), w_in[i], b_in[i], conv_w[i], conv_b[i],
                             conv_ln_g[i], conv_ln_b[i], w_conv_out[i], w_attn_out[i], w_mix_out[i])
        hn = rms_norm(h, ffn_norm_g[i]).reshape(-1, D_MODEL)
        h = h + moe_ffn(hn, router_w[i], router_b[i], w_gu[i], b_gu[i], w_down[i], b_down[i]).reshape(h.shape)
    h = rms_norm(h, final_norm_g)
    return h[:, N_META:]
```

```cpp
#include <hip/hip_runtime.h>
#include <cstdio>
#include <cstdint>

typedef unsigned short bf16_t;
typedef short bf16x8 __attribute__((ext_vector_type(8)));
typedef float f32x4 __attribute__((ext_vector_type(4)));
typedef float f32x16 __attribute__((ext_vector_type(16)));
typedef unsigned u32x4 __attribute__((ext_vector_type(4)));
typedef unsigned u32x2 __attribute__((ext_vector_type(2)));

constexpr int D = 1024, NB = 4, SEQ = 8192, NMETA = 16, M = NB * SEQ;
constexpr int NH = 16, HD = 64, NE = 32, TOPK = 4, NA = M * TOPK;
constexpr int IN_COLS = 7184, OFF_Q = 2048, OFF_K = 3072, OFF_V = 4096, OFF_F = 5120, OFF_GA = 5136, OFF_GB = 6160;
constexpr int CONVW = 31;
constexpr int KVROWS = SEQ + 64;
constexpr float LOG2E = 1.4426950408889634f;
constexpr float C2 = 0.125f * LOG2E;
constexpr float RMS_EPS = 1e-5f, LN_EPS = 1e-5f;
constexpr float NEG_BIG = -1e30f;

constexpr size_t MiB = 1u << 20;
constexpr size_t WS_CTL = 0, CTL_ZERO_BYTES = 1 * MiB;
constexpr size_t WS_LISTS = 4 * MiB;
constexpr size_t WS_TOPI = 8 * MiB;
constexpr size_t WS_TOPG = 8 * MiB + 512 * 1024;
constexpr size_t WS_LOGF = 10 * MiB;
constexpr size_t WS_LOGFM = 12 * MiB;
constexpr size_t WS_BIAS = 13 * MiB;
constexpr size_t WS_RSX = 9 * MiB + 512 * 1024;
constexpr size_t WS_RSTD = 9 * MiB;
constexpr size_t WS_WR_T = 17 * MiB;
constexpr size_t WS_LRS = 20 * MiB, WS_LGT = 24 * MiB;
constexpr size_t WS_SBIN = 18 * MiB + 512 * 1024;
constexpr size_t WS_SBDN = 19 * MiB;
constexpr size_t WS_SACT = 28 * MiB;
constexpr size_t WS_GSUM = 15 * MiB + 512 * 1024;
constexpr size_t WS_KN2 = 52 * MiB;
constexpr size_t WS_QN2 = 57 * MiB;
constexpr size_t WS_KNM = 61 * MiB + 512 * 1024;
constexpr size_t WS_SBGU = 18 * MiB;
constexpr size_t WS_XNM = 16 * MiB;
constexpr size_t WS_GLUM = 16 * MiB + 64 * 1024;
constexpr size_t WS_WIN_T = 32 * MiB, WS_WCO_T = 46 * MiB, WS_WAO_T = 48 * MiB, WS_WMIX_T = 50 * MiB;
constexpr size_t WS_WGU_T = 64 * MiB;
constexpr size_t WS_TMPA = 192 * MiB;
constexpr size_t WS_Y = 192 * MiB;
constexpr size_t WS_XN = 256 * MiB;
constexpr size_t WS_GLU = 320 * MiB;
constexpr size_t WS_Q = 384 * MiB;
constexpr size_t WS_QSTRIDE = 66 * MiB;
constexpr size_t WS_K = WS_Q + WS_QSTRIDE, WS_V = WS_Q + 2 * WS_QSTRIDE;
constexpr size_t WS_SGA = WS_Q + 3 * WS_QSTRIDE, WS_SGB = WS_Q + 4 * WS_QSTRIDE, WS_U = 714 * MiB;
constexpr size_t WS_ACT = 450 * MiB;
constexpr size_t WS_H = 778 * MiB;
constexpr size_t WS_WDN_T = 906 * MiB;
constexpr size_t WS_END = 970 * MiB;
static_assert(WS_SGB + 64 * MiB <= WS_U && WS_ACT + 256 * MiB <= WS_U && WS_ACT >= WS_K && WS_U + 64 * MiB <= WS_H && WS_H + 128 * MiB <= WS_WDN_T, "d_ws map");
constexpr int CW_CNT = 64;

__device__ __forceinline__ unsigned f2bf(float f) { unsigned u = __builtin_bit_cast(unsigned, f); return (u + 0x7fffu + ((u >> 16) & 1u)) >> 16; }
__device__ __forceinline__ float bf2f(unsigned short b) { return __builtin_bit_cast(float, (unsigned)b << 16); }
__device__ __forceinline__ unsigned pk2(float lo, float hi) { return f2bf(lo) | (f2bf(hi) << 16); }
__device__ __forceinline__ unsigned pk4_i8(float a, float b, float c, float d) {
    const int ia = (int)__builtin_rintf(a), ib = (int)__builtin_rintf(b), ic = (int)__builtin_rintf(c), id = (int)__builtin_rintf(d);
    return ((unsigned)ia & 0xffu) | (((unsigned)ib & 0xffu) << 8) | (((unsigned)ic & 0xffu) << 16) | ((unsigned)id << 24);
}
__device__ __forceinline__ float lane_max_16_32(float v) {
    float a = v, b = v; asm volatile("s_nop 1\n\tv_permlane16_swap_b32 %0, %1" : "+v"(a), "+v"(b)); v = fmaxf(a, b);
    a = v; b = v; asm volatile("s_nop 1\n\tv_permlane32_swap_b32 %0, %1" : "+v"(a), "+v"(b)); return fmaxf(a, b);
}
__device__ __forceinline__ float wave_sum(float v) {
#pragma unroll
    for (int o = 1; o < 64; o <<= 1) v += __shfl_xor(v, o);
    return v;
}
__device__ __forceinline__ float sigmoidf_(float z) { return 1.f / (1.f + __expf(-z)); }

__device__ __forceinline__ int launder(int v) { asm volatile("" : "+v"(v)); return v; }
__device__ __forceinline__ int tid_of(int wave) { return launder(wave * 64 + (int)__builtin_amdgcn_mbcnt_hi(~0u, __builtin_amdgcn_mbcnt_lo(~0u, 0u))); }
namespace pg8 {
#define PG8_LAS __attribute__((address_space(3)))
typedef unsigned short bf16_t;
typedef short bf16x8 __attribute__((ext_vector_type(8)));
typedef float f32x4 __attribute__((ext_vector_type(4)));
typedef unsigned u32x4 __attribute__((ext_vector_type(4)));
constexpr int BM = 256, BK = 64, HALF = 128, HTB = HALF * BK * 2  , STAGE_BYTES = 8 * HTB, NXCD = 8, WGM = 8;

__host__ __device__ __forceinline__ int lds_byte(int r, int c) { const int st = (r >> 4) * 2 + (c >> 5), rr = r & 15, cc = c & 31, ob = rr * 64 + cc * 2; return st * 1024 + (ob ^ (((ob >> 9) & 1) << 5)); }
__host__ __device__ __forceinline__ void stage_rc(int b, int& R, int& C) { const int st = b / 1024, sb = b % 1024, swz = sb ^ (((sb >> 9) & 1) << 5); R = (st >> 1) * 16 + swz / 64; C = (st & 1) * 32 + (swz % 64) / 2; }
__host__ __device__ __forceinline__ int perm32(int rho) { const int n = rho >> 4, i = rho & 15; return 8 * (i >> 2) + 4 * n + (i & 3); }

struct Unit { int pm, pn, part; };
struct Gemm { const bf16_t* A; const bf16_t* Bt; int M, N, K; const bf16_t* A2 = nullptr; const bf16_t* Bt2 = nullptr; };

struct StaticOrder {
    int nM, nN, nwg, G, c;
    __host__ __device__ void init(int M, int N, int G_, int c_) { nM = M / BM; nN = N / BM; nwg = nM * nN; G = G_; c = c_; }
    __host__ __device__ bool next(int i, Unit& u) const {
        const long L = (long)i * G + c; if (L >= nwg) return false;
        int wgid = (int)L; { const int q = nwg / NXCD, r = nwg % NXCD, xcd = wgid % NXCD, off = wgid / NXCD; wgid = (xcd < r ? xcd * (q + 1) : r * (q + 1) + (xcd - r) * q) + off; }
        const int nig = WGM * nN, gid = wgid / nig, fm = gid * WGM, gsz = (nM - fm) < WGM ? (nM - fm) : WGM;
        u.pm = fm + ((wgid % nig) % gsz); u.pn = (wgid % nig) / gsz; u.part = 0; return true;
    }
    __device__ __forceinline__ void a_ready(const Unit&) const {}
    __device__ __forceinline__ void done(const Unit&) const {}
};

struct PairOrder {
    StaticOrder base;
    __host__ __device__ void init(int M, int N, int G_, int c_) { base.init(M, N, G_, c_); }
    __host__ __device__ bool next(int i, Unit& u) const { if (!base.next(i >> 1, u)) return false; u.part = i & 1; return true; }
    __device__ __forceinline__ void a_ready(const Unit&) const {}
    __device__ __forceinline__ void done(const Unit&) const {}
};
__device__ __forceinline__ unsigned cvt_pk_bf16(float lo, float hi) { unsigned r; asm volatile("v_cvt_pk_bf16_f32 %0, %1, %2" : "=v"(r) : "v"(lo), "v"(hi)); return r; }
typedef float f32x2 __attribute__((ext_vector_type(2)));
typedef int i32x4 __attribute__((ext_vector_type(4)));
template <bool I8> struct AccSel { typedef f32x4 T; };
template <> struct AccSel<true> { typedef i32x4 T; };
__device__ __forceinline__ f32x4 mma16(bf16x8 b, bf16x8 a, f32x4 c) { return __builtin_amdgcn_mfma_f32_16x16x32_bf16(b, a, c, 0, 0, 0); }
__device__ __forceinline__ i32x4 mma16(bf16x8 b, bf16x8 a, i32x4 c) { return __builtin_amdgcn_mfma_i32_16x16x64_i8(__builtin_bit_cast(i32x4, b), __builtin_bit_cast(i32x4, a), c, 0, 0, 0); }
__device__ __forceinline__ float sigm(float z) { return __builtin_amdgcn_rcpf(1.0f + __expf(-z)); }
__device__ __forceinline__ f32x4 sigm4(f32x4 z) { return (f32x4){sigm(z[0]), sigm(z[1]), sigm(z[2]), sigm(z[3])}; }
__device__ __forceinline__ f32x2 sigm_pk(f32x2 z) { f32x2 e = z * (-1.4426950408889634f); e.x = __builtin_amdgcn_exp2f(e.x); e.y = __builtin_amdgcn_exp2f(e.y); e = e + 1.0f; f32x2 r; r.x = __builtin_amdgcn_rcpf(e.x); r.y = __builtin_amdgcn_rcpf(e.y); return r; }
__device__ __forceinline__ f32x2 lo2(f32x4 v) { return (f32x2){v[0], v[1]}; }
__device__ __forceinline__ f32x2 hi2(f32x4 v) { return (f32x2){v[2], v[3]}; }
__device__ __forceinline__ f32x2 cvt_lo2(i32x4 v) { return (f32x2){(float)v[0], (float)v[1]}; }
__device__ __forceinline__ f32x2 cvt_hi2(i32x4 v) { return (f32x2){(float)v[2], (float)v[3]}; }
__device__ __forceinline__ f32x2 swiglu_pk(f32x2 z1, f32x2 z2) {
    f32x2 gg, up; gg.x = fminf(z1.x, 7.f); gg.y = fminf(z1.y, 7.f); up.x = fminf(fmaxf(z2.x, -7.f), 7.f); up.y = fminf(fmaxf(z2.y, -7.f), 7.f);
    f32x2 e = gg * (-1.702f * 1.4426950408889634f); e.x = __builtin_amdgcn_exp2f(e.x); e.y = __builtin_amdgcn_exp2f(e.y); e = e + 1.0f;
    f32x2 r; r.x = __builtin_amdgcn_rcpf(e.x); r.y = __builtin_amdgcn_rcpf(e.y);
    const f32x2 t = gg * r; return t * up + t; }
__device__ __forceinline__ u32x4 pack8_pk(f32x2 a, f32x2 b, f32x2 c, f32x2 d) { u32x4 w; w.x = cvt_pk_bf16(a.x, a.y); w.y = cvt_pk_bf16(b.x, b.y); w.z = cvt_pk_bf16(c.x, c.y); w.w = cvt_pk_bf16(d.x, d.y); return w; }
__device__ __forceinline__ u32x4 pack8(f32x4 v0, f32x4 v1) { u32x4 w; w.x = cvt_pk_bf16(v0[0], v0[1]); w.y = cvt_pk_bf16(v0[2], v0[3]); w.z = cvt_pk_bf16(v1[0], v1[1]); w.w = cvt_pk_bf16(v1[2], v1[3]); return w; }
__device__ __forceinline__ void unpack8(u32x4 w, f32x4& lo, f32x4& hi) {
    lo = (f32x4){__builtin_bit_cast(float, w.x << 16), __builtin_bit_cast(float, w.x & 0xffff0000u), __builtin_bit_cast(float, w.y << 16), __builtin_bit_cast(float, w.y & 0xffff0000u)};
    hi = (f32x4){__builtin_bit_cast(float, w.z << 16), __builtin_bit_cast(float, w.z & 0xffff0000u), __builtin_bit_cast(float, w.w << 16), __builtin_bit_cast(float, w.w & 0xffff0000u)};
}
struct EpiInProj {
    static constexpr bool PERM = true, AFTER_DRAIN = false;
    const float* b_in; const float* RSX; const float* SB; bf16_t *GLU, *Q; size_t qstride; float qscale; int seq; float* QN2; float* KN2;
    __device__ __forceinline__ void operator()(const i32x4 (&acc)[2][2][4][2], const Unit& u, int wr, int wc, int fr, int fq) const {
        const int row0 = u.pm * BM + wr * 64 + fr;
        const float* sp = SB + u.pn * 256 + wc * 32 + 8 * fq;
        float rs[2][4];
#pragma unroll
        for (int ai = 0; ai < 2; ++ai)
#pragma unroll
            for (int m = 0; m < 4; ++m) rs[ai][m] = RSX[row0 + ai * HALF + m * 16];
        f32x4 sc[2][2];
#pragma unroll
        for (int bj = 0; bj < 2; ++bj)
#pragma unroll
            for (int n = 0; n < 2; ++n) sc[bj][n] = *(const f32x4*)(sp + bj * HALF + 4 * n);
        if (u.pn < 8) {
            const int ch0 = u.pn * 128 + wc * 32 + 8 * fq;
            f32x4 ba[2], bb[2];
#pragma unroll
            for (int n = 0; n < 2; ++n) { ba[n] = *(const f32x4*)(b_in + ch0 + 4 * n); bb[n] = *(const f32x4*)(b_in + 1024 + ch0 + 4 * n); }
#pragma unroll
            for (int ai = 0; ai < 2; ++ai)
#pragma unroll
                for (int m = 0; m < 4; ++m) { const float r_ = rs[ai][m];
                    f32x2 o[4];
#pragma unroll
                    for (int n = 0; n < 2; ++n) { const f32x4 fa = sc[0][n] * r_, fb = sc[1][n] * r_;
                        o[2 * n] = (cvt_lo2(acc[ai][0][m][n]) * lo2(fa) + lo2(ba[n])) * sigm_pk(cvt_lo2(acc[ai][1][m][n]) * lo2(fb) + lo2(bb[n]));
                        o[2 * n + 1] = (cvt_hi2(acc[ai][0][m][n]) * hi2(fa) + hi2(ba[n])) * sigm_pk(cvt_hi2(acc[ai][1][m][n]) * hi2(fb) + hi2(bb[n])); }
                    __builtin_nontemporal_store(pack8_pk(o[0], o[1], o[2], o[3]), (u32x4*)(GLU + (size_t)(row0 + ai * HALF + m * 16) * 1024 + ch0));
                }
        } else {
            const int kind = (u.pn - 8) >> 2, ct = wc * 32 + 8 * fq, cw = (u.pn & 3) * 256 + ct, bcol = u.pn * 256 + ct + (u.pn >= 20 ? 16 : 0);
            bf16_t* base = Q + (size_t)kind * qstride;
            const int radd = (kind == 1 || kind == 2) ? 64 * ((u.pm * BM) / seq + 1) : 0;
            f32x4 bv[2][2];
#pragma unroll
            for (int bj = 0; bj < 2; ++bj)
#pragma unroll
                for (int n = 0; n < 2; ++n) bv[bj][n] = *(const f32x4*)(b_in + bcol + bj * HALF + 4 * n);
#pragma unroll
            for (int ai = 0; ai < 2; ++ai)
#pragma unroll
                for (int m = 0; m < 4; ++m) { bf16_t* rowp = base + (size_t)(row0 + ai * HALF + m * 16 + radd) * 1024 + cw; const float r_ = rs[ai][m];
#pragma unroll
                    for (int bj = 0; bj < 2; ++bj) { const f32x4 f0 = sc[bj][0] * r_, f1 = sc[bj][1] * r_;
                        f32x2 o0 = cvt_lo2(acc[ai][bj][m][0]) * lo2(f0) + lo2(bv[bj][0]), o1 = cvt_hi2(acc[ai][bj][m][0]) * hi2(f0) + hi2(bv[bj][0]), o2 = cvt_lo2(acc[ai][bj][m][1]) * lo2(f1) + lo2(bv[bj][1]), o3 = cvt_hi2(acc[ai][bj][m][1]) * hi2(f1) + hi2(bv[bj][1]);
                        if (kind == 0) { o0 = o0 * qscale; o1 = o1 * qscale; o2 = o2 * qscale; o3 = o3 * qscale; } else if (kind >= 3) { o0 = sigm_pk(o0); o1 = sigm_pk(o1); o2 = sigm_pk(o2); o3 = sigm_pk(o3); }
                        const u32x4 w_ = pack8_pk(o0, o1, o2, o3);
                        __builtin_nontemporal_store(w_, (u32x4*)(rowp + bj * HALF));
                        if (kind <= 1) {
                            f32x4 lo, hi; unpack8(w_, lo, hi); lo = lo * lo + hi * hi; float ss = (lo[0] + lo[1]) + (lo[2] + lo[3]);
                            ss += __shfl_xor(ss, 16); ss += __shfl_xor(ss, 32);
                            if (fq == 0) (kind == 0 ? QN2 : KN2)[((size_t)((u.pn & 3) * 4 + bj * 2 + (wc >> 1)) * (kind == 0 ? (size_t)M : (size_t)NB * KVROWS) + (size_t)(row0 + ai * HALF + m * 16 + radd)) * 2 + (wc & 1)] = ss; } } }
        }
    }
};
template <bool HAS_ADD> struct EpiGated {
    static constexpr bool PERM = true, AFTER_DRAIN = false;
    const bf16_t* SG; const bf16_t* ADD; bf16_t* OUT;
    __device__ __forceinline__ void operator()(const f32x4 (&acc)[2][2][4][2], const Unit& u, int wr, int wc, int fr, int fq) const {
        const int row0 = u.pm * BM + wr * 64 + fr, col0 = u.pn * BM + wc * 32 + 8 * fq;
#pragma unroll
        for (int ai = 0; ai < 2; ++ai)
#pragma unroll
            for (int m = 0; m < 4; ++m) { const size_t off = (size_t)(row0 + ai * HALF + m * 16) * 1024 + col0;
#pragma unroll
                for (int bj = 0; bj < 2; ++bj) { f32x4 g0, g1; unpack8(*(const u32x4*)(SG + off + bj * HALF), g0, g1);
                    f32x4 v0 = acc[ai][bj][m][0] * g0, v1 = acc[ai][bj][m][1] * g1;
                    if (HAS_ADD) { f32x4 t0, t1; unpack8(*(const u32x4*)(ADD + off + bj * HALF), t0, t1); v0 = v0 + t0; v1 = v1 + t1; }
                    *(u32x4*)(OUT + off + bj * HALF) = pack8(v0, v1); } }
    }
};
struct EpiMerge {
    static constexpr bool PERM = true, AFTER_DRAIN = false; static constexpr int NREL = 16;
    const bf16_t* SGA; const bf16_t* SGB; bf16_t* OUT;
    __device__ __forceinline__ void mid(f32x4 (&acc)[2][2][4][2], const Unit& u, int wr, int wc, int fr, int fq) const {
        const int row0 = u.pm * BM + wr * 64 + fr, col0 = u.pn * BM + wc * 32 + 8 * fq;
#pragma unroll
        for (int ai = 0; ai < 2; ++ai) {
#pragma unroll
            for (int m = 0; m < 4; ++m) { const size_t off = (size_t)(row0 + ai * HALF + m * 16) * 1024 + col0;
#pragma unroll
                for (int bj = 0; bj < 2; ++bj) { f32x4 a0, a1, b0, b1; unpack8(*(const u32x4*)(SGA + off + bj * HALF), a0, a1); unpack8(*(const u32x4*)(SGB + off + bj * HALF), b0, b1);
#pragma unroll
                    for (int i = 0; i < 4; ++i) { a0[i] *= __builtin_amdgcn_rcpf(fmaxf(b0[i], 1e-30f)); a1[i] *= __builtin_amdgcn_rcpf(fmaxf(b1[i], 1e-30f)); }
                    acc[ai][bj][m][0] = acc[ai][bj][m][0] * a0; acc[ai][bj][m][1] = acc[ai][bj][m][1] * a1; } }
            asm volatile("" ::: "memory");
        }
    }
    __device__ __forceinline__ void operator()(const f32x4 (&acc)[2][2][4][2], const Unit& u, int wr, int wc, int fr, int fq) const {
        const int row0 = u.pm * BM + wr * 64 + fr, col0 = u.pn * BM + wc * 32 + 8 * fq;
#pragma unroll
        for (int ai = 0; ai < 2; ++ai)
#pragma unroll
            for (int m = 0; m < 4; ++m) { const size_t off = (size_t)(row0 + ai * HALF + m * 16) * 1024 + col0;
#pragma unroll
                for (int bj = 0; bj < 2; ++bj) { f32x4 b0, b1; unpack8(*(const u32x4*)(SGB + off + bj * HALF), b0, b1);
#pragma unroll
                    for (int i = 0; i < 4; ++i) { b0[i] = fmaxf(b0[i], 1e-30f); b1[i] = fmaxf(b1[i], 1e-30f); }
                    *(u32x4*)(OUT + off + bj * HALF) = pack8(acc[ai][bj][m][0] * b0, acc[ai][bj][m][1] * b1); } }
    }
};
struct EpiResid {
    static constexpr bool PERM = true, AFTER_DRAIN = false;
    const float* X; bf16_t* H;
    __device__ __forceinline__ void operator()(const f32x4 (&acc)[2][2][4][2], const Unit& u, int wr, int wc, int fr, int fq) const {
        const int row0 = u.pm * BM + wr * 64 + fr, col0 = u.pn * BM + wc * 32 + 8 * fq;
#pragma unroll
        for (int ai = 0; ai < 2; ++ai)
#pragma unroll
            for (int m = 0; m < 4; ++m) { const size_t off = (size_t)(row0 + ai * HALF + m * 16) * 1024 + col0;
#pragma unroll
                for (int bj = 0; bj < 2; ++bj) { const f32x4 x0 = *(const f32x4*)(X + off + bj * HALF), x1 = *(const f32x4*)(X + off + bj * HALF + 4);
                    *(u32x4*)(H + off + bj * HALF) = pack8(x0 + acc[ai][bj][m][0], x1 + acc[ai][bj][m][1]); } }
    }
};
template <class Epi, class Sched, bool ALIGN_EPI = false, bool SP2 = false, bool I8 = false, bool DUAL = false>
__device__ __forceinline__ void gemm_phase(PG8_LAS unsigned char* lds, const Gemm g, const Sched& S, const Epi& E) {
    const int tid = ::launder((int)threadIdx.x), wid = __builtin_amdgcn_readfirstlane(tid >> 6), lane = tid & 63, wr = wid >> 2, wc = wid & 3, fr = lane & 15, fq = lane >> 4;
    const int K = g.K, nt = K / BK;
    unsigned voffA[2], voffB[2];
#pragma unroll
    for (int i = 0; i < 2; ++i) { int R, C; stage_rc(tid * 16 + i * 8192, R, C); const int Rb = Epi::PERM ? ((R & ~31) + perm32(R & 31)) : R;
        voffA[i] = (unsigned)(R * K + C) * 2u; voffB[i] = (unsigned)(Rb * K + C) * 2u; }
    const size_t kstep = (size_t)(BK * 2);
    const size_t hstep = (size_t)HALF * K * 2;
    const size_t tstep = 2 * hstep;
    const unsigned ldsw = (unsigned)wid * 1024u;
    const int aoff = lds_byte(wr * 64 + fr, fq * 8), boff = lds_byte(wc * 32 + fr, fq * 8);
#define PG8_SA(b, h) (((b) * 2 + (h)) * HTB)
#define PG8_SB(b, h) ((4 + (b) * 2 + (h)) * HTB)
#define PG8_STAGE(bufoff, gbase, voff) do { _Pragma("unroll") for (int _i = 0; _i < 2; ++_i) \
        __builtin_amdgcn_global_load_lds((const unsigned*)((const char*)(gbase) + (voff)[_i]), (PG8_LAS unsigned*)(lds + (bufoff) + ldsw + _i * 8192), 16, 0, 0); } while (0)
#define PG8_LDA(dst, b, h) do { _Pragma("unroll") for (int m = 0; m < 4; ++m) _Pragma("unroll") for (int k = 0; k < 2; ++k) dst[m][k] = *(const PG8_LAS bf16x8*)(lds + PG8_SA(b, h) + aoff + m * 2048 + k * 1024); } while (0)
#define PG8_LDB(dst, b, h) do { _Pragma("unroll") for (int n = 0; n < 2; ++n) _Pragma("unroll") for (int k = 0; k < 2; ++k) dst[n][k] = *(const PG8_LAS bf16x8*)(lds + PG8_SB(b, h) + boff + n * 2048 + k * 1024); } while (0)
#define PG8_MMA(ai, bj, At, Bt) do { __builtin_amdgcn_s_setprio(1); _Pragma("unroll") for (int m = 0; m < 4; ++m) _Pragma("unroll") for (int n = 0; n < 2; ++n) _Pragma("unroll") for (int k = 0; k < 2; ++k) \
        acc[ai][bj][m][n] = mma16(Bt[n][k], At[m][k], acc[ai][bj][m][n]); __builtin_amdgcn_s_setprio(0); } while (0)
#define PG8_WAIT_V(n) asm volatile("s_waitcnt vmcnt(" #n ")" ::: "memory")
#define PG8_WAIT_L(n) asm volatile("s_waitcnt lgkmcnt(" #n ")" ::: "memory")
#define PG8_BAR __builtin_amdgcn_s_barrier()
#define PG8_SCHED __builtin_amdgcn_sched_barrier(0)
    Unit cur, nxt; int ui = 0;
    if (!S.next(0, cur)) return;
    typedef typename AccSel<I8>::T acc_t; acc_t acc[2][2][4][2];
#pragma unroll
    for (int a = 0; a < 2; ++a)
#pragma unroll
        for (int b = 0; b < 2; ++b)
#pragma unroll
            for (int m = 0; m < 4; ++m)
#pragma unroll
                for (int n = 0; n < 2; ++n) acc[a][b][m][n] = acc_t{};
    bf16x8 At[4][2], B0[2][2], B1[2][2];
    const char* cA = (const char*)((DUAL && cur.part) ? g.A2 : g.A) + (size_t)cur.pm * tstep; const char* cB = (const char*)((DUAL && cur.part) ? g.Bt2 : g.Bt) + (size_t)cur.pn * tstep;
    S.a_ready(cur);
    if constexpr (SP2) {
        PG8_STAGE(PG8_SB(0, 0), cB, voffB); PG8_STAGE(PG8_SB(0, 1), cB + hstep, voffB); PG8_STAGE(PG8_SA(0, 0), cA, voffA); PG8_STAGE(PG8_SA(0, 1), cA + hstep, voffA);
        if (wr == 1) PG8_BAR;
        PG8_WAIT_V(2); PG8_BAR;
        PG8_STAGE(PG8_SB(1, 0), cB + kstep, voffB); PG8_STAGE(PG8_SA(1, 0), cA + kstep, voffA); PG8_STAGE(PG8_SB(1, 1), cB + hstep + kstep, voffB);
        PG8_WAIT_V(6); PG8_BAR;
    } else {
        PG8_STAGE(PG8_SB(0, 0), cB, voffB); PG8_STAGE(PG8_SA(0, 0), cA, voffA); PG8_STAGE(PG8_SB(0, 1), cB + hstep, voffB); PG8_STAGE(PG8_SA(0, 1), cA + hstep, voffA);
        if (wr == 1) PG8_BAR;
        PG8_WAIT_V(4); PG8_BAR;
        PG8_STAGE(PG8_SB(1, 0), cB + kstep, voffB); PG8_STAGE(PG8_SA(1, 0), cA + kstep, voffA); PG8_STAGE(PG8_SB(1, 1), cB + hstep + kstep, voffB);
        PG8_WAIT_V(6); PG8_BAR;
    }
    for (;;) {
        const bool has_next = S.next(ui + 1, nxt);
        const char* nA = has_next ? (const char*)((DUAL && nxt.part) ? g.A2 : g.A) + (size_t)nxt.pm * tstep : cA; const char* nB = has_next ? (const char*)((DUAL && nxt.part) ? g.Bt2 : g.Bt) + (size_t)nxt.pn * tstep : cB;
        for (int t = 0; t < nt; t += 2) {
            const bool last = (t == nt - 2);
            const char* a1 = cA + (size_t)(t + 1) * kstep;
            const char* a2 = last ? nA : cA + (size_t)(t + 2) * kstep; const char* b2 = last ? nB : cB + (size_t)(t + 2) * kstep;
            const char* a3 = a2 + kstep; const char* b3 = b2 + kstep;
            if (last && has_next) S.a_ready(nxt);
            if constexpr (SP2) {
            PG8_LDB(B0, 0, 0); PG8_LDB(B1, 0, 1); PG8_SCHED; PG8_LDA(At, 0, 0); PG8_STAGE(PG8_SA(1, 1), a1 + hstep, voffA);
            PG8_WAIT_V(8); PG8_WAIT_L(0); PG8_BAR; PG8_MMA(0, 0, At, B0); PG8_MMA(0, 1, At, B1); PG8_BAR; PG8_SCHED;
            PG8_LDA(At, 0, 1); PG8_STAGE(PG8_SB(0, 0), b2, voffB); PG8_STAGE(PG8_SB(0, 1), b2 + hstep, voffB); PG8_STAGE(PG8_SA(0, 0), a2, voffA);
            PG8_WAIT_V(8); PG8_WAIT_L(0); PG8_BAR; PG8_MMA(1, 0, At, B0); PG8_MMA(1, 1, At, B1); PG8_BAR; PG8_SCHED;
            PG8_LDB(B0, 1, 0); PG8_LDB(B1, 1, 1); PG8_SCHED; PG8_LDA(At, 1, 0); PG8_STAGE(PG8_SA(0, 1), a2 + hstep, voffA);
            PG8_WAIT_V(8); PG8_WAIT_L(0); PG8_BAR; PG8_MMA(0, 0, At, B0); PG8_MMA(0, 1, At, B1); PG8_BAR; PG8_SCHED;
            PG8_LDA(At, 1, 1); PG8_STAGE(PG8_SB(1, 0), b3, voffB); PG8_STAGE(PG8_SB(1, 1), b3 + hstep, voffB); PG8_STAGE(PG8_SA(1, 0), a3, voffA);
            PG8_WAIT_V(8); PG8_WAIT_L(0); PG8_BAR; PG8_MMA(1, 0, At, B0); PG8_MMA(1, 1, At, B1); PG8_BAR; PG8_SCHED;
            } else {
            PG8_LDB(B0, 0, 0); PG8_SCHED; PG8_LDA(At, 0, 0); PG8_STAGE(PG8_SA(1, 1), a1 + hstep, voffA);
            PG8_WAIT_L(8); PG8_BAR; PG8_WAIT_L(0); PG8_MMA(0, 0, At, B0); PG8_BAR; PG8_SCHED;
            PG8_LDB(B1, 0, 1); PG8_STAGE(PG8_SB(0, 0), b2, voffB);
            PG8_BAR; PG8_WAIT_L(0); PG8_MMA(0, 1, At, B1); PG8_BAR;
            PG8_LDA(At, 0, 1); PG8_STAGE(PG8_SA(0, 0), a2, voffA);
            PG8_BAR; PG8_WAIT_L(0); PG8_MMA(1, 0, At, B0); PG8_BAR; PG8_SCHED;
            PG8_STAGE(PG8_SB(0, 1), b2 + hstep, voffB);
            PG8_WAIT_V(6); PG8_BAR; PG8_MMA(1, 1, At, B1); PG8_BAR;
            PG8_LDB(B0, 1, 0); PG8_SCHED; PG8_LDA(At, 1, 0); PG8_STAGE(PG8_SA(0, 1), a2 + hstep, voffA);
            PG8_WAIT_L(8); PG8_BAR; PG8_WAIT_L(0); PG8_MMA(0, 0, At, B0); PG8_BAR; PG8_SCHED;
            PG8_LDB(B1, 1, 1); PG8_STAGE(PG8_SB(1, 0), b3, voffB);
            PG8_BAR; PG8_WAIT_L(0); PG8_MMA(0, 1, At, B1); PG8_BAR;
            PG8_LDA(At, 1, 1); PG8_STAGE(PG8_SA(1, 0), a3, voffA);
            PG8_BAR; PG8_WAIT_L(0); PG8_MMA(1, 0, At, B0); PG8_BAR; PG8_SCHED;
            PG8_STAGE(PG8_SB(1, 1), b3 + hstep, voffB);
            PG8_WAIT_V(6); PG8_BAR; PG8_MMA(1, 1, At, B1); PG8_BAR;
            }
        }
        if constexpr (ALIGN_EPI) { if (wr == 0) PG8_BAR; }
        bool keep_acc = false;
        if constexpr (DUAL) { if (cur.part == 0) { E.mid(acc, cur, wr, wc, fr, fq); keep_acc = true; } else E(acc, cur, wr, wc, fr, fq); }
        else if constexpr (!Epi::AFTER_DRAIN) { E(acc, cur, wr, wc, fr, fq); S.done(cur); }
        if (!has_next) break;
        if (!keep_acc) {
#pragma unroll
        for (int a = 0; a < 2; ++a)
#pragma unroll
            for (int b = 0; b < 2; ++b)
#pragma unroll
                for (int m = 0; m < 4; ++m)
#pragma unroll
                    for (int n = 0; n < 2; ++n) acc[a][b][m][n] = acc_t{};
        }
        cur = nxt; cA = nA; cB = nB; ++ui;
        if constexpr (ALIGN_EPI) { if (wr == 1) PG8_BAR; }
    }
    PG8_WAIT_V(0);
    if constexpr (!ALIGN_EPI) { if (wr == 0) PG8_BAR; }
    PG8_BAR;
    if constexpr (Epi::AFTER_DRAIN) { E.fused(acc, cur, wr, wc, fr, fq, lds, wid, lane); S.done(cur); }
#undef PG8_SA
#undef PG8_SB
#undef PG8_STAGE
#undef PG8_LDA
#undef PG8_LDB
#undef PG8_MMA
#undef PG8_WAIT_V
#undef PG8_WAIT_L
#undef PG8_BAR
#undef PG8_SCHED
}
}
namespace pg8 {
struct GUnit { int e, row0, nrows, pn, cntm1, base, tau; };
struct MoeOrder {
    const PG8_LAS int* tab; int npn, G, c, total;
    __device__ __forceinline__ void init(const PG8_LAS int* t, int npn_, int G_, int c_) { tab = t; npn = npn_; G = G_; c = c_; total = __builtin_amdgcn_readfirstlane(t[32]) * npn_; }
    __device__ __forceinline__ bool next(int i, GUnit& u) const {
        const int L = i * G + c; if (L >= total) return false;
        const int tau = L / npn; u.pn = L % npn;
        int e = 0;
#pragma unroll
        for (int j = 1; j < 32; ++j) e += (__builtin_amdgcn_readfirstlane(tab[j]) <= tau) ? 1 : 0;
        const int cn = __builtin_amdgcn_readfirstlane(tab[33 + e]), t0 = __builtin_amdgcn_readfirstlane(tab[e]);
        u.e = e; u.row0 = (tau - t0) * 256; u.nrows = (cn - u.row0) < 256 ? (cn - u.row0) : 256; u.cntm1 = cn - 1; u.base = __builtin_amdgcn_readfirstlane(tab[65 + e]); u.tau = tau;
        return true;
    }
};
struct RowsGather {
    static constexpr bool LOADS = true;
    const int* lists;
    __device__ __forceinline__ int raw0(const GUnit&) const { return 0; }
    __device__ __forceinline__ const int* addr(const GUnit& u, int R) const { int s = u.row0 + R; s = s < u.cntm1 ? s : u.cntm1; return lists + (size_t)u.e * 32768 + s; }
    __device__ __forceinline__ int raw(const GUnit& u, int R) const { int s = u.row0 + R; s = s < u.cntm1 ? s : u.cntm1; return lists[(size_t)u.e * 32768 + s]; }
    static __device__ __forceinline__ unsigned row(int raw) { return (unsigned)raw >> 2; }
};
struct RowsDense {
    static constexpr bool LOADS = false;
    __device__ __forceinline__ const int* addr(const GUnit&, int) const { return nullptr; }
    __device__ __forceinline__ int raw0(const GUnit& u) const { return u.base + u.row0; }
    __device__ __forceinline__ int raw(const GUnit& u, int R) const { int s = u.row0 + R; s = s < u.cntm1 ? s : u.cntm1; return u.base + s; }
    static __device__ __forceinline__ unsigned row(int raw) { return (unsigned)raw; }
};
struct EpiMoeGU {
    static constexpr bool PERM = true, AFTER_DRAIN = false;
    const float* b_gu; const float* LRS; const float* SB; unsigned char* ACTq; float* SACT; PG8_LAS float* xm;
    __device__ __forceinline__ void operator()(const i32x4 (&acc)[2][2][4][2], const GUnit& u, int wr, int wc, int fr, int fq) const {
        const int fq_ = ::launder(fq), ch0 = u.pn * 128 + wc * 32 + 8 * fq_, rb = ::launder(wr * 64 + fr); const float* bp = b_gu + (size_t)u.e * 2048 + ch0;
        const float* sp = SB + (size_t)u.e * 2048 + u.pn * 256 + wc * 32 + 8 * fq_;
        const float* lrs = LRS + (size_t)u.e * 32768 + u.row0;
        f32x4 bg[2], bu[2], sg[2], su[2];
#pragma unroll
        for (int n = 0; n < 2; ++n) { bg[n] = *(const f32x4*)(bp + 4 * n); bu[n] = *(const f32x4*)(bp + 1024 + 4 * n); sg[n] = *(const f32x4*)(sp + 4 * n); su[n] = *(const f32x4*)(sp + HALF + 4 * n); }
        float rsv[2][4];
#pragma unroll
        for (int ai = 0; ai < 2; ++ai)
#pragma unroll
            for (int m = 0; m < 4; ++m) { int rr = ai * HALF + m * 16 + rb; rr = rr < u.nrows ? rr : u.nrows - 1; rsv[ai][m] = lrs[rr]; }
        f32x2 av[2][4][4];
#pragma unroll
        for (int ai = 0; ai < 2; ++ai)
#pragma unroll
            for (int m = 0; m < 4; ++m) { const float rs = rsv[ai][m];
                const f32x4 sgr[2] = {sg[0] * rs, sg[1] * rs}, sur[2] = {su[0] * rs, su[1] * rs};
                f32x2 o[4];
#pragma unroll
                for (int n = 0; n < 2; ++n) {
                    o[2 * n] = swiglu_pk(cvt_lo2(acc[ai][0][m][n]) * lo2(sgr[n]) + lo2(bg[n]), cvt_lo2(acc[ai][1][m][n]) * lo2(sur[n]) + lo2(bu[n]));
                    o[2 * n + 1] = swiglu_pk(cvt_hi2(acc[ai][0][m][n]) * hi2(sgr[n]) + hi2(bg[n]), cvt_hi2(acc[ai][1][m][n]) * hi2(sur[n]) + hi2(bu[n])); }
                av[ai][m][0] = o[0]; av[ai][m][1] = o[1]; av[ai][m][2] = o[2]; av[ai][m][3] = o[3];
                float mx = fmaxf(fmaxf(fmaxf(fabsf(o[0].x), fabsf(o[0].y)), fmaxf(fabsf(o[1].x), fabsf(o[1].y))), fmaxf(fmaxf(fabsf(o[2].x), fabsf(o[2].y)), fmaxf(fabsf(o[3].x), fabsf(o[3].y))));
                mx = ::lane_max_16_32(mx);
                if (fq == 0) (xm + (ai * HALF + m * 16) * 4 + wc)[rb * 4] = mx; }
        asm volatile("s_waitcnt lgkmcnt(0)" ::: "memory"); __builtin_amdgcn_s_barrier(); asm volatile("" ::: "memory");
        unsigned char* actp = ACTq + ((size_t)u.tau * 8 + u.pn) * 32768; float* scp = SACT + (size_t)(u.base + u.row0) * 8 + u.pn;
        const unsigned loff = (unsigned)rb * 128u + (unsigned)(wc * 32 + 8 * fq_), soff = (unsigned)rb * 8u, xoff = (unsigned)rb * 4u;
#pragma unroll
        for (int ai = 0; ai < 2; ++ai)
#pragma unroll
            for (int m = 0; m < 4; ++m) { const int rs0 = ai * HALF + m * 16;
                const f32x4 t = *(const PG8_LAS f32x4*)(xm + rs0 * 4 + xoff); const float tmax = fmaxf(fmaxf(t[0], t[1]), fmaxf(t[2], t[3])), inv = tmax > 0.f ? 127.f * __builtin_amdgcn_rcpf(tmax) : 0.f;
                if (rb < u.nrows - rs0) { const f32x2 q0_ = av[ai][m][0] * inv, q1_ = av[ai][m][1] * inv, q2_ = av[ai][m][2] * inv, q3_ = av[ai][m][3] * inv;
                    u32x2 q; q.x = ::pk4_i8(q0_.x, q0_.y, q1_.x, q1_.y); q.y = ::pk4_i8(q2_.x, q2_.y, q3_.x, q3_.y);
                    *(u32x2*)(actp + (size_t)rs0 * 128 + loff) = q;
                    if (wc == 0 && fq == 0) (scp + (size_t)rs0 * 8)[soff] = tmax * (1.f / 127.f); } }
    }
};
struct EpiMoeDown {
    static constexpr bool PERM = true, AFTER_DRAIN = false;
    const float* b_dn; const float* SB; const int* lists; const float* LGT; bf16_t* Y;
    __device__ __forceinline__ void operator()(const f32x4 (&acc)[2][2][4][2], const GUnit& u, int wr, int wc, int fr, int fq, const PG8_LAS float* scb  ) const {
        const int col0 = u.pn * BM + wc * 32 + 8 * ::launder(fq), rb = ::launder(wr * 64 + fr); const float* bp = b_dn + (size_t)u.e * 1024 + col0;
        const int* lp = lists + (size_t)u.e * 32768 + u.row0; const float* gp = LGT + (size_t)u.e * 32768 + u.row0; const float* sp = SB + (size_t)u.e * 1024 + col0;
        f32x4 bv[2][2], sv[2][2];
#pragma unroll
        for (int bj = 0; bj < 2; ++bj)
#pragma unroll
            for (int n = 0; n < 2; ++n) { bv[bj][n] = *(const f32x4*)(bp + bj * HALF + 4 * n); sv[bj][n] = *(const f32x4*)(sp + bj * HALF + 4 * n); }
        int idv[2][4]; float gtv[2][4];
#pragma unroll
        for (int ai = 0; ai < 2; ++ai)
#pragma unroll
            for (int m = 0; m < 4; ++m) { int rr = ai * HALF + m * 16 + rb; rr = rr < u.nrows ? rr : u.nrows - 1; idv[ai][m] = lp[rr]; gtv[ai][m] = gp[rr]; }
#pragma unroll
        for (int ai = 0; ai < 2; ++ai)
#pragma unroll
            for (int m = 0; m < 4; ++m) { const int rs0 = ai * HALF + m * 16;
                if (rb < u.nrows - rs0) { const float gt = gtv[ai][m]; bf16_t* yp = Y + (size_t)idv[ai][m] * 1024 + col0;
                    const float off = scb[rs0 + rb];
#pragma unroll
                    for (int bj = 0; bj < 2; ++bj) *(u32x4*)(yp + bj * HALF) = pack8(((acc[ai][bj][m][0] - off) * sv[bj][0] + bv[bj][0]) * gt, ((acc[ai][bj][m][1] - off) * sv[bj][1] + bv[bj][1]) * gt); } }
    }
};

template <class Epi, class Sched, class Rows, int KE = 1024, bool I8 = false, bool BS = false, bool KTM = false>
__device__ __forceinline__ void gemm_phase_g(int wave_  , PG8_LAS unsigned char* lds, PG8_LAS unsigned char* park  , PG8_LAS unsigned char* spark  , const float* ASC, const bf16_t* A, const bf16_t* Bt, size_t b_estride  , const Sched& S, const Rows& RW, const Epi& E) {
    const int tid = ::tid_of(wave_), wid = wave_, lane = tid & 63, wr = wid >> 2, wc = wid & 3, fr = lane & 15, fq = lane >> 4;
    constexpr int K = KE, nt = K / BK;
    typedef typename AccSel<I8 && !BS>::T acc_t;
    unsigned voffB[2];
#pragma unroll
    for (int i = 0; i < 2; ++i) { int R, C; stage_rc(tid * 16 + i * 8192, R, C); const int Rb = Epi::PERM ? ((R & ~31) + perm32(R & 31)) : R; voffB[i] = (unsigned)(Rb * K + C) * 2u; }
#define PG8_RC(i, R, C) int R, C; stage_rc(::tid_of(wave_) * 16 + (i) * 8192, R, C)
    constexpr size_t kstep = (size_t)(BK * 2), hstep = (size_t)HALF * K * 2, tstep = 2 * hstep, kstepA = KTM ? (size_t)32768 : kstep;
    const unsigned ldsw = (unsigned)wid * 1024u;
    const int aoff = lds_byte(wr * 64 + fr, fq * 8), boff = lds_byte(wc * 32 + fr, fq * 8);
#define PG8_SA(b, h) (((b) * 2 + (h)) * HTB)
#define PG8_SB(b, h) ((4 + (b) * 2 + (h)) * HTB)
#define PG8_STAGE(bufoff, gbase, voff) do { _Pragma("unroll") for (int _i = 0; _i < 2; ++_i) \
        __builtin_amdgcn_global_load_lds((const unsigned*)((const char*)(gbase) + (voff)[_i]), (PG8_LAS unsigned*)(lds + (bufoff) + ldsw + _i * 8192), 16, 0, 0); } while (0)
#define PG8_LDA(dst, b, h) do { _Pragma("unroll") for (int m = 0; m < 4; ++m) _Pragma("unroll") for (int k = 0; k < 2; ++k) dst[m][k] = *(const PG8_LAS bf16x8*)(lds + PG8_SA(b, h) + aoff + m * 2048 + k * 1024); } while (0)
#define PG8_LDB(dst, b, h) do { _Pragma("unroll") for (int n = 0; n < 2; ++n) _Pragma("unroll") for (int k = 0; k < 2; ++k) dst[n][k] = *(const PG8_LAS bf16x8*)(lds + PG8_SB(b, h) + boff + n * 2048 + k * 1024); } while (0)
#define PG8_MMA(ai, bj, At, Bt) do { __builtin_amdgcn_s_setprio(1); _Pragma("unroll") for (int m = 0; m < 4; ++m) _Pragma("unroll") for (int n = 0; n < 2; ++n) _Pragma("unroll") for (int k = 0; k < 2; ++k) \
        acc[ai][bj][m][n] = mma16(Bt[n][k], At[m][k], acc[ai][bj][m][n]); __builtin_amdgcn_s_setprio(0); } while (0)
#define PG8_MMA_BS(ai, bj, At, Bt, sc) do { _Pragma("unroll") for (int m = 0; m < 4; ++m) { i32x4 tq_[2]; __builtin_amdgcn_s_setprio(1); \
        _Pragma("unroll") for (int n = 0; n < 2; ++n) tq_[n] = mma16(Bt[n][0], At[m][0], magic); \
        _Pragma("unroll") for (int n = 0; n < 2; ++n) tq_[n] = mma16(Bt[n][1], At[m][1], tq_[n]); \
        __builtin_amdgcn_s_setprio(0); \
        _Pragma("unroll") for (int n = 0; n < 2; ++n) acc[ai][bj][m][n] = acc[ai][bj][m][n] + __builtin_bit_cast(f32x4, tq_[n]) * sc[m]; } } while (0)
#define PG8_LDSC(sc, ai, kt) do { if constexpr (BS) { _Pragma("unroll") for (int m = 0; m < 4; ++m) sc[m] = *(const PG8_LAS float*)(spark + (ui & 1) * 8192 + (((ai) * HALF + wr * 64 + m * 16 + fr) * 8 + (kt)) * 4); } } while (0)
#define PG8_SSUM(par_) do { const int t_ = ::tid_of(wave_), row_ = t_ >> 1, hf_ = t_ & 1; \
        const f32x4 s4_ = *(const PG8_LAS f32x4*)(spark + (par_) * 8192 + row_ * 32 + hf_ * 16); \
        float sm_ = (s4_.x + s4_.y) + (s4_.z + s4_.w); sm_ += __shfl_xor(sm_, 1); \
        if (hf_ == 0) *(PG8_LAS float*)(spark - 2048 + (par_) * 1024 + row_ * 4) = sm_ * 12582912.f; } while (0)
#define PG8_MM2(ai) do { if constexpr (BS) { PG8_MMA_BS(ai, 0, At, B0, sc); PG8_MMA_BS(ai, 1, At, B1, sc); } else { PG8_MMA(ai, 0, At, B0); PG8_MMA(ai, 1, At, B1); } } while (0)
#define PG8_SPARK(u_, par_) do { if constexpr (BS) __builtin_amdgcn_global_load_lds((const unsigned*)(ASC + (size_t)((u_).base + (u_).row0) * 8 + wid * 256 + lane * 4), (PG8_LAS unsigned*)(spark + (par_) * 8192 + wid * 1024), 16, 0, 0); } while (0)
#define PG8_WAIT_V(n) asm volatile("s_waitcnt vmcnt(" #n ")" ::: "memory")
#define PG8_WAIT_L(n) asm volatile("s_waitcnt lgkmcnt(" #n ")" ::: "memory")
#define PG8_BAR __builtin_amdgcn_s_barrier()
#define PG8_SCHED __builtin_amdgcn_sched_barrier(0)
    GUnit cur, nxt, nn; int ui = 0;
    if (!S.next(0, cur)) return;
    bool has_next = S.next(1, nxt), has_nn = has_next && S.next(2, nn);
    unsigned voC[2][2], voN[2][2];
    PG8_LAS unsigned char* pk = park + wid * 1024;
#define PG8_PARK(u_) do { if constexpr (Rows::LOADS) { _Pragma("unroll") for (int i = 0; i < 2; ++i) { PG8_RC(i, R_, C_); (void)C_; _Pragma("unroll") for (int h = 0; h < 2; ++h) \
        __builtin_amdgcn_global_load_lds((const unsigned*)RW.addr(u_, h * HALF + R_), (PG8_LAS unsigned*)(pk + (h * 2 + i) * 256), 4, 0, 0); } } } while (0)
#define PG8_UNPARK(h, i) (*(const PG8_LAS int*)(pk + ((h) * 2 + (i)) * 256 + lane * 4))
#pragma unroll
    for (int i = 0; i < 2; ++i) { PG8_RC(i, R_, C_);
#pragma unroll
        for (int h = 0; h < 2; ++h) {
            if constexpr (Rows::LOADS) {
                voC[h][i] = Rows::row(RW.raw(cur, h * HALF + R_)) * (unsigned)(K * 2) + (unsigned)C_ * 2u;
                voN[h][i] = has_next ? Rows::row(RW.raw(nxt, h * HALF + R_)) * (unsigned)(K * 2) + (unsigned)C_ * 2u : voC[h][i];
            } else { voC[h][i] = (unsigned)(h * HALF + R_) * (KTM ? 128u : (unsigned)(K * 2)) + (unsigned)C_ * 2u; voN[h][i] = 0u; } } }
    if (has_nn) PG8_PARK(nn);
    acc_t acc[2][2][4][2];
#pragma unroll
    for (int a = 0; a < 2; ++a)
#pragma unroll
        for (int b = 0; b < 2; ++b)
#pragma unroll
            for (int m = 0; m < 4; ++m)
#pragma unroll
                for (int n = 0; n < 2; ++n) acc[a][b][m][n] = acc_t{};
    bf16x8 At[4][2], B0[2][2], B1[2][2]; float sc[4];
    i32x4 magic = {0x4B400000, 0x4B400000, 0x4B400000, 0x4B400000}; asm volatile("" : "+v"(magic));
    const char* cA = (const char*)A; if constexpr (!Rows::LOADS) cA += KTM ? (size_t)cur.tau * 262144 : (size_t)Rows::row(RW.raw0(cur)) * (size_t)(K * 2);
    const char* cB = (const char*)Bt + (size_t)cur.e * b_estride + (size_t)cur.pn * tstep;
    PG8_SPARK(cur, 0); if (has_next) PG8_SPARK(nxt, 1);
    PG8_STAGE(PG8_SB(0, 0), cB, voffB); PG8_STAGE(PG8_SB(0, 1), cB + hstep, voffB); PG8_STAGE(PG8_SA(0, 0), cA, voC[0]); PG8_STAGE(PG8_SA(0, 1), cA, voC[1]);
    if (wr == 1) PG8_BAR;
    PG8_WAIT_V(2); PG8_BAR;
    PG8_STAGE(PG8_SB(1, 0), cB + kstep, voffB); PG8_STAGE(PG8_SA(1, 0), cA + kstepA, voC[0]); PG8_STAGE(PG8_SB(1, 1), cB + hstep + kstep, voffB);
    PG8_WAIT_V(6); PG8_BAR;
    for (;;) {
        const char* nA = cA; if constexpr (!Rows::LOADS) { if (has_next) nA = (const char*)A + (KTM ? (size_t)nxt.tau * 262144 : (size_t)Rows::row(RW.raw0(nxt)) * (size_t)(K * 2)); }
        const char* nB = has_next ? (const char*)Bt + (size_t)nxt.e * b_estride + (size_t)nxt.pn * tstep : cB;
        for (int t = 0; t < nt; t += 2) {
            const bool last = (t == nt - 2);
            const char* a1 = cA + (size_t)(t + 1) * kstepA;
            const char* a2 = last ? nA : cA + (size_t)(t + 2) * kstepA; const char* b2 = last ? nB : cB + (size_t)(t + 2) * kstep;
            const char* a3 = a2 + kstepA; const char* b3 = b2 + kstep;
            unsigned v20[2], v21[2];
#pragma unroll
            for (int i = 0; i < 2; ++i) { if constexpr (Rows::LOADS) { v20[i] = last ? voN[0][i] : voC[0][i]; v21[i] = last ? voN[1][i] : voC[1][i]; } else { v20[i] = voC[0][i]; v21[i] = voC[1][i]; } }
            if constexpr (BS) { if (t == 2) PG8_SSUM(ui & 1); }
            PG8_LDB(B0, 0, 0); PG8_LDB(B1, 0, 1); PG8_SCHED; PG8_LDA(At, 0, 0); PG8_LDSC(sc, 0, t); PG8_STAGE(PG8_SA(1, 1), a1, voC[1]);
            PG8_WAIT_V(8); PG8_WAIT_L(0); PG8_BAR; PG8_MM2(0); PG8_BAR; PG8_SCHED;
            PG8_LDA(At, 0, 1); PG8_LDSC(sc, 1, t); PG8_STAGE(PG8_SB(0, 0), b2, voffB); PG8_STAGE(PG8_SB(0, 1), b2 + hstep, voffB); PG8_STAGE(PG8_SA(0, 0), a2, v20);
            PG8_WAIT_V(8); PG8_WAIT_L(0); PG8_BAR; PG8_MM2(1); PG8_BAR; PG8_SCHED;
            PG8_LDB(B0, 1, 0); PG8_LDB(B1, 1, 1); PG8_SCHED; PG8_LDA(At, 1, 0); PG8_LDSC(sc, 0, t + 1); PG8_STAGE(PG8_SA(0, 1), a2, v21);
            PG8_WAIT_V(8); PG8_WAIT_L(0); PG8_BAR; PG8_MM2(0); PG8_BAR; PG8_SCHED;
            PG8_LDA(At, 1, 1); PG8_LDSC(sc, 1, t + 1); PG8_STAGE(PG8_SB(1, 0), b3, voffB); PG8_STAGE(PG8_SB(1, 1), b3 + hstep, voffB); PG8_STAGE(PG8_SA(1, 0), a3, v20);
            PG8_WAIT_V(8); PG8_WAIT_L(0); PG8_BAR; PG8_MM2(1); PG8_BAR; PG8_SCHED;
        }
        if (wr == 0) PG8_BAR;
        if constexpr (BS) E(acc, cur, wr, wc, fr, fq, (const PG8_LAS float*)(spark - 2048 + (ui & 1) * 1024)); else E(acc, cur, wr, wc, fr, fq);
        if (!has_next) break;
#pragma unroll
        for (int a = 0; a < 2; ++a)
#pragma unroll
            for (int b = 0; b < 2; ++b)
#pragma unroll
                for (int m = 0; m < 4; ++m)
#pragma unroll
                    for (int n = 0; n < 2; ++n) acc[a][b][m][n] = acc_t{};
        cur = nxt; cB = nB; cA = nA; nxt = nn; has_next = has_nn; ++ui;
        has_nn = has_next && S.next(ui + 2, nn);
        if constexpr (Rows::LOADS) {
#pragma unroll
        for (int i = 0; i < 2; ++i) { PG8_RC(i, R_, C_);
#pragma unroll
            for (int h = 0; h < 2; ++h) { voC[h][i] = voN[h][i];
                if (has_next) voN[h][i] = Rows::row(PG8_UNPARK(h, i)) * (unsigned)(K * 2) + (unsigned)C_ * 2u; } }
        }
        if constexpr (Rows::LOADS) { PG8_WAIT_L(0); asm volatile("" ::: "memory"); }
        if (has_nn) PG8_PARK(nn);
        if (has_next) PG8_SPARK(nxt, (ui + 1) & 1);
        if (wr == 1) PG8_BAR;
    }
    PG8_WAIT_V(0);
    PG8_BAR;
#undef PG8_PARK
#undef PG8_MMA_BS
#undef PG8_LDSC
#undef PG8_SSUM
#undef PG8_MM2
#undef PG8_SPARK
#undef PG8_RC
#undef PG8_UNPARK
#undef PG8_SA
#undef PG8_SB
#undef PG8_STAGE
#undef PG8_LDA
#undef PG8_LDB
#undef PG8_MMA
#undef PG8_WAIT_V
#undef PG8_WAIT_L
#undef PG8_BAR
#undef PG8_SCHED
}
}
#include <hip/hip_bf16.h>
#include <cmath>
namespace attn_body {
using bf16=__hip_bfloat16;
using bf16x8=__attribute__((ext_vector_type(8)))short;
using s16x4=__attribute__((ext_vector_type(4)))short;
using f32x16=__attribute__((ext_vector_type(16)))float;
using u32x4=__attribute__((ext_vector_type(4)))unsigned;
typedef float f32x4_t __attribute__((ext_vector_type(4)));
constexpr int BATCH=4,NHEAD=16,SEQ=8192,KVR=SEQ+64,D=64,DM=NHEAD*D;
constexpr int NW=8,QBLK=32,QB=QBLK*NW,KVBLK=64,NQB=SEQ/QB;
constexpr int ATTN_PITCH=DM, ATTN_UNIT_ROWS=QB;
__device__ __forceinline__ int crow(int r,int hi){return (r&3)+8*(r>>2)+4*hi;}
#define SBAR() __builtin_amdgcn_sched_barrier(0)
__device__ __forceinline__ void cmask(f32x16&p0,f32x16&p1,int jb,int qrel,int hi){
  const float NEG=-INFINITY; int kb=64*jb+4*hi;
  #pragma unroll
  for(int r=0;r<16;++r){int kv=kb+(r&3)+8*(r>>2); if(kv>qrel)p0[r]=NEG; if(kv+32>qrel)p1[r]=NEG;}
}

constexpr int NSLOT=3, SLOTB=8192;
constexpr int LDS_K=0, LDS_V=NSLOT*SLOTB, LDS_WS=2*NSLOT*SLOTB, LDS_OST=LDS_WS+NW*64*4, LDS_BIAS=LDS_OST+NW*4096, LDS_KN=LDS_BIAS+KVR*4, LDS_QM=LDS_KN+132*4, LDS_BYTES=LDS_QM+32;
constexpr float SKIP_THR=24.f;
constexpr float C2=0.125f*1.4426950408889634f;
__device__ __forceinline__ void glds16(const void*gsrc,unsigned lds_dst){unsigned keep;
  asm volatile("s_mov_b32 %0, m0\n\ts_mov_b32 m0, %2\n\ts_nop 0\n\tglobal_load_lds_dwordx4 %1, off\n\ts_mov_b32 m0, %0":"=&s"(keep):"v"(gsrc),"s"(lds_dst):"memory");}
__device__ __forceinline__ float max3f(float a,float b,float c){float r;asm("v_max3_f32 %0, %1, %2, %3":"=v"(r):"v"(a),"v"(b),"v"(c));return r;}
__device__ __forceinline__ float max2f(float a,float b){float r;asm("v_max_f32_e32 %0, %1, %2":"=v"(r):"v"(a),"v"(b));return r;}
__device__ __forceinline__ float fadd_s(float a,float b){float r;asm("v_add_f32_e32 %0, %1, %2":"=v"(r):"v"(a),"v"(b));return r;}
__device__ __forceinline__ float fsub_s(float a,float b){float r;asm("v_sub_f32_e32 %0, %1, %2":"=v"(r):"v"(a),"v"(b));return r;}
typedef float f32x2_t __attribute__((ext_vector_type(2))); typedef __bf16 bf16x2_t __attribute__((ext_vector_type(2)));
__device__ __forceinline__ unsigned cvtpk_s(float lo,float hi){f32x2_t v={lo,hi};bf16x2_t b=__builtin_convertvector(v,bf16x2_t);return __builtin_bit_cast(unsigned,b);}
#define WAIT_BAR(N) asm volatile("s_waitcnt vmcnt(" #N ") lgkmcnt(0)\n\ts_barrier":::"memory")

__device__ __forceinline__ void qkt(f32x16&p0,f32x16&p1,const char*Kslot,const bf16x8*qr,int r32,int hi){
  const char*kb=Kslot+hi*1024+r32*16;
  #pragma unroll
  for(int d0=0;d0<4;++d0){
    const bf16x8 b0=*reinterpret_cast<const bf16x8*>(kb+d0*2048);
    const bf16x8 b1=*reinterpret_cast<const bf16x8*>(kb+d0*2048+512);
    {p0=__builtin_amdgcn_mfma_f32_32x32x16_bf16(b0,qr[d0],p0,0,0,0);p1=__builtin_amdgcn_mfma_f32_32x32x16_bf16(b1,qr[d0],p1,0,0,0);}}
}
typedef __attribute__((address_space(3))) const char* lds_cptr;
typedef short v4i16_t __attribute__((ext_vector_type(4)));
__device__ __forceinline__ void kload8(bf16x8*kf,lds_cptr kp){
  kf[0]=*(const __attribute__((address_space(3))) bf16x8*)(kp);      kf[1]=*(const __attribute__((address_space(3))) bf16x8*)(kp+512);
  kf[2]=*(const __attribute__((address_space(3))) bf16x8*)(kp+2048); kf[3]=*(const __attribute__((address_space(3))) bf16x8*)(kp+2560);
  kf[4]=*(const __attribute__((address_space(3))) bf16x8*)(kp+4096); kf[5]=*(const __attribute__((address_space(3))) bf16x8*)(kp+4608);
  kf[6]=*(const __attribute__((address_space(3))) bf16x8*)(kp+6144); kf[7]=*(const __attribute__((address_space(3))) bf16x8*)(kp+6656);
}
__device__ __forceinline__ void kload2(bf16x8*kf,lds_cptr kp,int j){ kf[2*j]=*(const __attribute__((address_space(3))) bf16x8*)(kp+j*2048); kf[2*j+1]=*(const __attribute__((address_space(3))) bf16x8*)(kp+j*2048+512); }
__device__ __forceinline__ s16x4 vtr(lds_cptr p){ return __builtin_bit_cast(s16x4,__builtin_amdgcn_ds_read_tr16_b64_v4i16((__attribute__((address_space(3))) v4i16_t*)p)); }
__device__ __forceinline__ float rowmax(const f32x16&p0,const f32x16&p1){
  float a=max3f(p0[0],p0[1],p1[0]),b=max3f(p0[2],p0[3],p1[1]);a=max3f(a,p1[2],p1[3]);
  #pragma unroll
  for(int r=4;r<16;r+=4){a=max3f(a,p0[r],p0[r+1]);b=max3f(b,p0[r+2],p0[r+3]);a=max3f(a,p1[r],p1[r+1]);b=max3f(b,p1[r+2],p1[r+3]);}
  const float m=max2f(a,b);
  auto rr=__builtin_amdgcn_permlane32_swap(__float_as_uint(m),__float_as_uint(m),false,false);
  return max2f(__uint_as_float(rr[0]),__uint_as_float(rr[1]));
}
__device__ __forceinline__ void pv(f32x16*o,int vb,bf16x8 pa0,bf16x8 pa1,bf16x8 pa2,bf16x8 pa3){
  #pragma unroll
  for(int d0=0;d0<2;++d0){s16x4 lo[4],hi[4];
    #pragma unroll
    for(int ks=0;ks<4;++ks){
      asm volatile("ds_read_b64_tr_b16 %0,%1 offset:%c2":"=&v"(lo[ks]):"v"(vb),"i"(d0*4096+ks*1024):"memory");
      asm volatile("ds_read_b64_tr_b16 %0,%1 offset:%c2":"=&v"(hi[ks]):"v"(vb),"i"(d0*4096+ks*1024+512):"memory");}
    asm volatile("s_waitcnt lgkmcnt(0)":::"memory");SBAR();
    #define PK(k) (bf16x8){lo[k][0],lo[k][1],lo[k][2],lo[k][3],hi[k][0],hi[k][1],hi[k][2],hi[k][3]}
    o[d0]=__builtin_amdgcn_mfma_f32_32x32x16_bf16(pa0,PK(0),o[d0],0,0,0);
    o[d0]=__builtin_amdgcn_mfma_f32_32x32x16_bf16(pa1,PK(1),o[d0],0,0,0);
    o[d0]=__builtin_amdgcn_mfma_f32_32x32x16_bf16(pa2,PK(2),o[d0],0,0,0);
    o[d0]=__builtin_amdgcn_mfma_f32_32x32x16_bf16(pa3,PK(3),o[d0],0,0,0);
    #undef PK
  }
}

#ifndef ATTN_STORE16
#define ATTN_STORE16(p,v) (*(u32x4*)(p)=(v))
#endif
__device__ __forceinline__ int attn_jstart(lds_cptr shm3,int ui,int q0,int lane){
  int jstart;
  { const __attribute__((address_space(3))) float*bl=(const __attribute__((address_space(3))) float*)(shm3+LDS_BIAS),*KN=(const __attribute__((address_space(3))) float*)(shm3+LDS_KN),*QM=(const __attribute__((address_space(3))) float*)(shm3+LDS_QM);
    const int NTf=1+(q0+QB)/KVBLK; const float qm2=QM[ui];
    const float kd2=__builtin_fmaxf(__builtin_fmaxf(KN[NTf-4],KN[NTf-3]),__builtin_fmaxf(KN[NTf-2],KN[NTf-1]));
    const float rhs=bl[64+q0]-__builtin_sqrtf(qm2*kd2)-SKIP_THR;
    unsigned long long mk[3];
    #pragma unroll
    for(int c=0;c<3;++c){ const int j=lane+64*c; bool keep=false;
      if(j<NTf-4){ const float bm=(j==0)?bl[15]:bl[64*j+63]; keep=!(__builtin_sqrtf(qm2*KN[j])+bm<rhs); }
      mk[c]=__ballot(keep); }
    int j0=NTf-4; if(mk[2])j0=128+__builtin_ctzll(mk[2]); if(mk[1])j0=64+__builtin_ctzll(mk[1]); if(mk[0])j0=__builtin_ctzll(mk[0]);
    if(j0>NTf-5)j0=NTf-5; jstart=__builtin_amdgcn_readfirstlane(j0&~1); }
  return jstart;
}
template<int THRL> __device__ __forceinline__ void attn_unit(int ui,int b,int h,int qb,const bf16*Q,const bf16*__restrict__ K,const bf16*__restrict__ V,bf16*O,char*shm,bool pre  ,int nui,int nqb  ){
  const int tid=::launder((int)threadIdx.x),lane=tid&63,r32=lane&31,hi=lane>>5; const int wid=__builtin_amdgcn_readfirstlane(tid>>6);
  const long rowbase=(long)b*SEQ, kvbase=(long)b*KVR; const int q0=qb*QB;
  const bf16*Qw=Q+(rowbase+q0+wid*QBLK)*DM+h*D;
  const lds_cptr shm3=(lds_cptr)shm;
  const int jstart=attn_jstart(shm3,ui,q0,lane);
  const bf16*Kh=K+(kvbase+(long)jstart*KVBLK)*DM+h*D,*Vh=V+(kvbase+(long)jstart*KVBLK)*DM+h*D;
  const unsigned lds0=(unsigned)(uintptr_t)shm;
  float*wsf=(float*)(shm+LDS_WS)+wid*64;
  const bf16*ksrc=Kh+(long)lane*DM+wid*8;
  const bf16*vsrc=Vh+(long)(16*(wid&3)+(lane>>2))*DM+(wid>>2)*32+(lane&3)*8;
  const unsigned kdst=lds0+LDS_K+wid*1024, vdst=lds0+LDS_V+wid*1024;
  #define DMA_K(t,slot) glds16(ksrc+(long)(t)*KVBLK*DM,(unsigned)__builtin_amdgcn_readfirstlane(kdst+(slot)))
  #define DMA_V(t,slot) glds16(vsrc+(long)(t)*KVBLK*DM,(unsigned)__builtin_amdgcn_readfirstlane(vdst+(slot)))
  const int vb0=(int)(lds0+LDS_V)+((lane>>4)&1)*32+(lane&3)*8+(4*hi+((lane&15)>>2))*64;
  const char*Kbase=shm+LDS_K; bf16x8 kf[8];
  const lds_cptr kp0=shm3+LDS_K+hi*1024+r32*16; const lds_cptr vp0=shm3+LDS_V+((lane>>4)&1)*32+(lane&3)*8+(4*hi+((lane&15)>>2))*64;
  const int NT=1+(q0+QB)/KVBLK-jstart;
  if(!pre){DMA_K(0,0);DMA_V(0,0);DMA_K(1,SLOTB);}
  bf16x8 qr[4];
  #pragma unroll
  for(int d0=0;d0<4;++d0)qr[d0]=*reinterpret_cast<const bf16x8*>(&Qw[(long)r32*DM+d0*16+hi*8]);
  const float mhat=*(const __attribute__((address_space(3))) float*)(shm3+LDS_BIAS+(64+q0+wid*QBLK+r32)*4); float l_reg=0.f;f32x16 o[2];o[0]=f32x16{};o[1]=f32x16{};
  const lds_cptr biasp=shm3+LDS_BIAS+jstart*256+hi*16;
  #define BINIT(P0,P1,tn) do{ const lds_cptr bp_=biasp+(tn)*256; _Pragma("unroll") for(int g_=0;g_<4;++g_){ \
      const f32x4_t v0_=*(const __attribute__((address_space(3))) f32x4_t*)(bp_+g_*32)-mhat, v1_=*(const __attribute__((address_space(3))) f32x4_t*)(bp_+128+g_*32)-mhat; \
      P0[4*g_]=v0_[0];P0[4*g_+1]=v0_[1];P0[4*g_+2]=v0_[2];P0[4*g_+3]=v0_[3]; P1[4*g_]=v1_[0];P1[4*g_+1]=v1_[1];P1[4*g_+2]=v1_[2];P1[4*g_+3]=v1_[3]; } }while(0)
  const int qrel=wid*QBLK+r32;
  #define CMASK(P0,P1,t) do{int jb_=(t)-(NT-4); if(jb_>=0)cmask(P0,P1,jb_,qrel,hi);}while(0)
  #define START(P0,P1) do{ _Pragma("unroll") for(int r=0;r<16;++r)P0[r]=__builtin_amdgcn_exp2f(P0[r]); }while(0)
  #define RESC() do{}while(0)
  f32x16 pA0,pA1,pB0,pB1;
  int sl_prev=0,sl_cur=0,sl_next=SLOTB;
  #define ROT() do{sl_prev=sl_cur;sl_cur=sl_next;sl_next=(sl_next==(NSLOT-1)*SLOTB)?0:sl_next+SLOTB;}while(0)
  if(!pre)DMA_K(2,2*SLOTB);
  WAIT_BAR(3);
  BINIT(pA0,pA1,0); qkt(pA0,pA1,Kbase,qr,r32,hi);asm volatile("s_nop 15\n\ts_nop 7":"+v"(pA0),"+v"(pA1));CMASK(pA0,pA1,0);
  START(pA0,pA1);
  BINIT(pB0,pB1,1);
  _Pragma("unroll") for(int r=0;r<16;++r)pA1[r]=__builtin_amdgcn_exp2f(pA1[r]);
  WAIT_BAR(0);
  DMA_K(3,0);DMA_V(1,SLOTB);
  ROT();
  kload8(kf,kp0+sl_cur);
  WAIT_BAR(2);
  s16x4 vlo[8],vhi[8]; u32x4 pw0,pw1,pw2,pw3;
  #define PKW(P,B) cvtpk_s(P[B],P[B+1])
  #define PAF(k) __builtin_bit_cast(bf16x8,pw##k)
  #define VFR(i) (bf16x8){vlo[i][0],vlo[i][1],vlo[i][2],vlo[i][3],vhi[i][0],vhi[i][1],vhi[i][2],vhi[i][3]}
  #define PIN(x) asm volatile("":"+v"(x))
  #define MX3(a,b,c) __builtin_fmaxf(__builtin_fmaxf((a),(b)),(c))
  #define GAPA(MF,A0,A1,A2,A3,W0,W1,PW) do{ MF; sacc+=A0; sacc+=A1; sacc+=A2; sacc+=A3; PIN(sacc); W0; W1; PIN(PW); SBAR(); }while(0)
  #define EX(v) __builtin_amdgcn_exp2f(v)
  #define GAPB(MF,X,B) do{ MF; X[B]=EX(X[B]); X[B+1]=EX(X[B+1]); X[B+2]=EX(X[B+2]); X[B+3]=EX(X[B+3]); PIN(X); SBAR(); }while(0)
  #define VRD(i) do{ vlo[i]=vtr(vp_+(((i)>>2)*4096+((i)&3)*1024)); vhi[i]=vtr(vp_+(((i)>>2)*4096+((i)&3)*1024+512)); }while(0)
  #define KRD(G,j) do{ if(G){ kload2(kf,kp0+sl_next,j); SBAR(); } }while(0)
  #define STEP(C0,C1,P0,P1,t,GK,GV,GL) do{ SBAR(); \
    const lds_cptr vp_=vp0+sl_prev; \
    VRD(0); SBAR(); float sacc=(P0[0]+P0[1]); \
    GAPA(C0=__builtin_amdgcn_mfma_f32_32x32x16_bf16(kf[0],qr[0],C0,0,0,0), P0[2],P0[3],P0[4],P0[5],     pw0[0]=PKW(P0,0), pw0[1]=PKW(P0,2), pw0); \
    VRD(4); SBAR(); GAPA(C1=__builtin_amdgcn_mfma_f32_32x32x16_bf16(kf[1],qr[0],C1,0,0,0), P0[6],P0[7],P0[8],P0[9],     pw0[2]=PKW(P0,4), pw0[3]=PKW(P0,6), pw0); \
    VRD(1); SBAR(); GAPA(C0=__builtin_amdgcn_mfma_f32_32x32x16_bf16(kf[2],qr[1],C0,0,0,0),   P0[10],P0[11],P0[12],P0[13], pw1[0]=PKW(P0,8), pw1[1]=PKW(P0,10), pw1); \
    VRD(5); SBAR(); GAPA(C1=__builtin_amdgcn_mfma_f32_32x32x16_bf16(kf[3],qr[1],C1,0,0,0),   P0[14],P0[15],P1[0],P1[1],   pw1[2]=PKW(P0,12),pw1[3]=PKW(P0,14), pw1); \
    VRD(2); SBAR(); GAPA(C0=__builtin_amdgcn_mfma_f32_32x32x16_bf16(kf[4],qr[2],C0,0,0,0),   P1[2],P1[3],P1[4],P1[5],     pw2[0]=PKW(P1,0), pw2[1]=PKW(P1,2), pw2); \
    VRD(6); SBAR(); GAPA(C1=__builtin_amdgcn_mfma_f32_32x32x16_bf16(kf[5],qr[2],C1,0,0,0),   P1[6],P1[7],P1[8],P1[9],     pw2[2]=PKW(P1,4), pw2[3]=PKW(P1,6), pw2); \
    VRD(3); SBAR(); GAPA(C0=__builtin_amdgcn_mfma_f32_32x32x16_bf16(kf[6],qr[3],C0,0,0,0),   P1[10],P1[11],P1[12],P1[13], pw3[0]=PKW(P1,8), pw3[1]=PKW(P1,10), pw3); \
    VRD(7); SBAR(); GAPA(C1=__builtin_amdgcn_mfma_f32_32x32x16_bf16(kf[7],qr[3],C1,0,0,0),   P1[14],P1[15],0.f,0.f,       pw3[2]=PKW(P1,12),pw3[3]=PKW(P1,14), pw3); \
    l_reg+=sacc; \
    if(GK){DMA_K((t)+3,sl_cur);} if(GV){DMA_V((t)+1,sl_next);} \
    CMASK(C0,C1,t); \
    SBAR(); \
    GAPB(o[0]=__builtin_amdgcn_mfma_f32_32x32x16_bf16(PAF(0),VFR(0),o[0],0,0,0), C0,0); \
    GAPB(o[1]=__builtin_amdgcn_mfma_f32_32x32x16_bf16(PAF(0),VFR(4),o[1],0,0,0), C0,4); \
    KRD(GL,0); GAPB(o[0]=__builtin_amdgcn_mfma_f32_32x32x16_bf16(PAF(1),VFR(1),o[0],0,0,0), C0,8); \
    KRD(GL,1); GAPB(o[1]=__builtin_amdgcn_mfma_f32_32x32x16_bf16(PAF(1),VFR(5),o[1],0,0,0), C0,12); \
    KRD(GL,2); GAPB(o[0]=__builtin_amdgcn_mfma_f32_32x32x16_bf16(PAF(2),VFR(2),o[0],0,0,0), C1,0); \
    KRD(GL,3); GAPB(o[1]=__builtin_amdgcn_mfma_f32_32x32x16_bf16(PAF(2),VFR(6),o[1],0,0,0), C1,4); \
    GAPB(o[0]=__builtin_amdgcn_mfma_f32_32x32x16_bf16(PAF(3),VFR(3),o[0],0,0,0), C1,8); \
    GAPB(o[1]=__builtin_amdgcn_mfma_f32_32x32x16_bf16(PAF(3),VFR(7),o[1],0,0,0), C1,12); \
    if(GL){ BINIT(P0,P1,(t)+1); } \
    }while(0)
  int t=1;
  #undef CMASK
  #define CMASK(P0,P1,t) do{}while(0)
  for(;t+5<NT;t+=2){
    STEP(pB0,pB1,pA0,pA1,t,true,true,true);     WAIT_BAR(2); RESC(); ROT();
    STEP(pA0,pA1,pB0,pB1,t+1,true,true,true);   WAIT_BAR(2); RESC(); ROT();
  }
  #undef CMASK
  #define CMASK(P0,P1,t) do{int jb_=(t)-(NT-4); if(jb_>=0)cmask(P0,P1,jb_,qrel,hi);}while(0)
  #define ENDW(tt) do{ if((tt)+3<NT){WAIT_BAR(2);} else if((tt)+2<NT){WAIT_BAR(1);} else {WAIT_BAR(0);} }while(0)
  for(;t+2<NT;t+=2){
    STEP(pB0,pB1,pA0,pA1,t,(t+3<NT),(t+1<NT),(t+1<NT));       ENDW(t);   RESC(); ROT();
    STEP(pA0,pA1,pB0,pB1,t+1,(t+4<NT),(t+2<NT),(t+2<NT));     ENDW(t+1); RESC(); ROT();
  }
  STEP(pB0,pB1,pA0,pA1,t,false,true,true);       ENDW(t);   RESC(); ROT();
  STEP(pA0,pA1,pB0,pB1,NT-1,false,false,false); RESC();
  { float sacc=pA0[0]+pA0[1]; _Pragma("unroll") for(int r=2;r<16;++r)sacc+=pA0[r]; _Pragma("unroll") for(int r=0;r<16;++r)sacc+=pA1[r]; l_reg+=sacc;
    pw0=(u32x4){PKW(pA0,0),PKW(pA0,2),PKW(pA0,4),PKW(pA0,6)};pw1=(u32x4){PKW(pA0,8),PKW(pA0,10),PKW(pA0,12),PKW(pA0,14)};pw2=(u32x4){PKW(pA1,0),PKW(pA1,2),PKW(pA1,4),PKW(pA1,6)};pw3=(u32x4){PKW(pA1,8),PKW(pA1,10),PKW(pA1,12),PKW(pA1,14)};
    SBAR(); pv(o,vb0+sl_cur,PAF(0),PAF(1),PAF(2),PAF(3)); }
  #undef PKW
  #undef PAF
  #undef VFR
  #undef PIN
  #undef MX3
  #undef GAPA
  #undef GAPB
  #undef EX
  #undef VRD
  #undef KRD
  #undef STEP
  #undef ENDW
  asm volatile("s_waitcnt lgkmcnt(0)\n\ts_barrier":::"memory");
  if(nqb>=0){ const int jn=attn_jstart(shm3,nui,nqb*QB,lane);
    const bf16*Kn=K+(kvbase+(long)jn*KVBLK)*DM+h*D+(long)lane*DM+wid*8; const bf16*Vn=V+(kvbase+(long)jn*KVBLK)*DM+h*D+(long)(16*(wid&3)+(lane>>2))*DM+(wid>>2)*32+(lane&3)*8;
    glds16(Kn,(unsigned)__builtin_amdgcn_readfirstlane(kdst)); glds16(Vn,(unsigned)__builtin_amdgcn_readfirstlane(vdst));
    glds16(Kn+(long)KVBLK*DM,(unsigned)__builtin_amdgcn_readfirstlane(kdst+SLOTB)); glds16(Kn+2L*KVBLK*DM,(unsigned)__builtin_amdgcn_readfirstlane(kdst+2*SLOTB)); }
  {auto rr=__builtin_amdgcn_permlane32_swap(__float_as_uint(l_reg),__float_as_uint(l_reg),false,false);l_reg=__uint_as_float(rr[0])+__uint_as_float(rr[1]);}
  if(hi==0)wsf[32+r32]=l_reg;asm volatile("s_waitcnt lgkmcnt(0)":::"memory");
  float rli[16];
  #pragma unroll
  for(int r=0;r<16;++r)rli[r]=__builtin_amdgcn_rcpf(wsf[32+crow(r,hi)]);
  bf16*Ow=O+(rowbase+q0+wid*QBLK)*DM+h*D;
  { bf16*stg=(bf16*)(shm+LDS_OST)+wid*2048;
    #pragma unroll
    for(int r=0;r<16;++r){const int orow=crow(r,hi);
      #pragma unroll
      for(int d0=0;d0<2;++d0)stg[orow*64+d0*32+r32]=__float2bfloat16(o[d0][r]*rli[r]);}
    asm volatile("s_waitcnt lgkmcnt(0)":::"memory");
    #pragma unroll
    for(int i=0;i<4;++i){const int row=i*8+(lane>>3),ch=lane&7; const u32x4 v=*(const u32x4*)(stg+row*64+ch*8); ATTN_STORE16(Ow+(long)row*DM+ch*8,v);} }
  if(nqb<0)asm volatile("s_waitcnt lgkmcnt(0)\n\ts_barrier":::"memory");
  #undef DMA_K
  #undef DMA_V
  #undef CMASK
  #undef START
  #undef RESC
  #undef ROT
  #undef BINIT
}
constexpr int ATTN_LDS_BYTES=LDS_BYTES;
struct AttnTensors { const bf16* Q; const bf16* K; const bf16* V; bf16* O; const float* KN2; const float* QN2; const float* KNM; };
struct AttnUnit { int bh; int qb; };
struct StaticOrder {
  int vcu;
  __device__ __forceinline__ explicit StaticOrder(int grid,int block):vcu((block%8)*(grid/8)+block/8){}
  __device__ __forceinline__ bool next(int i,AttnUnit&u)const{ if(i>=8)return false; const int s=vcu&3, base=8*(i>>1); u.bh=vcu>>2; u.qb=(i&1)?base+7-s:base+s; return true; }
  __device__ __forceinline__ void a_ready(const AttnUnit&)const{}
  __device__ __forceinline__ void done(const AttnUnit&)const{}
};
template<class Sched,int THRL=8> __device__ __forceinline__ void attn_phase(char*lds,const AttnTensors&T,const float*bias,const Sched&S){
  AttnUnit u;
  if(!S.next(0,u))return;
  typedef __attribute__((address_space(3))) unsigned lds_u32;
  const int tid=::launder((int)threadIdx.x);
  { const f32x4_t*src=(const f32x4_t*)(bias+(long)u.bh*KVR); f32x4_t*dst=(f32x4_t*)(lds+LDS_BIAS);
    for(int i=tid;i<KVR/4;i+=NW*64)dst[i]=src[i];
    if(tid<140)((lds_u32*)((lds_cptr)lds+LDS_KN))[tid]=0u;
    __syncthreads(); }
  { lds_u32*KNu=(lds_u32*)((lds_cptr)lds+LDS_KN),*QMu=(lds_u32*)((lds_cptr)lds+LDS_QM);
    const int bb_=u.bh/NHEAD, hh_=u.bh%NHEAD;
    for(int row=tid;row<KVR;row+=NW*64){ float ss;
      if(row<64){ ss=0.f; if(row<16){ const f32x4_t q4=*(const f32x4_t*)(T.KNM+(row*NHEAD+hh_)*4); ss=(q4[0]+q4[1])+(q4[2]+q4[3]); } }
      else { const f32x2_t h2=*(const f32x2_t*)(T.KN2+((long)hh_*((long)::NB*KVR)+(long)bb_*KVR+row)*2); ss=h2[0]+h2[1]; }
      __hip_atomic_fetch_max(KNu+(row>>6),__float_as_uint(ss),__ATOMIC_RELAXED,__HIP_MEMORY_SCOPE_WORKGROUP); }
    for(int r=tid;r<8*QB;r+=NW*64){ AttnUnit v; if(!S.next(r>>8,v))break;
      const f32x2_t h2=*(const f32x2_t*)(T.QN2+((long)(v.bh%NHEAD)*(long)::M+(long)(v.bh/NHEAD)*SEQ+(long)v.qb*QB+(r&255))*2); const float ss=h2[0]+h2[1];
      __hip_atomic_fetch_max(QMu+(r>>8),__float_as_uint(ss),__ATOMIC_RELAXED,__HIP_MEMORY_SCOPE_WORKGROUP); }
    __syncthreads(); }
  for(int i=0;S.next(i,u);++i){ AttnUnit un; const bool hn=S.next(i+1,un); S.a_ready(u); attn_unit<THRL>(i,u.bh/NHEAD,u.bh%NHEAD,u.qb,T.Q,T.K,T.V,T.O,lds,i>0,i+1,hn?un.qb:-1); S.done(u); }
}
#undef SBAR
#undef WAIT_BAR
}
constexpr int NWAVES = 8;
constexpr int RING_OFF = 0, RING_BYTES = 131072;
constexpr int LDSCTL_OFF = RING_BYTES, MISC_OFF = LDSCTL_OFF + 320;
constexpr int LDS_BYTES = 163840;
constexpr int CW_TMO = 0, CW_CODE = 1;
constexpr int CW_BAR = 4096;
#define GAS __attribute__((address_space(1)))
#define LAS __attribute__((address_space(3)))
typedef unsigned v4u __attribute__((ext_vector_type(4)));
typedef GAS unsigned gu32;
#define RLX_AGENT __ATOMIC_RELAXED, __HIP_MEMORY_SCOPE_AGENT
#define LDS_WAIT() asm volatile("s_waitcnt lgkmcnt(0)" ::: "memory")
#define VM_WAIT() asm volatile("s_waitcnt vmcnt(0)" ::: "memory")
#define XB_TMO      128
#define XB_XCNT(j)  (256  + 64 * (j))
#define XB_XSUB(j)  (1280 + 64 * (j))
#define XB_XGEN(j)  (2304 + 64 * (j))
#define XB_TOP      3328
#define XB_TOPGEN   3392
#define XCD_BAR_WORDS 3456
#define XB_SPIN_CAP (1u << 18)

__device__ __forceinline__ unsigned xb_ld(unsigned* p)              { return __hip_atomic_load(p, __ATOMIC_RELAXED, __HIP_MEMORY_SCOPE_AGENT); }
__device__ __forceinline__ unsigned xb_add(unsigned* p, unsigned v) { return __hip_atomic_fetch_add(p, v, __ATOMIC_RELAXED, __HIP_MEMORY_SCOPE_AGENT); }
__device__ __forceinline__ unsigned xb_xcc_id() { return (unsigned)__builtin_amdgcn_s_getreg((3 << 11) | 20) & 0xFu; }
#define XB_SPIN(cond, bar) do { unsigned _sp = 0; while (cond) { __builtin_amdgcn_s_sleep(1); \
    if ((++_sp & 255u) == 0u) { if (xb_ld(&(bar)[XB_TMO])) break; if (_sp > XB_SPIN_CAP) { atomicAdd(&(bar)[XB_TMO], 1u); break; } } } } while (0)

struct XcdBarrier {
    unsigned* bar; unsigned x;
    volatile LAS unsigned* st;
};

__device__ __forceinline__ XcdBarrier xcd_barrier_post(unsigned* bar, volatile LAS unsigned* st) {
    XcdBarrier b; b.bar = bar; b.x = xb_xcc_id(); b.st = st;
    if (threadIdx.x == 0) (void)xb_add(&bar[XB_XCNT(b.x)], 1u);
    return b;
}
__device__ __forceinline__ void xcd_barrier_complete(unsigned* bar, unsigned x, unsigned& nloc, unsigned& nx) {
    const unsigned G = gridDim.x * gridDim.y * gridDim.z;
    unsigned sum, cnt, mine, sp = 0u;
    for (;;) {
        sum = 0u; cnt = 0u; mine = 0u;
#pragma unroll
        for (unsigned j = 0; j < 16; ++j) { const unsigned c = xb_ld(&bar[XB_XCNT(j)]); sum += c; cnt += (c > 0u) ? 1u : 0u; mine = (j == x) ? c : mine; }
        if (sum == G) break;
        __builtin_amdgcn_s_sleep(1);
        if ((++sp & 255u) == 0u) { if (xb_ld(&bar[XB_TMO])) break; if (sp > XB_SPIN_CAP) { atomicAdd(&bar[XB_TMO], 1u); break; } }
    }
    nloc = mine > 0u ? mine : 1u; nx = cnt > 0u ? cnt : 1u;
}

__device__ __forceinline__ void xcd_barrier(const XcdBarrier& b) {
    asm volatile("s_waitcnt vmcnt(0)" ::: "memory");
    __syncthreads();
    if (threadIdx.x == 0) {
        unsigned* bar = b.bar;
        __builtin_amdgcn_s_waitcnt(0);
        unsigned nloc = b.st[0], nx = b.st[1];
        if (nloc == 0u) { xcd_barrier_complete(bar, b.x, nloc, nx); b.st[0] = nloc; b.st[1] = nx; }
        const unsigned old = xb_add(&bar[XB_XSUB(b.x)], 1u);
        const unsigned gen = old / nloc;
        if (old + 1u == (gen + 1u) * nloc) {
            __builtin_amdgcn_fence(__ATOMIC_RELEASE, "agent");
            asm volatile("s_waitcnt vmcnt(0)" ::: "memory");
            const unsigned og = xb_add(&bar[XB_TOP], 1u);
            const unsigned tg = og / nx;
            if (og + 1u == (tg + 1u) * nx) xb_add(&bar[XB_TOPGEN], 1u);
            else XB_SPIN(xb_ld(&bar[XB_TOPGEN]) == tg, bar);
            __builtin_amdgcn_fence(__ATOMIC_ACQUIRE, "agent");
            xb_add(&bar[XB_XGEN(b.x)], 1u);
            asm volatile("s_waitcnt vmcnt(0)" ::: "memory");
        } else {
            XB_SPIN(xb_ld(&bar[XB_XGEN(b.x)]) == gen, bar);
            __builtin_amdgcn_fence(__ATOMIC_ACQUIRE, "agent");
            asm volatile("s_waitcnt vmcnt(0)" ::: "memory");
        }
    }
    __syncthreads();
}

struct Frame {
    LAS unsigned char* lds;
    volatile LAS unsigned* MISC;
    gu32* ctl;
    int tid, lane, wave, vcu, G;
};
struct Args { const float* in[20]; float* out; unsigned char* ws; int ph_lo, ph_hi; };
struct KA {
    unsigned long long base;
    __device__ __forceinline__ const float* in(int i) const { return (const float*)(const __attribute__((address_space(1))) float*)((const __attribute__((address_space(4))) unsigned long long*)base)[i]; }
    __device__ __forceinline__ float* out() const { return (float*)(__attribute__((address_space(1))) float*)((const __attribute__((address_space(4))) unsigned long long*)base)[20]; }
    __device__ __forceinline__ unsigned char* ws() const { return (unsigned char*)(__attribute__((address_space(1))) unsigned char*)((const __attribute__((address_space(4))) unsigned long long*)base)[21]; }
};
__device__ __forceinline__ KA kargs() {
#if defined(__HIP_DEVICE_COMPILE__)
    unsigned long long p = (unsigned long long)__builtin_amdgcn_kernarg_segment_ptr(); asm volatile("" : "+s"(p));
    return KA{p};
#else
    return KA{0ull};
#endif
}

struct P0Item { const float* W; size_t ldw; bf16_t* WT; };
__device__ __forceinline__ void p0_item_load(const P0Item& it, int lane, f32x4 (&r)[8]) {
#pragma unroll
    for (int i = 0; i < 8; ++i) r[i] = __builtin_nontemporal_load((const f32x4*)(it.W + (size_t)(8 * i + (lane >> 3)) * it.ldw + 4 * (lane & 7)));
}
__device__ __forceinline__ void p0_item_store(const P0Item& it, int K, LAS float* scr, int lane, const f32x4 (&r)[8]) {
#pragma unroll
    for (int i = 0; i < 8; ++i) { LAS float* d = scr + (8 * i + (lane >> 3)) * 33 + 4 * (lane & 7); d[0] = r[i].x; d[1] = r[i].y; d[2] = r[i].z; d[3] = r[i].w; }
    LDS_WAIT(); asm volatile("" ::: "memory");
    const int c = lane & 7;
#pragma unroll
    for (int j = 0; j < 4; ++j) { const int n = (lane >> 3) + 8 * j; const LAS float* s = scr + (8 * c) * 33 + n;
        v4u o; o.x = pk2(s[0 * 33], s[1 * 33]); o.y = pk2(s[2 * 33], s[3 * 33]); o.z = pk2(s[4 * 33], s[5 * 33]); o.w = pk2(s[6 * 33], s[7 * 33]);
        *(GAS v4u*)(it.WT + (size_t)n * K + 8 * c) = o; }
    LDS_WAIT(); asm volatile("" ::: "memory");
}
__device__ __forceinline__ int glu_src_col(int r) { return ((r >> 7) & 1) * 1024 + (r >> 8) * 128 + (r & 127); }

__device__ __forceinline__ void p0_rows_wg(Frame& F, const KA& A, unsigned char* ws) {
    const int lane = F.lane, wave = F.wave, fr = lane & 15, fq = lane >> 4, c0 = wave * 128 + 8 * fq;
    LAS float* xs = (LAS float*)(F.lds + RING_OFF);
    LAS float* pacc = (LAS float*)(F.lds + RING_OFF + 4096);
    f32x4 gv[4][2]; u32x4 wh[4], wl[4];
    { const float* g = A.in(2); const float* wp = A.in(3) + (size_t)c0 * IN_COLS + OFF_F + fr;
#pragma unroll
      for (int s_ = 0; s_ < 4; ++s_) { gv[s_][0] = *(const f32x4*)(g + c0 + 32 * s_); gv[s_][1] = *(const f32x4*)(g + c0 + 32 * s_ + 4);
        float wv[8];
#pragma unroll
        for (int j = 0; j < 8; ++j) wv[j] = wp[(size_t)(32 * s_ + j) * IN_COLS];
        u32x4 h_; h_.x = pk2(wv[0], wv[1]); h_.y = pk2(wv[2], wv[3]); h_.z = pk2(wv[4], wv[5]); h_.w = pk2(wv[6], wv[7]);
        u32x4 l_;
        l_.x = pk2(wv[0] - __builtin_bit_cast(float, h_.x << 16), wv[1] - __builtin_bit_cast(float, h_.x & 0xffff0000u)); l_.y = pk2(wv[2] - __builtin_bit_cast(float, h_.y << 16), wv[3] - __builtin_bit_cast(float, h_.y & 0xffff0000u));
        l_.z = pk2(wv[4] - __builtin_bit_cast(float, h_.z << 16), wv[5] - __builtin_bit_cast(float, h_.z & 0xffff0000u)); l_.w = pk2(wv[6] - __builtin_bit_cast(float, h_.w << 16), wv[7] - __builtin_bit_cast(float, h_.w & 0xffff0000u));
        wh[s_] = h_; wl[s_] = l_; } }
    const float bbh = A.in(4)[OFF_F + 4 * (wave & 3) + (lane & 3)];
    constexpr int NGRP = M / 16 + 1;
    int grp = F.vcu, par = 0; f32x4 h[4][2];
    { const float* src = (grp < M / 16 ? A.in(0) + (size_t)grp * 16 * D : A.in(1)) + (size_t)fr * D + c0;
#pragma unroll
      for (int s_ = 0; s_ < 4; ++s_) { h[s_][0] = *(const f32x4*)(src + 32 * s_); h[s_][1] = *(const f32x4*)(src + 32 * s_ + 4); } }
    for (; grp < NGRP; grp += F.G, par ^= 1) {
#pragma unroll
        for (int s_ = 0; s_ < 4; ++s_) asm volatile("" : "+v"(h[s_][0]), "+v"(h[s_][1]));
        const int nx = grp + F.G; f32x4 hn[4][2];
        if (nx < NGRP) { const float* src = (nx < M / 16 ? A.in(0) + (size_t)nx * 16 * D : A.in(1)) + (size_t)fr * D + c0;
#pragma unroll
            for (int s_ = 0; s_ < 4; ++s_) { hn[s_][0] = *(const f32x4*)(src + 32 * s_); hn[s_][1] = *(const f32x4*)(src + 32 * s_ + 4); } }
        float ss = 0.f, amax = 0.f; f32x4 v[4][2];
#pragma unroll
        for (int s_ = 0; s_ < 4; ++s_)
#pragma unroll
            for (int t = 0; t < 2; ++t) { const f32x4 x_ = h[s_][t]; ss += (x_.x * x_.x + x_.y * x_.y) + (x_.z * x_.z + x_.w * x_.w);
                v[s_][t] = x_ * gv[s_][t]; const f32x4 a_ = __builtin_elementwise_abs(v[s_][t]); amax = fmaxf(amax, fmaxf(fmaxf(a_.x, a_.y), fmaxf(a_.z, a_.w))); }
        ss += __shfl_xor(ss, 16); ss += __shfl_xor(ss, 32);
        amax = fmaxf(amax, __shfl_xor(amax, 16)); amax = fmaxf(amax, __shfl_xor(amax, 32));
        LAS float* xp = xs + par * 256;
        if (fq == 0) { xp[(wave * 16 + fr) * 2] = ss; xp[(wave * 16 + fr) * 2 + 1] = amax; }
        __syncthreads();
        float sst = 0.f, amt = 0.f;
#pragma unroll
        for (int w2 = 0; w2 < NWAVES; ++w2) { sst += xp[(w2 * 16 + fr) * 2]; amt = fmaxf(amt, xp[(w2 * 16 + fr) * 2 + 1]); }
        const float qinv = amt > 0.f ? 127.f / amt : 0.f;
        const bool is_x = grp < M / 16;
        unsigned char* op = (is_x ? ws + WS_XN + (size_t)grp * 16 * D : ws + WS_XNM) + (size_t)fr * D + c0;
        pg8::f32x4 acc = {0.f, 0.f, 0.f, 0.f};
#pragma unroll
        for (int s_ = 0; s_ < 4; ++s_) { const f32x4 v0 = v[s_][0], v1 = v[s_][1];
            u32x4 hi; hi.x = pk2(v0.x, v0.y); hi.y = pk2(v0.z, v0.w); hi.z = pk2(v1.x, v1.y); hi.w = pk2(v1.z, v1.w);
            { const f32x4 q0 = v0 * qinv, q1 = v1 * qinv; u32x2 q8; q8.x = pk4_i8(q0.x, q0.y, q0.z, q0.w); q8.y = pk4_i8(q1.x, q1.y, q1.z, q1.w); *(u32x2*)(op + 32 * s_) = q8; }
            u32x4 lo;
            lo.x = pk2(v0.x - __builtin_bit_cast(float, hi.x << 16), v0.y - __builtin_bit_cast(float, hi.x & 0xffff0000u)); lo.y = pk2(v0.z - __builtin_bit_cast(float, hi.y << 16), v0.w - __builtin_bit_cast(float, hi.y & 0xffff0000u));
            lo.z = pk2(v1.x - __builtin_bit_cast(float, hi.z << 16), v1.y - __builtin_bit_cast(float, hi.z & 0xffff0000u)); lo.w = pk2(v1.z - __builtin_bit_cast(float, hi.w << 16), v1.w - __builtin_bit_cast(float, hi.w & 0xffff0000u));
            const bf16x8 ah = __builtin_bit_cast(bf16x8, hi), al = __builtin_bit_cast(bf16x8, lo), bh = __builtin_bit_cast(bf16x8, wh[s_]), bl = __builtin_bit_cast(bf16x8, wl[s_]);
            acc = __builtin_amdgcn_mfma_f32_16x16x32_bf16(ah, bh, acc, 0, 0, 0); acc = __builtin_amdgcn_mfma_f32_16x16x32_bf16(al, bh, acc, 0, 0, 0); acc = __builtin_amdgcn_mfma_f32_16x16x32_bf16(ah, bl, acc, 0, 0, 0); }
#pragma unroll
        for (int r = 0; r < 4; ++r) pacc[(wave * 4 + r) * 64 + lane] = acc[r];
        __syncthreads();
        if (wave < 4) {
            const int row = lane >> 2, hd = 4 * wave + (lane & 3); float z = 0.f, ssr = 0.f;
#pragma unroll
            for (int w2 = 0; w2 < NWAVES; ++w2) { z += pacc[(w2 * 4 + (row & 3)) * 64 + (row >> 2) * 16 + hd]; ssr += xp[(w2 * 16 + row) * 2]; }
            z = z * rsqrtf(ssr * (1.f / D) + RMS_EPS) + bbh;
            float lf = fminf(z, 0.f) - log1pf(expf(-fabsf(z)));
            (is_x ? (float*)(ws + WS_LOGF) + (size_t)grp * 256 : (float*)(ws + WS_LOGFM))[row * 16 + hd] = lf;
            lf += __shfl_xor(lf, 4); lf += __shfl_xor(lf, 8); lf += __shfl_xor(lf, 16); lf += __shfl_xor(lf, 32);
            if (is_x && lane < 4) ((float*)(ws + WS_GSUM))[grp * 16 + hd] = lf;
        } else if (wave == 4 && fq == 0) {
            ((float*)(ws + WS_RSX) + (is_x ? grp * 16 : M))[fr] = rsqrtf(sst * (1.f / D) + RMS_EPS) * amt * (1.f / 127.f);
        }
#pragma unroll
        for (int s_ = 0; s_ < 4; ++s_) { h[s_][0] = hn[s_][0]; h[s_][1] = hn[s_][1]; }
    }
    __syncthreads();
}

constexpr int I_SQ = 16 * 32, N_ITEMS = 3 * I_SQ, N_STRIPS = NE * 64, N_STRIPS_IN = 224, N_STRIPS_DN = NE * 32;
__device__ __forceinline__ P0Item p0_item(const KA& A, unsigned char* ws, int it) {
    int r = it;
    if (r < 3 * I_SQ) { const int w = r / I_SQ, rr = r % I_SQ, kb = rr / 32, nb = rr % 32; const float* src = w == 0 ? A.in(9) : w == 1 ? A.in(10) : A.in(11); bf16_t* dst = (bf16_t*)(ws + (w == 0 ? WS_WCO_T : w == 1 ? WS_WAO_T : WS_WMIX_T));
        return P0Item{src + (size_t)(64 * kb) * D + 32 * nb, (size_t)D, dst + (size_t)(32 * nb) * D + 64 * kb}; }
    return P0Item{nullptr, 0, nullptr};
}
struct P0Strip { const float* W0; size_t ldw; unsigned char* Wq; float* SB; };
__device__ __forceinline__ void p0_strip_load(const P0Strip& st, int wave, int lane, f32x4 (&r0)[8], f32x4 (&r1)[8]) {
    const P0Item i0{st.W0 + (size_t)(64 * (2 * wave)) * st.ldw, st.ldw, nullptr}, i1{st.W0 + (size_t)(64 * (2 * wave + 1)) * st.ldw, st.ldw, nullptr}; p0_item_load(i0, lane, r0); p0_item_load(i1, lane, r1);
}
__device__ __forceinline__ void p0_strip_finish(const P0Strip& st, LAS unsigned char* ring, int wave, int lane, int parity, const f32x4 (&r0)[8], const f32x4 (&r1)[8]) {
    LAS float* scr = (LAS float*)(ring + wave * 16384);
    f32x4 mx = {0.f, 0.f, 0.f, 0.f};
#pragma unroll
    for (int i = 0; i < 8; ++i) mx = __builtin_elementwise_max(mx, __builtin_elementwise_max(__builtin_elementwise_abs(r0[i]), __builtin_elementwise_abs(r1[i])));
#pragma unroll
    for (int o = 8; o < 64; o <<= 1) { f32x4 t; t.x = __shfl_xor(mx.x, o); t.y = __shfl_xor(mx.y, o); t.z = __shfl_xor(mx.z, o); t.w = __shfl_xor(mx.w, o); mx = __builtin_elementwise_max(mx, t); }
    const int c = lane & 7, xoff = 8448 + 64 + parity * 128;
    if (lane < 8) *(LAS f32x4*)(ring + wave * 16384 + xoff + 16 * lane) = mx;
    __syncthreads();
#pragma unroll
    for (int w2 = 0; w2 < NWAVES; ++w2) mx = __builtin_elementwise_max(mx, *(const LAS f32x4*)(ring + w2 * 16384 + xoff + 16 * c));
    f32x4 inv; inv.x = mx.x > 0.f ? 127.f / mx.x : 0.f; inv.y = mx.y > 0.f ? 127.f / mx.y : 0.f; inv.z = mx.z > 0.f ? 127.f / mx.z : 0.f; inv.w = mx.w > 0.f ? 127.f / mx.w : 0.f;
    if (wave == 0 && lane < 8) *(f32x4*)(st.SB + 4 * lane) = mx * (1.f / 127.f);
#pragma unroll
    for (int half = 0; half < 2; ++half) { const int kb = 2 * wave + half;
#pragma unroll
        for (int i = 0; i < 8; ++i) { const f32x4 q = (half ? r1[i] : r0[i]) * inv; LAS float* d = scr + (8 * i + (lane >> 3)) * 33 + 4 * c; d[0] = q.x; d[1] = q.y; d[2] = q.z; d[3] = q.w; }
        LDS_WAIT(); asm volatile("" ::: "memory");
#pragma unroll
        for (int j = 0; j < 4; ++j) { const int n = (lane >> 3) + 8 * j; const LAS float* sp = scr + (8 * c) * 33 + n;
            u32x2 o; o.x = pk4_i8(sp[0 * 33], sp[1 * 33], sp[2 * 33], sp[3 * 33]); o.y = pk4_i8(sp[4 * 33], sp[5 * 33], sp[6 * 33], sp[7 * 33]);
            *(GAS u32x2*)(st.Wq + (size_t)n * 1024 + 64 * kb + 8 * c) = o; }
        LDS_WAIT(); asm volatile("" ::: "memory");
    }
}
__device__ __forceinline__ bool p0_strip_desc(const KA& A, unsigned char* ws, int vcu, int G, int s, P0Strip& st) {
    const int n_in = (vcu < N_STRIPS_IN) ? (N_STRIPS_IN - vcu + G - 1) / G : 0, n_gu = (vcu < N_STRIPS) ? (N_STRIPS - vcu + G - 1) / G : 0;
    if (s < n_in) { const int drow = 32 * (vcu + s * G), scol = drow < 2048 ? glu_src_col(drow) : (drow < 5120 ? drow : drow + 16);
        st = P0Strip{A.in(3) + scol, (size_t)IN_COLS, ws + WS_WIN_T + (size_t)drow * 1024, (float*)(ws + WS_SBIN) + drow}; return true; }
    s -= n_in;
    if (s < n_gu) { const int gi = (N_STRIPS % (8 * G) == 0) ? ((s >> 3) * G + vcu) * 8 + (s & 7) : vcu + s * G, e = gi >> 6, drow = 32 * (gi & 63);
        st = P0Strip{A.in(15) + (size_t)e * D * 2048 + glu_src_col(drow), (size_t)2048, ws + WS_WGU_T + ((size_t)e * 2048 + drow) * 1024, (float*)(ws + WS_SBGU) + e * 2048 + drow}; return true; }
    s -= n_gu;
    const int gi = (N_STRIPS_DN % (4 * G) == 0) ? ((s >> 2) * G + vcu) * 4 + (s & 3) : vcu + s * G; if (gi >= N_STRIPS_DN) return false;
    const int e = gi >> 5, drow = 32 * (gi & 31);
    st = P0Strip{A.in(17) + (size_t)e * D * D + drow, (size_t)D, ws + WS_WDN_T + ((size_t)e * 1024 + drow) * 1024, (float*)(ws + WS_SBDN) + e * 1024 + drow}; return true;
}
__device__ __forceinline__ void p0_prologue(Frame& F, const KA& A) {
    unsigned char* ws = A.ws();
    LAS float* scr = (LAS float*)(F.lds + RING_OFF + F.wave * 16384);
    const int gw = F.vcu * NWAVES + F.wave, NGW = F.G * NWAVES;
    {
        int it = gw; f32x4 r[8]; P0Item cur{nullptr, 0, nullptr};
        if (it < N_ITEMS) { cur = p0_item(A, ws, it); p0_item_load(cur, F.lane, r); }
        while (it < N_ITEMS) {
            const int nx = it + NGW; f32x4 rn[8]; P0Item nxt{nullptr, 0, nullptr};
            if (nx < N_ITEMS) { nxt = p0_item(A, ws, nx); p0_item_load(nxt, F.lane, rn); }
            p0_item_store(cur, D, scr, F.lane, r);
#pragma unroll
            for (int i = 0; i < 8; ++i) r[i] = rn[i];
            cur = nxt; it = nx;
        }
    }
    {
        P0Strip cur{nullptr, 0, nullptr, nullptr}, nxt{nullptr, 0, nullptr, nullptr}; f32x4 r0[8], r1[8];
        bool have = p0_strip_desc(A, ws, F.vcu, F.G, 0, cur);
        if (have) p0_strip_load(cur, F.wave, F.lane, r0, r1);
        for (int si = 0; have; ++si) {
#pragma unroll
            for (int i = 0; i < 8; ++i) asm volatile("" : "+v"(r0[i]), "+v"(r1[i]));
            f32x4 n0[8], n1[8];
            const bool hn = p0_strip_desc(A, ws, F.vcu, F.G, si + 1, nxt);
            if (hn) p0_strip_load(nxt, F.wave, F.lane, n0, n1);
            p0_strip_finish(cur, F.lds + RING_OFF, F.wave, F.lane, si & 1, r0, r1);
#pragma unroll
            for (int i = 0; i < 8; ++i) { r0[i] = n0[i]; r1[i] = n1[i]; }
            cur = nxt; have = hn;
        }
        __syncthreads();
    }
    p0_rows_wg(F, A, ws);
    for (int i = gw * 64 + F.lane; i < NE * D; i += NGW * 64) {
        const int e = i / D, k = i % D; const float w = A.in(13)[(size_t)k * NE + e]; const unsigned hi = f2bf(w);
        ((bf16_t*)(ws + WS_WR_T))[i] = (bf16_t)hi; ((bf16_t*)(ws + WS_WR_T))[NE * D + i] = (bf16_t)f2bf(w - __builtin_bit_cast(float, hi << 16));
    }
    for (int r = gw; r < 2 * NB * 48; r += NGW) {
        const int kv = r / (NB * 48), rr = r % (NB * 48), b = rr / 48, row = 16 + rr % 48;
        bf16_t* p = (bf16_t*)(ws + (kv ? WS_V : WS_K)) + ((size_t)b * KVROWS + row) * D + 16 * F.lane;
        const v4u z = {0u, 0u, 0u, 0u}; *(GAS v4u*)p = z; *(GAS v4u*)(p + 8) = z;
    }
}

__device__ __forceinline__ void p1_scan(Frame& F, const KA& A) {
    if (F.vcu >= NB * 64) return;
    const int b = F.vcu >> 6, seg = F.vcu & 63, t = F.tid, head = t & 15, pc = t >> 4;
    const float* LOGF = (const float*)(A.ws() + WS_LOGF); const float* LOGFm = (const float*)(A.ws() + WS_LOGFM); const float* GSUM = (const float*)(A.ws() + WS_GSUM);
    float* outb = (float*)(A.ws() + WS_BIAS) + (size_t)(b * NH + head) * KVROWS;
    LAS float* part = (LAS float*)(F.lds + RING_OFF);
    const float* src = LOGF + ((size_t)b * SEQ + seg * 128 + 4 * pc) * 16 + head;
    const float v0 = src[0], v1 = src[16], v2 = src[32], v3 = src[48];
    float pre = 0.f;
    { float gq[16];
#pragma unroll
      for (int i = 0; i < 16; ++i) { const int j = pc + 32 * i; gq[i] = j < seg * 8 ? GSUM[(size_t)(b * (SEQ / 16) + j) * 16 + head] : 0.f; }
#pragma unroll
      for (int i = 0; i < 16; ++i) pre += gq[i]; }
    float cm = 0.f;
    { float mq[NMETA];
#pragma unroll
      for (int j = 0; j < NMETA; ++j) mq[j] = LOGFm[j * 16 + head];
#pragma unroll
      for (int j = 0; j < NMETA; ++j) { cm += mq[j]; if (seg == 0 && pc == 0) outb[j] = -cm * LOG2E; } }
    if (seg == 0) for (int idx = t; idx < NH * 48; idx += NWAVES * 64) ((float*)(A.ws() + WS_BIAS) + (size_t)(b * NH + idx / 48) * KVROWS)[16 + idx % 48] = NEG_BIG;
    pre += __shfl_xor(pre, 16); pre += __shfl_xor(pre, 32);
    const float c0 = v0, c1 = c0 + v1, c2 = c1 + v2, c3 = c2 + v3;
    part[pc * 16 + head] = c3; if (F.lane < 16) part[512 + F.wave * 16 + head] = pre;
    __syncthreads();
    float base = cm;
#pragma unroll
    for (int w = 0; w < NWAVES; ++w) base += part[512 + w * 16 + head];
    for (int c = 0; c < pc; ++c) base += part[c * 16 + head];
    { f32x4 o; o.x = -(base + c0) * LOG2E; o.y = -(base + c1) * LOG2E; o.z = -(base + c2) * LOG2E; o.w = -(base + c3) * LOG2E; *(f32x4*)(outb + 64 + seg * 128 + 4 * pc) = o; }
    __syncthreads();
}
__device__ __forceinline__ void p1_meta(Frame& F, const KA& A) {
    if (F.vcu >= 192) return;
    const int lane = F.lane, fr = lane & 15, fq = lane >> 4;
    const unsigned char* XNm = A.ws() + WS_XNM; const unsigned char* Wq = A.ws() + WS_WIN_T; const float* b_in = A.in(4); const float* SB = (const float*)(A.ws() + WS_SBIN);
    const int kind = F.vcu >> 6, c = F.vcu & 63;
    const int ch0 = 16 * c;
    const int rowA = kind == 0 ? 256 * (ch0 >> 7) + (ch0 & 127) : (kind == 1 ? OFF_K : OFF_V) + ch0;
    const unsigned char* ap = XNm + (size_t)fr * D + 16 * fq; const unsigned char* bp = Wq + (size_t)(rowA + fr) * D + 16 * fq;
    pg8::i32x4 acc0 = {0, 0, 0, 0}, acc1 = {0, 0, 0, 0};
#pragma unroll
    for (int k0 = 0; k0 < D; k0 += 64) {
        const pg8::i32x4 af = *(const pg8::i32x4*)(ap + k0), bf = *(const pg8::i32x4*)(bp + k0);
        acc0 = __builtin_amdgcn_mfma_i32_16x16x64_i8(af, bf, acc0, 0, 0, 0);
        if (kind == 0) { const pg8::i32x4 bg = *(const pg8::i32x4*)(bp + (size_t)128 * D + k0); acc1 = __builtin_amdgcn_mfma_i32_16x16x64_i8(af, bg, acc1, 0, 0, 0); }
    }
    const int ch = ch0 + fr;
    const float* rsx = (const float*)(A.ws() + WS_RSX) + M + 4 * fq;
    const float s0 = SB[rowA + fr], s1 = kind == 0 ? SB[rowA + 128 + fr] : 0.f;
    float v0[4], v1[4];
#pragma unroll
    for (int r = 0; r < 4; ++r) { v0[r] = (float)acc0[r] * (rsx[r] * s0); v1[r] = (float)acc1[r] * (rsx[r] * s1); }
    if (kind == 0) {
        bf16_t* GLUm = (bf16_t*)(A.ws() + WS_GLUM); const float ba = b_in[ch], bb = b_in[1024 + ch];
#pragma unroll
        for (int r = 0; r < 4; ++r) { const float z1 = v0[r] + ba, z2 = v1[r] + bb; GLUm[(size_t)(4 * fq + r) * D + ch] = (bf16_t)f2bf(z1 * (1.f / (1.f + __expf(-z2)))); }
    } else {
        bf16_t* dst = (bf16_t*)(A.ws() + (kind == 1 ? WS_K : WS_V)); const float bb = b_in[(kind == 1 ? OFF_K : OFF_V) + ch];
#pragma unroll
        for (int r = 0; r < 4; ++r) { const bf16_t o = (bf16_t)f2bf(v0[r] + bb);
            if (kind == 1) { float ss = bf2f(o) * bf2f(o);
                ss += __shfl_xor(ss, 1); ss += __shfl_xor(ss, 2); ss += __shfl_xor(ss, 4); ss += __shfl_xor(ss, 8);
                if (fr == 0) ((float*)(A.ws() + WS_KNM))[((4 * fq + r) * NH + (c >> 2)) * 4 + (c & 3)] = ss; }
#pragma unroll
            for (int b2 = 0; b2 < NB; ++b2) dst[((size_t)b2 * KVROWS + 4 * fq + r) * D + ch] = o; }
    }
}

typedef float f32x2_ __attribute__((ext_vector_type(2)));
__device__ __forceinline__ f32x2_ bfpair(unsigned u) { f32x2_ r; r.x = __builtin_bit_cast(float, u << 16); r.y = __builtin_bit_cast(float, u & 0xffff0000u); return r; }
__device__ __forceinline__ float wave_sum16(float (&v)[16], int lane) {
    const bool b5 = lane & 32, b4 = lane & 16, b3 = lane & 8, b2 = lane & 4;
    float a[8];
#pragma unroll
    for (int i = 0; i < 8; ++i) { const float keep = b5 ? v[i + 8] : v[i], give = b5 ? v[i] : v[i + 8]; a[i] = keep + __shfl_xor(give, 32); }
    float c[4];
#pragma unroll
    for (int i = 0; i < 4; ++i) { const float keep = b4 ? a[i + 4] : a[i], give = b4 ? a[i] : a[i + 4]; c[i] = keep + __shfl_xor(give, 16); }
    float d[2];
#pragma unroll
    for (int i = 0; i < 2; ++i) { const float keep = b3 ? c[i + 2] : c[i], give = b3 ? c[i] : c[i + 2]; d[i] = keep + __shfl_xor(give, 8); }
    float e = (b2 ? d[1] : d[0]) + __shfl_xor(b2 ? d[0] : d[1], 4);
    e += __shfl_xor(e, 1); e += __shfl_xor(e, 2);
    return e;
}
__device__ __forceinline__ void p2_conv(Frame& F, const KA& A) {
    const int tid = launder((int)threadIdx.x), c0 = 2 * tid, lane = tid & 63, wave = __builtin_amdgcn_readfirstlane(tid >> 6);
    const bf16_t* GLU = (const bf16_t*)(A.ws() + WS_GLU); const bf16_t* GLUm = (const bf16_t*)(A.ws() + WS_GLUM); bf16_t* U = (bf16_t*)(A.ws() + WS_U);
    LAS float* red = (LAS float*)(F.lds + RING_OFF);
    f32x2_ cw[CONVW];
#pragma unroll
    for (int j = 0; j < CONVW; ++j) cw[j] = *(const f32x2_*)(A.in(5) + (size_t)j * D + c0);
    const f32x2_ cb = *(const f32x2_*)(A.in(6) + c0), lg = *(const f32x2_*)(A.in(7) + c0), lb = *(const f32x2_*)(A.in(8) + c0);
    for (int chunk = F.vcu; chunk < M / 128; chunk += F.G) {
        const int m0 = chunk * 128, b = m0 / SEQ, i0 = m0 % SEQ;
        const bf16_t* src = GLU + (size_t)m0 * D + c0; bf16_t* dst = U + (size_t)m0 * D + c0;
        unsigned raw[8];
#pragma unroll
        for (int q = 0; q < 8; ++q) raw[q] = *(const unsigned*)(src + (size_t)q * D);
        f32x2_ win[32];
#pragma unroll
        for (int s = 0; s < 32; ++s) {
            const int pp = NMETA + i0 - 32 + s;
            unsigned rw = 0u;
            if (pp >= NMETA) rw = *(const unsigned*)(GLU + ((size_t)b * SEQ + (pp - NMETA)) * D + c0);
            else if (pp >= 0) rw = *(const unsigned*)(GLUm + (size_t)pp * D + c0);
            win[s] = bfpair(rw);
        }
#pragma unroll 1
        for (int blk = 0; blk < 4; ++blk) {
#pragma unroll
            for (int s8 = 0; s8 < 4; ++s8) {
                unsigned cur[8];
#pragma unroll
                for (int q = 0; q < 8; ++q) cur[q] = raw[q];
                { const int nrow = 32 * blk + 8 * s8 + 8;
                  const bf16_t* ns = src + (size_t)(nrow < 128 ? nrow : 120) * D;
#pragma unroll
                  for (int q = 0; q < 8; ++q) raw[q] = __builtin_nontemporal_load((const unsigned*)(ns + (size_t)q * D)); }
                f32x2_ o[8]; float st[16];
#pragma unroll
                for (int q = 0; q < 8; ++q) { const int s = 8 * s8 + q; win[s] = bfpair(cur[q]);
                    f32x2_ acc = cb;
#pragma unroll
                    for (int j = 0; j < CONVW; ++j) acc = win[(s + 2 + j) & 31] * cw[j] + acc;
                    o[q] = acc; st[2 * q] = acc.x + acc.y; st[2 * q + 1] = acc.x * acc.x + acc.y * acc.y; }
                const float tot = wave_sum16(st, lane);
                LAS float* rp = red + (s8 & 1) * 128;
                if ((lane & 3) == 0) rp[wave * 16 + (lane >> 2)] = tot;
                __syncthreads();
                float tsum = 0.f;
#pragma unroll
                for (int w = 0; w < NWAVES; ++w) tsum += rp[w * 16 + ((lane >> 2) & 15)];
                bf16_t* dg = dst + (size_t)(32 * blk + 8 * s8) * D;
#pragma unroll
                for (int q = 0; q < 8; ++q) {
                    const float s1_ = __builtin_bit_cast(float, __builtin_amdgcn_readlane(__builtin_bit_cast(int, tsum), 8 * q)), s2_ = __builtin_bit_cast(float, __builtin_amdgcn_readlane(__builtin_bit_cast(int, tsum), 8 * q + 4));
                    const float mean = s1_ * (1.f / D), var = s2_ * (1.f / D) - mean * mean, rstd = rsqrtf(fmaxf(var, 0.f) + LN_EPS);
                    f32x2_ y = ((o[q] - mean) * rstd) * lg + lb;
                    y.x = y.x * __builtin_amdgcn_rcpf(1.f + __expf(-y.x)); y.y = y.y * __builtin_amdgcn_rcpf(1.f + __expf(-y.y));
                    *(unsigned*)(dg + (size_t)q * D) = pk2(y.x, y.y);
                }
            }
        }
    }
    __syncthreads();
}
__device__ __forceinline__ void p5_router(Frame& F, const KA& A) {
    const int tid = launder((int)threadIdx.x), lane = tid & 63, wave = __builtin_amdgcn_readfirstlane(tid >> 6), fr = lane & 15, fq = lane >> 4;
    const bf16_t* H = (const bf16_t*)(A.ws() + WS_H); unsigned char* HN = A.ws() + WS_GLU;
    float* TOPG = (float*)(A.ws() + WS_TOPG); float* RSTD = (float*)(A.ws() + WS_RSTD); int* lists = (int*)(A.ws() + WS_LISTS); int* cnt = (int*)(A.ws() + WS_CTL) + CW_CNT;
    const bf16_t* Wh = (const bf16_t*)(A.ws() + WS_WR_T); const bf16_t* Wl = Wh + NE * D;
    const float* g = A.in(12); const float* rb = A.in(14);
    LAS int* lcnt = (LAS int*)(F.lds + RING_OFF);
    LAS int* lbase = lcnt + 32; LAS int* ent = lcnt + 64; LAS int* lslot = ent + 512;
    LAS float* erst = (LAS float*)(lslot + 512); LAS float* egt = erst + 512;
    LAS float* lg = egt + 512 + wave * (16 * 33 + 32); LAS float* lr = lg + 16 * 33; LAS float* lq = lr + 16;
    float* LRS = (float*)(A.ws() + WS_LRS); float* LGT = (float*)(A.ws() + WS_LGT);
    const int c0 = wave * 128 + 8 * fq;
    LAS float* xs = (LAS float*)(F.lds + RING_OFF + 32768);
    LAS float* pacc = (LAS float*)(F.lds + RING_OFF + 36864);
    LAS float* lgall = egt + 512;
    f32x4 gv[4][2]; bf16x8 wh0[4], wh1[4], wl0[4], wl1[4];
#pragma unroll
    for (int s_ = 0; s_ < 4; ++s_) { gv[s_][0] = *(const f32x4*)(g + c0 + 32 * s_); gv[s_][1] = *(const f32x4*)(g + c0 + 32 * s_ + 4);
        const bf16_t* whp = Wh + (size_t)fr * D + c0 + 32 * s_; const bf16_t* wlp = Wl + (size_t)fr * D + c0 + 32 * s_;
        wh0[s_] = *(const bf16x8*)whp; wh1[s_] = *(const bf16x8*)(whp + (size_t)16 * D); wl0[s_] = *(const bf16x8*)wlp; wl1[s_] = *(const bf16x8*)(wlp + (size_t)16 * D); }
    for (int chunk = F.vcu; chunk < M / 128; chunk += F.G) {
        if (tid < 32) lcnt[tid] = 0;
        const bf16_t* hp = H + (size_t)(chunk * 128 + fr) * D + c0; unsigned char* hnp = HN + (size_t)(chunk * 128 + fr) * D + c0;
        u32x4 h0r[4], h1r[4];
#pragma unroll
        for (int s_ = 0; s_ < 4; ++s_) { h0r[s_] = *(const u32x4*)(hp + 32 * s_); h1r[s_] = *(const u32x4*)(hp + (size_t)16 * D + 32 * s_); }
        for (int gi = 0; gi < 8; ++gi) {
#pragma unroll
            for (int s_ = 0; s_ < 4; ++s_) asm volatile("" : "+v"(h0r[s_]));
            u32x4 h2r[4];
            if (gi < 6) {
#pragma unroll
                for (int s_ = 0; s_ < 4; ++s_) h2r[s_] = *(const u32x4*)(hp + (size_t)(gi + 2) * 16 * D + 32 * s_); }
            float ss = 0.f, amax = 0.f; f32x4 v[4][2];
#pragma unroll
            for (int s_ = 0; s_ < 4; ++s_) { f32x4 x0, x1; pg8::unpack8(h0r[s_], x0, x1);
                ss += (x0.x * x0.x + x0.y * x0.y) + (x0.z * x0.z + x0.w * x0.w) + (x1.x * x1.x + x1.y * x1.y) + (x1.z * x1.z + x1.w * x1.w);
                v[s_][0] = x0 * gv[s_][0]; v[s_][1] = x1 * gv[s_][1];
                const f32x4 a0 = __builtin_elementwise_abs(v[s_][0]), a1 = __builtin_elementwise_abs(v[s_][1]);
                amax = fmaxf(amax, fmaxf(fmaxf(fmaxf(a0.x, a0.y), fmaxf(a0.z, a0.w)), fmaxf(fmaxf(a1.x, a1.y), fmaxf(a1.z, a1.w)))); }
            ss += __shfl_xor(ss, 16); ss += __shfl_xor(ss, 32);
            amax = fmaxf(amax, __shfl_xor(amax, 16)); amax = fmaxf(amax, __shfl_xor(amax, 32));
            LAS float* xp = xs + (gi & 1) * 256;
            if (fq == 0) { xp[(wave * 16 + fr) * 2] = ss; xp[(wave * 16 + fr) * 2 + 1] = amax; }
            __syncthreads();
            float sst = 0.f, amt = 0.f;
#pragma unroll
            for (int w2 = 0; w2 < NWAVES; ++w2) { sst += xp[(w2 * 16 + fr) * 2]; amt = fmaxf(amt, xp[(w2 * 16 + fr) * 2 + 1]); }
            const float qinv = amt > 0.f ? 127.f / amt : 0.f;
            pg8::f32x4 acc0 = {0.f, 0.f, 0.f, 0.f}, acc1 = {0.f, 0.f, 0.f, 0.f};
#pragma unroll
            for (int s_ = 0; s_ < 4; ++s_) { const f32x4 v0 = v[s_][0], v1 = v[s_][1];
                u32x4 hi; hi.x = pk2(v0.x, v0.y); hi.y = pk2(v0.z, v0.w); hi.z = pk2(v1.x, v1.y); hi.w = pk2(v1.z, v1.w);
                { const f32x4 q0 = v0 * qinv, q1 = v1 * qinv; u32x2 q8; q8.x = pk4_i8(q0.x, q0.y, q0.z, q0.w); q8.y = pk4_i8(q1.x, q1.y, q1.z, q1.w); *(u32x2*)(hnp + (size_t)gi * 16 * D + 32 * s_) = q8; }
                u32x4 lo;
                lo.x = pk2(v0.x - __builtin_bit_cast(float, hi.x << 16), v0.y - __builtin_bit_cast(float, hi.x & 0xffff0000u)); lo.y = pk2(v0.z - __builtin_bit_cast(float, hi.y << 16), v0.w - __builtin_bit_cast(float, hi.y & 0xffff0000u));
                lo.z = pk2(v1.x - __builtin_bit_cast(float, hi.z << 16), v1.y - __builtin_bit_cast(float, hi.z & 0xffff0000u)); lo.w = pk2(v1.z - __builtin_bit_cast(float, hi.w << 16), v1.w - __builtin_bit_cast(float, hi.w & 0xffff0000u));
                const bf16x8 ah = __builtin_bit_cast(bf16x8, hi), al = __builtin_bit_cast(bf16x8, lo);
                acc0 = __builtin_amdgcn_mfma_f32_16x16x32_bf16(ah, wh0[s_], acc0, 0, 0, 0); acc1 = __builtin_amdgcn_mfma_f32_16x16x32_bf16(ah, wh1[s_], acc1, 0, 0, 0);
                acc0 = __builtin_amdgcn_mfma_f32_16x16x32_bf16(al, wh0[s_], acc0, 0, 0, 0); acc1 = __builtin_amdgcn_mfma_f32_16x16x32_bf16(al, wh1[s_], acc1, 0, 0, 0);
                acc0 = __builtin_amdgcn_mfma_f32_16x16x32_bf16(ah, wl0[s_], acc0, 0, 0, 0); acc1 = __builtin_amdgcn_mfma_f32_16x16x32_bf16(ah, wl1[s_], acc1, 0, 0, 0); }
#pragma unroll
            for (int r = 0; r < 4; ++r) { pacc[(wave * 8 + r) * 64 + lane] = acc0[r]; pacc[(wave * 8 + 4 + r) * 64 + lane] = acc1[r]; }
            __syncthreads();
            {
                float z = 0.f;
#pragma unroll
                for (int w2 = 0; w2 < NWAVES; ++w2) z += pacc[(w2 * 8 + wave) * 64 + lane];
                LAS float* lgg = lgall + gi * (16 * 33 + 32);
                lgg[(4 * fq + (wave & 3)) * 33 + 16 * (wave >> 2) + fr] = z;
                if (wave == 0 && fq == 0) { const float rstd_ = rsqrtf(sst * (1.f / D) + RMS_EPS); lgg[16 * 33 + fr] = rstd_; lgg[16 * 33 + 16 + fr] = rstd_ * amt * (1.f / 127.f); }
            }
#pragma unroll
            for (int s_ = 0; s_ < 4; ++s_) { h0r[s_] = h1r[s_]; h1r[s_] = h2r[s_]; }
        }
        __syncthreads();
        const int m0 = chunk * 128 + wave * 16;
        if (lane < 16) {
            const int m = m0 + lane; const float rstd = lr[lane], rsa = lq[lane];
            float lv[32];
#pragma unroll
            for (int e = 0; e < 32; ++e) lv[e] = lg[lane * 33 + e] * rstd + rb[e];
            int bi[4]; float bv[4];
#pragma unroll
            for (int k = 0; k < 4; ++k) {
                float best = -INFINITY; int idx = 0;
#pragma unroll
                for (int e = 0; e < 32; ++e) if (lv[e] > best) { best = lv[e]; idx = e; }
#pragma unroll
                for (int e = 0; e < 32; ++e) if (e == idx) lv[e] = -INFINITY;
                bi[k] = idx; bv[k] = best;
            }
            const float e1 = __expf(bv[1] - bv[0]), e2 = __expf(bv[2] - bv[0]), e3 = __expf(bv[3] - bv[0]), inv = 1.f / (1.f + e1 + e2 + e3);
            RSTD[m] = rstd;
            *(f32x4*)(TOPG + (size_t)m * 4) = (f32x4){inv, e1 * inv, e2 * inv, e3 * inv};
#pragma unroll
            for (int k = 0; k < 4; ++k) { const int li = (wave * 16 + lane) * 4 + k;
                lslot[li] = __hip_atomic_fetch_add(lcnt + bi[k], 1, __ATOMIC_RELAXED, __HIP_MEMORY_SCOPE_WORKGROUP);
                ent[li] = ((m * 4 + k) << 5) | bi[k]; erst[li] = rsa; egt[li] = (k == 0 ? 1.f : k == 1 ? e1 : k == 2 ? e2 : e3) * inv; }
        }
        __syncthreads();
        if (tid < 32) lbase[tid] = __hip_atomic_fetch_add(cnt + tid, lcnt[tid], __ATOMIC_RELAXED, __HIP_MEMORY_SCOPE_AGENT);
        __syncthreads();
        { const int en = ent[tid], e = en & 31; const size_t sl = (size_t)e * M + lbase[e] + lslot[tid]; lists[sl] = en >> 5; LRS[sl] = erst[tid]; LGT[sl] = egt[tid]; }
        __syncthreads();
    }
}
constexpr int MOE_TAB_OFF = LDSCTL_OFF + 1024, MOE_PARK_OFF = LDSCTL_OFF + 2048, MOE_XM_OFF = LDSCTL_OFF + 10240  , MOE_SPARK_OFF = LDSCTL_OFF + 16384  ;
__device__ __forceinline__ void moe_table(Frame& F, const KA& A) {
    LAS int* tab = (LAS int*)(F.lds + MOE_TAB_OFF);
    if (tid_of(F.wave) == 0) {
        const int* cnt = (const int*)(A.ws() + WS_CTL) + CW_CNT; int tp = 0, bp = 0;
        for (int e = 0; e < NE; ++e) { const int c = cnt[e]; tab[e] = tp; tab[33 + e] = c; tab[65 + e] = bp; tp += (c + 255) >> 8; bp += c; }
        tab[32] = tp;
    }
    __syncthreads();
}
__device__ __forceinline__ void p8_final(Frame& F, const KA& A) {
    const int wave = F.wave, tid = tid_of(wave), lane = tid & 63;
    const bf16_t* H = (const bf16_t*)(A.ws() + WS_H); const bf16_t* Y = (const bf16_t*)(A.ws() + WS_Y); const float* g = A.in(19); float* out = A.out();
    for (int m = F.vcu * NWAVES + wave; m < M; m += F.G * NWAVES) {
        f32x4 v[4]; float ss = 0.f;
#pragma unroll
        for (int j = 0; j < 4; ++j) {
            { const u32x2 hh = __builtin_nontemporal_load((const u32x2*)(H + (size_t)m * D + 4 * lane + 256 * j)); v[j] = (f32x4){__builtin_bit_cast(float, hh.x << 16), __builtin_bit_cast(float, hh.x & 0xffff0000u), __builtin_bit_cast(float, hh.y << 16), __builtin_bit_cast(float, hh.y & 0xffff0000u)}; }
#pragma unroll
            for (int k = 0; k < 4; ++k) { const u32x2 y = __builtin_nontemporal_load((const u32x2*)(Y + ((size_t)m * 4 + k) * D + 4 * lane + 256 * j));
                v[j].x += __builtin_bit_cast(float, y.x << 16); v[j].y += __builtin_bit_cast(float, y.x & 0xffff0000u); v[j].z += __builtin_bit_cast(float, y.y << 16); v[j].w += __builtin_bit_cast(float, y.y & 0xffff0000u); }
            ss += (v[j].x * v[j].x + v[j].y * v[j].y) + (v[j].z * v[j].z + v[j].w * v[j].w);
        }
        ss = wave_sum(ss);
        const float rstd = rsqrtf(ss * (1.f / D) + RMS_EPS);
#pragma unroll
        for (int j = 0; j < 4; ++j) { const f32x4 gv = *(const f32x4*)(g + 4 * lane + 256 * j); __builtin_nontemporal_store((v[j] * rstd) * gv, (f32x4*)(out + (size_t)m * D + 4 * lane + 256 * j)); }
    }
}
constexpr int N_MEGA_PHASES = 9;
__global__ void __launch_bounds__(NWAVES * 64, 2) mega_fwd(Args args) {
    extern __shared__ __attribute__((aligned(16))) unsigned char lds[];
    Frame F;
    F.lds = (LAS unsigned char*)lds;
    F.MISC = (volatile LAS unsigned*)(F.lds + MISC_OFF);
    F.tid = threadIdx.x; F.lane = F.tid & 63; F.wave = __builtin_amdgcn_readfirstlane(F.tid >> 6);
    F.G = gridDim.x; { const int bx = blockIdx.x; F.vcu = (F.G % 8 == 0) ? (bx % 8) * (F.G / 8) + bx / 8 : bx; }
    { const KA A0 = kargs(); F.ctl = (gu32*)(A0.ws() + WS_CTL); }
    for (int u = F.tid; u < (LDS_BYTES - LDSCTL_OFF) / 4; u += NWAVES * 64) ((LAS unsigned*)(F.lds + LDSCTL_OFF))[u] = 0u;
    __syncthreads();
    XcdBarrier bar = xcd_barrier_post((unsigned*)(F.ctl + CW_BAR), F.MISC + 8);
    const int lo = args.ph_lo, hi = args.ph_hi;
#define IN(k) (lo <= (k) && (k) < hi)
#define BOTH(k) (IN(k) && IN((k) + 1))

    if (IN(0)) { const KA A = kargs(); p0_prologue(F, A); if (BOTH(0)) xcd_barrier(bar); }

    if (IN(1)) { const KA A = kargs(); unsigned char* const ws = A.ws();
        p1_scan(F, A);
        if (F.wave == 0) p1_meta(F, A);
        pg8::Gemm g{(const bf16_t*)(ws + WS_XN), (const bf16_t*)(ws + WS_WIN_T), M, 7168, D / 2}; pg8::StaticOrder S; S.init(M, 7168, F.G, (int)blockIdx.x);
        pg8::EpiInProj E{A.in(4), (const float*)(ws + WS_RSX), (const float*)(ws + WS_SBIN), (bf16_t*)(ws + WS_GLU), (bf16_t*)(ws + WS_Q), WS_QSTRIDE / 2, C2, SEQ, (float*)(ws + WS_QN2), (float*)(ws + WS_KN2)};
        pg8::gemm_phase<pg8::EpiInProj, pg8::StaticOrder, true, true, true>(F.lds + RING_OFF, g, S, E);
        if (BOTH(1)) xcd_barrier(bar);
    }

    if (IN(2)) { const KA A = kargs(); unsigned char* const ws = A.ws();
        static_assert(attn_body::ATTN_LDS_BYTES <= RING_BYTES, "attention LDS");
        const attn_body::AttnTensors AT{(const attn_body::bf16*)(ws + WS_Q), (const attn_body::bf16*)(ws + WS_K), (const attn_body::bf16*)(ws + WS_V), (attn_body::bf16*)(ws + WS_Q), (const float*)(ws + WS_KN2), (const float*)(ws + WS_QN2), (const float*)(ws + WS_KNM)};
        const attn_body::StaticOrder S((int)F.G, (int)blockIdx.x);
        attn_body::attn_phase<attn_body::StaticOrder>((char*)lds + RING_OFF, AT, (const float*)(ws + WS_BIAS), S);
        p2_conv(F, A);
        if (BOTH(2)) xcd_barrier(bar);
    }

    if (IN(3)) { const KA A = kargs(); unsigned char* const ws = A.ws();
        pg8::PairOrder S; S.init(M, D, F.G, (int)blockIdx.x);
        pg8::Gemm g{(const bf16_t*)(ws + WS_U), (const bf16_t*)(ws + WS_WCO_T), M, D, D, (const bf16_t*)(ws + WS_Q), (const bf16_t*)(ws + WS_WAO_T)};
        pg8::EpiMerge E{(const bf16_t*)(ws + WS_SGA), (const bf16_t*)(ws + WS_SGB), (bf16_t*)(ws + WS_XN)};
        pg8::gemm_phase<pg8::EpiMerge, pg8::PairOrder, true, true, false, true>(F.lds + RING_OFF, g, S, E);
        if (BOTH(3)) xcd_barrier(bar);
    }

    if (IN(4)) { const KA A = kargs(); unsigned char* const ws = A.ws();
        pg8::Gemm g{(const bf16_t*)(ws + WS_XN), (const bf16_t*)(ws + WS_WMIX_T), M, D, D}; pg8::StaticOrder S; S.init(M, D, F.G, (int)blockIdx.x);
        pg8::EpiResid E{A.in(0), (bf16_t*)(ws + WS_H)};
        pg8::gemm_phase<pg8::EpiResid, pg8::StaticOrder, true, true>(F.lds + RING_OFF, g, S, E);
        if (BOTH(4)) xcd_barrier(bar);
    }

    if (IN(5)) { const KA A = kargs(); p5_router(F, A); if (BOTH(5)) xcd_barrier(bar); }

    if (IN(6)) { const KA A = kargs(); unsigned char* const ws = A.ws();
        moe_table(F, A);
        pg8::MoeOrder S; S.init((const LAS int*)(F.lds + MOE_TAB_OFF), 8, F.G, (int)blockIdx.x);
        pg8::RowsGather RW{(const int*)(ws + WS_LISTS)};
        pg8::EpiMoeGU E{A.in(16), (const float*)(ws + WS_LRS), (const float*)(ws + WS_SBGU), ws + WS_ACT, (float*)(ws + WS_SACT), (LAS float*)(F.lds + MOE_XM_OFF)};
        pg8::gemm_phase_g<pg8::EpiMoeGU, pg8::MoeOrder, pg8::RowsGather, 512, true>(F.wave, F.lds + RING_OFF, F.lds + MOE_PARK_OFF, nullptr, nullptr, (const bf16_t*)(ws + WS_GLU), (const bf16_t*)(ws + WS_WGU_T), (size_t)2048 * 1024, S, RW, E);
        if (BOTH(6)) xcd_barrier(bar);
    }

    if (IN(7)) { const KA A = kargs(); unsigned char* const ws = A.ws();
        moe_table(F, A);
        pg8::MoeOrder S; S.init((const LAS int*)(F.lds + MOE_TAB_OFF), 4, F.G, (F.G % 8 == 0) ? (int)(blockIdx.x % 8) * (int)(F.G / 8) + (int)(blockIdx.x / 8) : (int)blockIdx.x);
        pg8::RowsDense RW{};
        pg8::EpiMoeDown E{A.in(18), (const float*)(ws + WS_SBDN), (const int*)(ws + WS_LISTS), (const float*)(ws + WS_LGT), (bf16_t*)(ws + WS_Y)};
        static_assert(MOE_SPARK_OFF - 2048 >= MOE_XM_OFF, "the down GEMM's row offsets sit in the gate-up exchange area (idle in this phase)");
        pg8::gemm_phase_g<pg8::EpiMoeDown, pg8::MoeOrder, pg8::RowsDense, 512, true, true, true>(F.wave, F.lds + RING_OFF, F.lds + MOE_PARK_OFF, F.lds + MOE_SPARK_OFF, (const float*)(ws + WS_SACT), (const bf16_t*)(ws + WS_ACT), (const bf16_t*)(ws + WS_WDN_T), (size_t)D * 1024, S, RW, E);
        if (BOTH(7)) xcd_barrier(bar);
    }

    if (IN(8)) { const KA A = kargs(); p8_final(F, A); }
#undef IN
#undef BOTH
}
extern "C" void kernel_launch(void* const* d_in, const int* in_sizes, int n_in, void* d_out, int out_size, void* d_ws, size_t ws_size, hipStream_t stream) {
    static int grid = 0;
    if (grid == 0) {
        if (n_in != 20 || in_sizes[0] != M * D || out_size != M * D || ws_size < WS_END) { fprintf(stderr, "kernel_launch: unexpected shapes (n_in %d in0 %d out %d ws %zu)\n", n_in, n_in > 0 ? in_sizes[0] : -1, out_size, ws_size); grid = -1; return; }
        int dev = 0, cus = 0, per_cu = 0;
        if (hipGetDevice(&dev) != hipSuccess || hipDeviceGetAttribute(&cus, hipDeviceAttributeMultiprocessorCount, dev) != hipSuccess) { grid = -1; return; }
        if (hipFuncSetAttribute((const void*)mega_fwd, hipFuncAttributeMaxDynamicSharedMemorySize, LDS_BYTES) != hipSuccess) { fprintf(stderr, "kernel_launch: hipFuncSetAttribute failed\n"); grid = -1; return; }
        if (hipOccupancyMaxActiveBlocksPerMultiprocessor(&per_cu, (const void*)mega_fwd, NWAVES * 64, LDS_BYTES) != hipSuccess || per_cu < 1) { fprintf(stderr, "kernel_launch: occupancy query says %d blocks per CU\n", per_cu); (void)hipGetLastError(); grid = -1; return; }
        grid = cus;
    }
    if (grid < 0) return;
    unsigned char* ws = (unsigned char*)d_ws; float* out = (float*)d_out;

    (void)hipMemsetAsync(ws + WS_CTL, 0, CTL_ZERO_BYTES, stream);
    Args a{};
    for (int i = 0; i < 20; ++i) a.in[i] = (const float*)d_in[i];
    a.out = out; a.ws = ws; a.ph_lo = 0; a.ph_hi = N_MEGA_PHASES;
    hipLaunchKernelGGL(mega_fwd, dim3(grid), dim3(NWAVES * 64), LDS_BYTES, stream, a);
    { const hipError_t le = hipPeekAtLastError(); if (le != hipSuccess) fprintf(stderr, "kernel_launch: launch failed: %s\n", hipGetErrorName(le)); }
}
```

```cpp
#include <hip/hip_runtime.h>
#include <cstdio>
#include <cstdint>

typedef unsigned short bf16_t;
typedef short bf16x8 __attribute__((ext_vector_type(8)));
typedef float f32x4 __attribute__((ext_vector_type(4)));
typedef float f32x16 __attribute__((ext_vector_type(16)));
typedef unsigned u32x4 __attribute__((ext_vector_type(4)));
typedef unsigned u32x2 __attribute__((ext_vector_type(2)));

constexpr int D = 1024, NB = 4, SEQ = 8192, NMETA = 16, M = NB * SEQ;
constexpr int NH = 16, HD = 64, NE = 32, TOPK = 4, NA = M * TOPK;
constexpr int IN_COLS = 7184, OFF_Q = 2048, OFF_K = 3072, OFF_V = 4096, OFF_F = 5120, OFF_GA = 5136, OFF_GB = 6160;
constexpr int CONVW = 31;
constexpr int KVROWS = SEQ + 64;
constexpr float LOG2E = 1.4426950408889634f;
constexpr float C2 = 0.125f * LOG2E;
constexpr float RMS_EPS = 1e-5f, LN_EPS = 1e-5f;
constexpr float NEG_BIG = -1e30f;

constexpr size_t MiB = 1u << 20;
constexpr size_t WS_CTL = 0, CTL_ZERO_BYTES = 1 * MiB;
constexpr size_t WS_LISTS = 4 * MiB;
constexpr size_t WS_TOPI = 8 * MiB;
constexpr size_t WS_TOPG = 8 * MiB + 512 * 1024;
constexpr size_t WS_LOGF = 10 * MiB;
constexpr size_t WS_LOGFM = 12 * MiB;
constexpr size_t WS_BIAS = 13 * MiB;
constexpr size_t WS_RSX = 9 * MiB + 512 * 1024;
constexpr size_t WS_RSTD = 9 * MiB;
constexpr size_t WS_WR_T = 17 * MiB;
constexpr size_t WS_LRS = 20 * MiB, WS_LGT = 24 * MiB;
constexpr size_t WS_SBIN = 18 * MiB + 512 * 1024;
constexpr size_t WS_SBDN = 19 * MiB;
constexpr size_t WS_SACT = 28 * MiB;
constexpr size_t WS_GSUM = 15 * MiB + 512 * 1024;
constexpr size_t WS_KN2 = 52 * MiB;
constexpr size_t WS_QN2 = 57 * MiB;
constexpr size_t WS_KNM = 61 * MiB + 512 * 1024;
constexpr size_t WS_SBGU = 18 * MiB;
constexpr size_t WS_XNM = 16 * MiB;
constexpr size_t WS_GLUM = 16 * MiB + 64 * 1024;
constexpr size_t WS_WIN_T = 32 * MiB, WS_WCO_T = 46 * MiB, WS_WAO_T = 48 * MiB, WS_WMIX_T = 50 * MiB;
constexpr size_t WS_WGU_T = 64 * MiB;
constexpr size_t WS_TMPA = 192 * MiB;
constexpr size_t WS_Y = 192 * MiB;
constexpr size_t WS_XN = 256 * MiB;
constexpr size_t WS_GLU = 320 * MiB;
constexpr size_t WS_Q = 384 * MiB;
constexpr size_t WS_QSTRIDE = 66 * MiB;
constexpr size_t WS_K = WS_Q + WS_QSTRIDE, WS_V = WS_Q + 2 * WS_QSTRIDE;
constexpr size_t WS_SGA = WS_Q + 3 * WS_QSTRIDE, WS_SGB = WS_Q + 4 * WS_QSTRIDE, WS_U = 714 * MiB;
constexpr size_t WS_ACT = 450 * MiB;
constexpr size_t WS_H = 778 * MiB;
constexpr size_t WS_WDN_T = 906 * MiB;
constexpr size_t WS_END = 970 * MiB;
static_assert(WS_SGB + 64 * MiB <= WS_U && WS_ACT + 256 * MiB <= WS_U && WS_ACT >= WS_K && WS_U + 64 * MiB <= WS_H && WS_H + 128 * MiB <= WS_WDN_T, "d_ws map");
constexpr int CW_CNT = 64;

__device__ __forceinline__ unsigned f2bf(float f) { unsigned u = __builtin_bit_cast(unsigned, f); return (u + 0x7fffu + ((u >> 16) & 1u)) >> 16; }
__device__ __forceinline__ float bf2f(unsigned short b) { return __builtin_bit_cast(float, (unsigned)b << 16); }
__device__ __forceinline__ unsigned pk2(float lo, float hi) { return f2bf(lo) | (f2bf(hi) << 16); }
__device__ __forceinline__ unsigned pk4_i8(float a, float b, float c, float d) {
    const int ia = (int)__builtin_rintf(a), ib = (int)__builtin_rintf(b), ic = (int)__builtin_rintf(c), id = (int)__builtin_rintf(d);
    return ((unsigned)ia & 0xffu) | (((unsigned)ib & 0xffu) << 8) | (((unsigned)ic & 0xffu) << 16) | ((unsigned)id << 24);
}
__device__ __forceinline__ float lane_max_16_32(float v) {
    float a = v, b = v; asm volatile("s_nop 1\n\tv_permlane16_swap_b32 %0, %1" : "+v"(a), "+v"(b)); v = fmaxf(a, b);
    a = v; b = v; asm volatile("s_nop 1\n\tv_permlane32_swap_b32 %0, %1" : "+v"(a), "+v"(b)); return fmaxf(a, b);
}
__device__ __forceinline__ float wave_sum(float v) {
#pragma unroll
    for (int o = 1; o < 64; o <<= 1) v += __shfl_xor(v, o);
    return v;
}
__device__ __forceinline__ float sigmoidf_(float z) { return 1.f / (1.f + __expf(-z)); }

__device__ __forceinline__ int launder(int v) { asm volatile("" : "+v"(v)); return v; }
__device__ __forceinline__ int tid_of(int wave) { return launder(wave * 64 + (int)__builtin_amdgcn_mbcnt_hi(~0u, __builtin_amdgcn_mbcnt_lo(~0u, 0u))); }
namespace pg8 {
#define PG8_LAS __attribute__((address_space(3)))
typedef unsigned short bf16_t;
typedef short bf16x8 __attribute__((ext_vector_type(8)));
typedef float f32x4 __attribute__((ext_vector_type(4)));
typedef unsigned u32x4 __attribute__((ext_vector_type(4)));
constexpr int BM = 256, BK = 64, HALF = 128, HTB = HALF * BK * 2  , STAGE_BYTES = 8 * HTB, NXCD = 8, WGM = 8;

__host__ __device__ __forceinline__ int lds_byte(int r, int c) { const int st = (r >> 4) * 2 + (c >> 5), rr = r & 15, cc = c & 31, ob = rr * 64 + cc * 2; return st * 1024 + (ob ^ (((ob >> 9) & 1) << 5)); }
__host__ __device__ __forceinline__ void stage_rc(int b, int& R, int& C) { const int st = b / 1024, sb = b % 1024, swz = sb ^ (((sb >> 9) & 1) << 5); R = (st >> 1) * 16 + swz / 64; C = (st & 1) * 32 + (swz % 64) / 2; }
__host__ __device__ __forceinline__ int perm32(int rho) { const int n = rho >> 4, i = rho & 15; return 8 * (i >> 2) + 4 * n + (i & 3); }

struct Unit { int pm, pn, part; };
struct Gemm { const bf16_t* A; const bf16_t* Bt; int M, N, K; const bf16_t* A2 = nullptr; const bf16_t* Bt2 = nullptr; };

struct StaticOrder {
    int nM, nN, nwg, G, c;
    __host__ __device__ void init(int M, int N, int G_, int c_) { nM = M / BM; nN = N / BM; nwg = nM * nN; G = G_; c = c_; }
    __host__ __device__ bool next(int i, Unit& u) const {
        const long L = (long)i * G + c; if (L >= nwg) return false;
        int wgid = (int)L; { const int q = nwg / NXCD, r = nwg % NXCD, xcd = wgid % NXCD, off = wgid / NXCD; wgid = (xcd < r ? xcd * (q + 1) : r * (q + 1) + (xcd - r) * q) + off; }
        const int nig = WGM * nN, gid = wgid / nig, fm = gid * WGM, gsz = (nM - fm) < WGM ? (nM - fm) : WGM;
        u.pm = fm + ((wgid % nig) % gsz); u.pn = (wgid % nig) / gsz; u.part = 0; return true;
    }
    __device__ __forceinline__ void a_ready(const Unit&) const {}
    __device__ __forceinline__ void done(const Unit&) const {}
};

struct PairOrder {
    StaticOrder base;
    __host__ __device__ void init(int M, int N, int G_, int c_) { base.init(M, N, G_, c_); }
    __host__ __device__ bool next(int i, Unit& u) const { if (!base.next(i >> 1, u)) return false; u.part = i & 1; return true; }
    __device__ __forceinline__ void a_ready(const Unit&) const {}
    __device__ __forceinline__ void done(const Unit&) const {}
};
__device__ __forceinline__ unsigned cvt_pk_bf16(float lo, float hi) { unsigned r; asm volatile("v_cvt_pk_bf16_f32 %0, %1, %2" : "=v"(r) : "v"(lo), "v"(hi)); return r; }
typedef float f32x2 __attribute__((ext_vector_type(2)));
typedef int i32x4 __attribute__((ext_vector_type(4)));
template <bool I8> struct AccSel { typedef f32x4 T; };
template <> struct AccSel<true> { typedef i32x4 T; };
__device__ __forceinline__ f32x4 mma16(bf16x8 b, bf16x8 a, f32x4 c) { return __builtin_amdgcn_mfma_f32_16x16x32_bf16(b, a, c, 0, 0, 0); }
__device__ __forceinline__ i32x4 mma16(bf16x8 b, bf16x8 a, i32x4 c) { return __builtin_amdgcn_mfma_i32_16x16x64_i8(__builtin_bit_cast(i32x4, b), __builtin_bit_cast(i32x4, a), c, 0, 0, 0); }
__device__ __forceinline__ float sigm(float z) { return __builtin_amdgcn_rcpf(1.0f + __expf(-z)); }
__device__ __forceinline__ f32x4 sigm4(f32x4 z) { return (f32x4){sigm(z[0]), sigm(z[1]), sigm(z[2]), sigm(z[3])}; }
__device__ __forceinline__ f32x2 sigm_pk(f32x2 z) { f32x2 e = z * (-1.4426950408889634f); e.x = __builtin_amdgcn_exp2f(e.x); e.y = __builtin_amdgcn_exp2f(e.y); e = e + 1.0f; f32x2 r; r.x = __builtin_amdgcn_rcpf(e.x); r.y = __builtin_amdgcn_rcpf(e.y); return r; }
__device__ __forceinline__ f32x2 lo2(f32x4 v) { return (f32x2){v[0], v[1]}; }
__device__ __forceinline__ f32x2 hi2(f32x4 v) { return (f32x2){v[2], v[3]}; }
__device__ __forceinline__ f32x2 cvt_lo2(i32x4 v) { return (f32x2){(float)v[0], (float)v[1]}; }
__device__ __forceinline__ f32x2 cvt_hi2(i32x4 v) { return (f32x2){(float)v[2], (float)v[3]}; }
__device__ __forceinline__ f32x2 swiglu_pk(f32x2 z1, f32x2 z2) {
    f32x2 gg, up; gg.x = fminf(z1.x, 7.f); gg.y = fminf(z1.y, 7.f); up.x = fminf(fmaxf(z2.x, -7.f), 7.f); up.y = fminf(fmaxf(z2.y, -7.f), 7.f);
    f32x2 e = gg * (-1.702f * 1.4426950408889634f); e.x = __builtin_amdgcn_exp2f(e.x); e.y = __builtin_amdgcn_exp2f(e.y); e = e + 1.0f;
    f32x2 r; r.x = __builtin_amdgcn_rcpf(e.x); r.y = __builtin_amdgcn_rcpf(e.y);
    const f32x2 t = gg * r; return t * up + t; }
__device__ __forceinline__ u32x4 pack8_pk(f32x2 a, f32x2 b, f32x2 c, f32x2 d) { u32x4 w; w.x = cvt_pk_bf16(a.x, a.y); w.y = cvt_pk_bf16(b.x, b.y); w.z = cvt_pk_bf16(c.x, c.y); w.w = cvt_pk_bf16(d.x, d.y); return w; }
__device__ __forceinline__ u32x4 pack8(f32x4 v0, f32x4 v1) { u32x4 w; w.x = cvt_pk_bf16(v0[0], v0[1]); w.y = cvt_pk_bf16(v0[2], v0[3]); w.z = cvt_pk_bf16(v1[0], v1[1]); w.w = cvt_pk_bf16(v1[2], v1[3]); return w; }
__device__ __forceinline__ void unpack8(u32x4 w, f32x4& lo, f32x4& hi) {
    lo = (f32x4){__builtin_bit_cast(float, w.x << 16), __builtin_bit_cast(float, w.x & 0xffff0000u), __builtin_bit_cast(float, w.y << 16), __builtin_bit_cast(float, w.y & 0xffff0000u)};
    hi = (f32x4){__builtin_bit_cast(float, w.z << 16), __builtin_bit_cast(float, w.z & 0xffff0000u), __builtin_bit_cast(float, w.w << 16), __builtin_bit_cast(float, w.w & 0xffff0000u)};
}
struct EpiInProj {
    static constexpr bool PERM = true, AFTER_DRAIN = false;
    const float* b_in; const float* RSX; const float* SB; bf16_t *GLU, *Q; size_t qstride; float qscale; int seq; float* QN2; float* KN2;
    __device__ __forceinline__ void operator()(const i32x4 (&acc)[2][2][4][2], const Unit& u, int wr, int wc, int fr, int fq) const {
        const int row0 = u.pm * BM + wr * 64 + fr;
        const float* sp = SB + u.pn * 256 + wc * 32 + 8 * fq;
        float rs[2][4];
#pragma unroll
        for (int ai = 0; ai < 2; ++ai)
#pragma unroll
            for (int m = 0; m < 4; ++m) rs[ai][m] = RSX[row0 + ai * HALF + m * 16];
        f32x4 sc[2][2];
#pragma unroll
        for (int bj = 0; bj < 2; ++bj)
#pragma unroll
            for (int n = 0; n < 2; ++n) sc[bj][n] = *(const f32x4*)(sp + bj * HALF + 4 * n);
        if (u.pn < 8) {
            const int ch0 = u.pn * 128 + wc * 32 + 8 * fq;
            f32x4 ba[2], bb[2];
#pragma unroll
            for (int n = 0; n < 2; ++n) { ba[n] = *(const f32x4*)(b_in + ch0 + 4 * n); bb[n] = *(const f32x4*)(b_in + 1024 + ch0 + 4 * n); }
#pragma unroll
            for (int ai = 0; ai < 2; ++ai)
#pragma unroll
                for (int m = 0; m < 4; ++m) { const float r_ = rs[ai][m];
                    f32x2 o[4];
#pragma unroll
                    for (int n = 0; n < 2; ++n) { const f32x4 fa = sc[0][n] * r_, fb = sc[1][n] * r_;
                        o[2 * n] = (cvt_lo2(acc[ai][0][m][n]) * lo2(fa) + lo2(ba[n])) * sigm_pk(cvt_lo2(acc[ai][1][m][n]) * lo2(fb) + lo2(bb[n]));
                        o[2 * n + 1] = (cvt_hi2(acc[ai][0][m][n]) * hi2(fa) + hi2(ba[n])) * sigm_pk(cvt_hi2(acc[ai][1][m][n]) * hi2(fb) + hi2(bb[n])); }
                    __builtin_nontemporal_store(pack8_pk(o[0], o[1], o[2], o[3]), (u32x4*)(GLU + (size_t)(row0 + ai * HALF + m * 16) * 1024 + ch0));
                }
        } else {
            const int kind = (u.pn - 8) >> 2, ct = wc * 32 + 8 * fq, cw = (u.pn & 3) * 256 + ct, bcol = u.pn * 256 + ct + (u.pn >= 20 ? 16 : 0);
            bf16_t* base = Q + (size_t)kind * qstride;
            const int radd = (kind == 1 || kind == 2) ? 64 * ((u.pm * BM) / seq + 1) : 0;
            f32x4 bv[2][2];
#pragma unroll
            for (int bj = 0; bj < 2; ++bj)
#pragma unroll
                for (int n = 0; n < 2; ++n) bv[bj][n] = *(const f32x4*)(b_in + bcol + bj * HALF + 4 * n);
#pragma unroll
            for (int ai = 0; ai < 2; ++ai)
#pragma unroll
                for (int m = 0; m < 4; ++m) { bf16_t* rowp = base + (size_t)(row0 + ai * HALF + m * 16 + radd) * 1024 + cw; const float r_ = rs[ai][m];
#pragma unroll
                    for (int bj = 0; bj < 2; ++bj) { const f32x4 f0 = sc[bj][0] * r_, f1 = sc[bj][1] * r_;
                        f32x2 o0 = cvt_lo2(acc[ai][bj][m][0]) * lo2(f0) + lo2(bv[bj][0]), o1 = cvt_hi2(acc[ai][bj][m][0]) * hi2(f0) + hi2(bv[bj][0]), o2 = cvt_lo2(acc[ai][bj][m][1]) * lo2(f1) + lo2(bv[bj][1]), o3 = cvt_hi2(acc[ai][bj][m][1]) * hi2(f1) + hi2(bv[bj][1]);
                        if (kind == 0) { o0 = o0 * qscale; o1 = o1 * qscale; o2 = o2 * qscale; o3 = o3 * qscale; } else if (kind >= 3) { o0 = sigm_pk(o0); o1 = sigm_pk(o1); o2 = sigm_pk(o2); o3 = sigm_pk(o3); }
                        const u32x4 w_ = pack8_pk(o0, o1, o2, o3);
                        __builtin_nontemporal_store(w_, (u32x4*)(rowp + bj * HALF));
                        if (kind <= 1) {
                            f32x4 lo, hi; unpack8(w_, lo, hi); lo = lo * lo + hi * hi; float ss = (lo[0] + lo[1]) + (lo[2] + lo[3]);
                            ss += __shfl_xor(ss, 16); ss += __shfl_xor(ss, 32);
                            if (fq == 0) (kind == 0 ? QN2 : KN2)[((size_t)((u.pn & 3) * 4 + bj * 2 + (wc >> 1)) * (kind == 0 ? (size_t)M : (size_t)NB * KVROWS) + (size_t)(row0 + ai * HALF + m * 16 + radd)) * 2 + (wc & 1)] = ss; } } }
        }
    }
};
template <bool HAS_ADD> struct EpiGated {
    static constexpr bool PERM = true, AFTER_DRAIN = false;
    const bf16_t* SG; const bf16_t* ADD; bf16_t* OUT;
    __device__ __forceinline__ void operator()(const f32x4 (&acc)[2][2][4][2], const Unit& u, int wr, int wc, int fr, int fq) const {
        const int row0 = u.pm * BM + wr * 64 + fr, col0 = u.pn * BM + wc * 32 + 8 * fq;
#pragma unroll
        for (int ai = 0; ai < 2; ++ai)
#pragma unroll
            for (int m = 0; m < 4; ++m) { const size_t off = (size_t)(row0 + ai * HALF + m * 16) * 1024 + col0;
#pragma unroll
                for (int bj = 0; bj < 2; ++bj) { f32x4 g0, g1; unpack8(*(const u32x4*)(SG + off + bj * HALF), g0, g1);
                    f32x4 v0 = acc[ai][bj][m][0] * g0, v1 = acc[ai][bj][m][1] * g1;
                    if (HAS_ADD) { f32x4 t0, t1; unpack8(*(const u32x4*)(ADD + off + bj * HALF), t0, t1); v0 = v0 + t0; v1 = v1 + t1; }
                    *(u32x4*)(OUT + off + bj * HALF) = pack8(v0, v1); } }
    }
};
struct EpiMerge {
    static constexpr bool PERM = true, AFTER_DRAIN = false; static constexpr int NREL = 16;
    const bf16_t* SGA; const bf16_t* SGB; bf16_t* OUT;
    __device__ __forceinline__ void mid(f32x4 (&acc)[2][2][4][2], const Unit& u, int wr, int wc, int fr, int fq) const {
        const int row0 = u.pm * BM + wr * 64 + fr, col0 = u.pn * BM + wc * 32 + 8 * fq;
#pragma unroll
        for (int ai = 0; ai < 2; ++ai) {
#pragma unroll
            for (int m = 0; m < 4; ++m) { const size_t off = (size_t)(row0 + ai * HALF + m * 16) * 1024 + col0;
#pragma unroll
                for (int bj = 0; bj < 2; ++bj) { f32x4 a0, a1, b0, b1; unpack8(*(const u32x4*)(SGA + off + bj * HALF), a0, a1); unpack8(*(const u32x4*)(SGB + off + bj * HALF), b0, b1);
#pragma unroll
                    for (int i = 0; i < 4; ++i) { a0[i] *= __builtin_amdgcn_rcpf(fmaxf(b0[i], 1e-30f)); a1[i] *= __builtin_amdgcn_rcpf(fmaxf(b1[i], 1e-30f)); }
                    acc[ai][bj][m][0] = acc[ai][bj][m][0] * a0; acc[ai][bj][m][1] = acc[ai][bj][m][1] * a1; } }
            asm volatile("" ::: "memory");
        }
    }
    __device__ __forceinline__ void operator()(const f32x4 (&acc)[2][2][4][2], const Unit& u, int wr, int wc, int fr, int fq) const {
        const int row0 = u.pm * BM + wr * 64 + fr, col0 = u.pn * BM + wc * 32 + 8 * fq;
#pragma unroll
        for (int ai = 0; ai < 2; ++ai)
#pragma unroll
            for (int m = 0; m < 4; ++m) { const size_t off = (size_t)(row0 + ai * HALF + m * 16) * 1024 + col0;
#pragma unroll
                for (int bj = 0; bj < 2; ++bj) { f32x4 b0, b1; unpack8(*(const u32x4*)(SGB + off + bj * HALF), b0, b1);
#pragma unroll
                    for (int i = 0; i < 4; ++i) { b0[i] = fmaxf(b0[i], 1e-30f); b1[i] = fmaxf(b1[i], 1e-30f); }
                    *(u32x4*)(OUT + off + bj * HALF) = pack8(acc[ai][bj][m][0] * b0, acc[ai][bj][m][1] * b1); } }
    }
};
struct EpiResid {
    static constexpr bool PERM = true, AFTER_DRAIN = false;
    const float* X; bf16_t* H;
    __device__ __forceinline__ void operator()(const f32x4 (&acc)[2][2][4][2], const Unit& u, int wr, int wc, int fr, int fq) const {
        const int row0 = u.pm * BM + wr * 64 + fr, col0 = u.pn * BM + wc * 32 + 8 * fq;
#pragma unroll
        for (int ai = 0; ai < 2; ++ai)
#pragma unroll
            for (int m = 0; m < 4; ++m) { const size_t off = (size_t)(row0 + ai * HALF + m * 16) * 1024 + col0;
#pragma unroll
                for (int bj = 0; bj < 2; ++bj) { const f32x4 x0 = *(const f32x4*)(X + off + bj * HALF), x1 = *(const f32x4*)(X + off + bj * HALF + 4);
                    *(u32x4*)(H + off + bj * HALF) = pack8(x0 + acc[ai][bj][m][0], x1 + acc[ai][bj][m][1]); } }
    }
};
template <class Epi, class Sched, bool ALIGN_EPI = false, bool SP2 = false, bool I8 = false, bool DUAL = false>
__device__ __forceinline__ void gemm_phase(PG8_LAS unsigned char* lds, const Gemm g, const Sched& S, const Epi& E) {
    const int tid = ::launder((int)threadIdx.x), wid = __builtin_amdgcn_readfirstlane(tid >> 6), lane = tid & 63, wr = wid >> 2, wc = wid & 3, fr = lane & 15, fq = lane >> 4;
    const int K = g.K, nt = K / BK;
    unsigned voffA[2], voffB[2];
#pragma unroll
    for (int i = 0; i < 2; ++i) { int R, C; stage_rc(tid * 16 + i * 8192, R, C); const int Rb = Epi::PERM ? ((R & ~31) + perm32(R & 31)) : R;
        voffA[i] = (unsigned)(R * K + C) * 2u; voffB[i] = (unsigned)(Rb * K + C) * 2u; }
    const size_t kstep = (size_t)(BK * 2);
    const size_t hstep = (size_t)HALF * K * 2;
    const size_t tstep = 2 * hstep;
    const unsigned ldsw = (unsigned)wid * 1024u;
    const int aoff = lds_byte(wr * 64 + fr, fq * 8), boff = lds_byte(wc * 32 + fr, fq * 8);
#define PG8_SA(b, h) (((b) * 2 + (h)) * HTB)
#define PG8_SB(b, h) ((4 + (b) * 2 + (h)) * HTB)
#define PG8_STAGE(bufoff, gbase, voff) do { _Pragma("unroll") for (int _i = 0; _i < 2; ++_i) \
        __builtin_amdgcn_global_load_lds((const unsigned*)((const char*)(gbase) + (voff)[_i]), (PG8_LAS unsigned*)(lds + (bufoff) + ldsw + _i * 8192), 16, 0, 0); } while (0)
#define PG8_LDA(dst, b, h) do { _Pragma("unroll") for (int m = 0; m < 4; ++m) _Pragma("unroll") for (int k = 0; k < 2; ++k) dst[m][k] = *(const PG8_LAS bf16x8*)(lds + PG8_SA(b, h) + aoff + m * 2048 + k * 1024); } while (0)
#define PG8_LDB(dst, b, h) do { _Pragma("unroll") for (int n = 0; n < 2; ++n) _Pragma("unroll") for (int k = 0; k < 2; ++k) dst[n][k] = *(const PG8_LAS bf16x8*)(lds + PG8_SB(b, h) + boff + n * 2048 + k * 1024); } while (0)
#define PG8_MMA(ai, bj, At, Bt) do { __builtin_amdgcn_s_setprio(1); _Pragma("unroll") for (int m = 0; m < 4; ++m) _Pragma("unroll") for (int n = 0; n < 2; ++n) _Pragma("unroll") for (int k = 0; k < 2; ++k) \
        acc[ai][bj][m][n] = mma16(Bt[n][k], At[m][k], acc[ai][bj][m][n]); __builtin_amdgcn_s_setprio(0); } while (0)
#define PG8_WAIT_V(n) asm volatile("s_waitcnt vmcnt(" #n ")" ::: "memory")
#define PG8_WAIT_L(n) asm volatile("s_waitcnt lgkmcnt(" #n ")" ::: "memory")
#define PG8_BAR __builtin_amdgcn_s_barrier()
#define PG8_SCHED __builtin_amdgcn_sched_barrier(0)
    Unit cur, nxt; int ui = 0;
    if (!S.next(0, cur)) return;
    typedef typename AccSel<I8>::T acc_t; acc_t acc[2][2][4][2];
#pragma unroll
    for (int a = 0; a < 2; ++a)
#pragma unroll
        for (int b = 0; b < 2; ++b)
#pragma unroll
            for (int m = 0; m < 4; ++m)
#pragma unroll
                for (int n = 0; n < 2; ++n) acc[a][b][m][n] = acc_t{};
    bf16x8 At[4][2], B0[2][2], B1[2][2];
    const char* cA = (const char*)((DUAL && cur.part) ? g.A2 : g.A) + (size_t)cur.pm * tstep; const char* cB = (const char*)((DUAL && cur.part) ? g.Bt2 : g.Bt) + (size_t)cur.pn * tstep;
    S.a_ready(cur);
    if constexpr (SP2) {
        PG8_STAGE(PG8_SB(0, 0), cB, voffB); PG8_STAGE(PG8_SB(0, 1), cB + hstep, voffB); PG8_STAGE(PG8_SA(0, 0), cA, voffA); PG8_STAGE(PG8_SA(0, 1), cA + hstep, voffA);
        if (wr == 1) PG8_BAR;
        PG8_WAIT_V(2); PG8_BAR;
        PG8_STAGE(PG8_SB(1, 0), cB + kstep, voffB); PG8_STAGE(PG8_SA(1, 0), cA + kstep, voffA); PG8_STAGE(PG8_SB(1, 1), cB + hstep + kstep, voffB);
        PG8_WAIT_V(6); PG8_BAR;
    } else {
        PG8_STAGE(PG8_SB(0, 0), cB, voffB); PG8_STAGE(PG8_SA(0, 0), cA, voffA); PG8_STAGE(PG8_SB(0, 1), cB + hstep, voffB); PG8_STAGE(PG8_SA(0, 1), cA + hstep, voffA);
        if (wr == 1) PG8_BAR;
        PG8_WAIT_V(4); PG8_BAR;
        PG8_STAGE(PG8_SB(1, 0), cB + kstep, voffB); PG8_STAGE(PG8_SA(1, 0), cA + kstep, voffA); PG8_STAGE(PG8_SB(1, 1), cB + hstep + kstep, voffB);
        PG8_WAIT_V(6); PG8_BAR;
    }
    for (;;) {
        const bool has_next = S.next(ui + 1, nxt);
        const char* nA = has_next ? (const char*)((DUAL && nxt.part) ? g.A2 : g.A) + (size_t)nxt.pm * tstep : cA; const char* nB = has_next ? (const char*)((DUAL && nxt.part) ? g.Bt2 : g.Bt) + (size_t)nxt.pn * tstep : cB;
        for (int t = 0; t < nt; t += 2) {
            const bool last = (t == nt - 2);
            const char* a1 = cA + (size_t)(t + 1) * kstep;
            const char* a2 = last ? nA : cA + (size_t)(t + 2) * kstep; const char* b2 = last ? nB : cB + (size_t)(t + 2) * kstep;
            const char* a3 = a2 + kstep; const char* b3 = b2 + kstep;
            if (last && has_next) S.a_ready(nxt);
            if constexpr (SP2) {
            PG8_LDB(B0, 0, 0); PG8_LDB(B1, 0, 1); PG8_SCHED; PG8_LDA(At, 0, 0); PG8_STAGE(PG8_SA(1, 1), a1 + hstep, voffA);
            PG8_WAIT_V(8); PG8_WAIT_L(0); PG8_BAR; PG8_MMA(0, 0, At, B0); PG8_MMA(0, 1, At, B1); PG8_BAR; PG8_SCHED;
            PG8_LDA(At, 0, 1); PG8_STAGE(PG8_SB(0, 0), b2, voffB); PG8_STAGE(PG8_SB(0, 1), b2 + hstep, voffB); PG8_STAGE(PG8_SA(0, 0), a2, voffA);
            PG8_WAIT_V(8); PG8_WAIT_L(0); PG8_BAR; PG8_MMA(1, 0, At, B0); PG8_MMA(1, 1, At, B1); PG8_BAR; PG8_SCHED;
            PG8_LDB(B0, 1, 0); PG8_LDB(B1, 1, 1); PG8_SCHED; PG8_LDA(At, 1, 0); PG8_STAGE(PG8_SA(0, 1), a2 + hstep, voffA);
            PG8_WAIT_V(8); PG8_WAIT_L(0); PG8_BAR; PG8_MMA(0, 0, At, B0); PG8_MMA(0, 1, At, B1); PG8_BAR; PG8_SCHED;
            PG8_LDA(At, 1, 1); PG8_STAGE(PG8_SB(1, 0), b3, voffB); PG8_STAGE(PG8_SB(1, 1), b3 + hstep, voffB); PG8_STAGE(PG8_SA(1, 0), a3, voffA);
            PG8_WAIT_V(8); PG8_WAIT_L(0); PG8_BAR; PG8_MMA(1, 0, At, B0); PG8_MMA(1, 1, At, B1); PG8_BAR; PG8_SCHED;
            } else {
            PG8_LDB(B0, 0, 0); PG8_SCHED; PG8_LDA(At, 0, 0); PG8_STAGE(PG8_SA(1, 1), a1 + hstep, voffA);
            PG8_WAIT_L(8); PG8_BAR; PG8_WAIT_L(0); PG8_MMA(0, 0, At, B0); PG8_BAR; PG8_SCHED;
            PG8_LDB(B1, 0, 1); PG8_STAGE(PG8_SB(0, 0), b2, voffB);
            PG8_BAR; PG8_WAIT_L(0); PG8_MMA(0, 1, At, B1); PG8_BAR;
            PG8_LDA(At, 0, 1); PG8_STAGE(PG8_SA(0, 0), a2, voffA);
            PG8_BAR; PG8_WAIT_L(0); PG8_MMA(1, 0, At, B0); PG8_BAR; PG8_SCHED;
            PG8_STAGE(PG8_SB(0, 1), b2 + hstep, voffB);
            PG8_WAIT_V(6); PG8_BAR; PG8_MMA(1, 1, At, B1); PG8_BAR;
            PG8_LDB(B0, 1, 0); PG8_SCHED; PG8_LDA(At, 1, 0); PG8_STAGE(PG8_SA(0, 1), a2 + hstep, voffA);
            PG8_WAIT_L(8); PG8_BAR; PG8_WAIT_L(0); PG8_MMA(0, 0, At, B0); PG8_BAR; PG8_SCHED;
            PG8_LDB(B1, 1, 1); PG8_STAGE(PG8_SB(1, 0), b3, voffB);
            PG8_BAR; PG8_WAIT_L(0); PG8_MMA(0, 1, At, B1); PG8_BAR;
            PG8_LDA(At, 1, 1); PG8_STAGE(PG8_SA(1, 0), a3, voffA);
            PG8_BAR; PG8_WAIT_L(0); PG8_MMA(1, 0, At, B0); PG8_BAR; PG8_SCHED;
            PG8_STAGE(PG8_SB(1, 1), b3 + hstep, voffB);
            PG8_WAIT_V(6); PG8_BAR; PG8_MMA(1, 1, At, B1); PG8_BAR;
            }
        }
        if constexpr (ALIGN_EPI) { if (wr == 0) PG8_BAR; }
        bool keep_acc = false;
        if constexpr (DUAL) { if (cur.part == 0) { E.mid(acc, cur, wr, wc, fr, fq); keep_acc = true; } else E(acc, cur, wr, wc, fr, fq); }
        else if constexpr (!Epi::AFTER_DRAIN) { E(acc, cur, wr, wc, fr, fq); S.done(cur); }
        if (!has_next) break;
        if (!keep_acc) {
#pragma unroll
        for (int a = 0; a < 2; ++a)
#pragma unroll
            for (int b = 0; b < 2; ++b)
#pragma unroll
                for (int m = 0; m < 4; ++m)
#pragma unroll
                    for (int n = 0; n < 2; ++n) acc[a][b][m][n] = acc_t{};
        }
        cur = nxt; cA = nA; cB = nB; ++ui;
        if constexpr (ALIGN_EPI) { if (wr == 1) PG8_BAR; }
    }
    PG8_WAIT_V(0);
    if constexpr (!ALIGN_EPI) { if (wr == 0) PG8_BAR; }
    PG8_BAR;
    if constexpr (Epi::AFTER_DRAIN) { E.fused(acc, cur, wr, wc, fr, fq, lds, wid, lane); S.done(cur); }
#undef PG8_SA
#undef PG8_SB
#undef PG8_STAGE
#undef PG8_LDA
#undef PG8_LDB
#undef PG8_MMA
#undef PG8_WAIT_V
#undef PG8_WAIT_L
#undef PG8_BAR
#undef PG8_SCHED
}
}
namespace pg8 {
struct GUnit { int e, row0, nrows, pn, cntm1, base, tau; };
struct MoeOrder {
    const PG8_LAS int* tab; int npn, G, c, total;
    __device__ __forceinline__ void init(const PG8_LAS int* t, int npn_, int G_, int c_) { tab = t; npn = npn_; G = G_; c = c_; total = __builtin_amdgcn_readfirstlane(t[32]) * npn_; }
    __device__ __forceinline__ bool next(int i, GUnit& u) const {
        const int L = i * G + c; if (L >= total) return false;
        const int tau = L / npn; u.pn = L % npn;
        int e = 0;
#pragma unroll
        for (int j = 1; j < 32; ++j) e += (__builtin_amdgcn_readfirstlane(tab[j]) <= tau) ? 1 : 0;
        const int cn = __builtin_amdgcn_readfirstlane(tab[33 + e]), t0 = __builtin_amdgcn_readfirstlane(tab[e]);
        u.e = e; u.row0 = (tau - t0) * 256; u.nrows = (cn - u.row0) < 256 ? (cn - u.row0) : 256; u.cntm1 = cn - 1; u.base = __builtin_amdgcn_readfirstlane(tab[65 + e]); u.tau = tau;
        return true;
    }
};
struct RowsGather {
    static constexpr bool LOADS = true;
    const int* lists;
    __device__ __forceinline__ int raw0(const GUnit&) const { return 0; }
    __device__ __forceinline__ const int* addr(const GUnit& u, int R) const { int s = u.row0 + R; s = s < u.cntm1 ? s : u.cntm1; return lists + (size_t)u.e * 32768 + s; }
    __device__ __forceinline__ int raw(const GUnit& u, int R) const { int s = u.row0 + R; s = s < u.cntm1 ? s : u.cntm1; return lists[(size_t)u.e * 32768 + s]; }
    static __device__ __forceinline__ unsigned row(int raw) { return (unsigned)raw >> 2; }
};
struct RowsDense {
    static constexpr bool LOADS = false;
    __device__ __forceinline__ const int* addr(const GUnit&, int) const { return nullptr; }
    __device__ __forceinline__ int raw0(const GUnit& u) const { return u.base + u.row0; }
    __device__ __forceinline__ int raw(const GUnit& u, int R) const { int s = u.row0 + R; s = s < u.cntm1 ? s : u.cntm1; return u.base + s; }
    static __device__ __forceinline__ unsigned row(int raw) { return (unsigned)raw; }
};
struct EpiMoeGU {
    static constexpr bool PERM = true, AFTER_DRAIN = false;
    const float* b_gu; const float* LRS; const float* SB; unsigned char* ACTq; float* SACT; PG8_LAS float* xm;
    __device__ __forceinline__ void operator()(const i32x4 (&acc)[2][2][4][2], const GUnit& u, int wr, int wc, int fr, int fq) const {
        const int fq_ = ::launder(fq), ch0 = u.pn * 128 + wc * 32 + 8 * fq_, rb = ::launder(wr * 64 + fr); const float* bp = b_gu + (size_t)u.e * 2048 + ch0;
        const float* sp = SB + (size_t)u.e * 2048 + u.pn * 256 + wc * 32 + 8 * fq_;
        const float* lrs = LRS + (size_t)u.e * 32768 + u.row0;
        f32x4 bg[2], bu[2], sg[2], su[2];
#pragma unroll
        for (int n = 0; n < 2; ++n) { bg[n] = *(const f32x4*)(bp + 4 * n); bu[n] = *(const f32x4*)(bp + 1024 + 4 * n); sg[n] = *(const f32x4*)(sp + 4 * n); su[n] = *(const f32x4*)(sp + HALF + 4 * n); }
        float rsv[2][4];
#pragma unroll
        for (int ai = 0; ai < 2; ++ai)
#pragma unroll
            for (int m = 0; m < 4; ++m) { int rr = ai * HALF + m * 16 + rb; rr = rr < u.nrows ? rr : u.nrows - 1; rsv[ai][m] = lrs[rr]; }
        f32x2 av[2][4][4];
#pragma unroll
        for (int ai = 0; ai < 2; ++ai)
#pragma unroll
            for (int m = 0; m < 4; ++m) { const float rs = rsv[ai][m];
                const f32x4 sgr[2] = {sg[0] * rs, sg[1] * rs}, sur[2] = {su[0] * rs, su[1] * rs};
                f32x2 o[4];
#pragma unroll
                for (int n = 0; n < 2; ++n) {
                    o[2 * n] = swiglu_pk(cvt_lo2(acc[ai][0][m][n]) * lo2(sgr[n]) + lo2(bg[n]), cvt_lo2(acc[ai][1][m][n]) * lo2(sur[n]) + lo2(bu[n]));
                    o[2 * n + 1] = swiglu_pk(cvt_hi2(acc[ai][0][m][n]) * hi2(sgr[n]) + hi2(bg[n]), cvt_hi2(acc[ai][1][m][n]) * hi2(sur[n]) + hi2(bu[n])); }
                av[ai][m][0] = o[0]; av[ai][m][1] = o[1]; av[ai][m][2] = o[2]; av[ai][m][3] = o[3];
                float mx = fmaxf(fmaxf(fmaxf(fabsf(o[0].x), fabsf(o[0].y)), fmaxf(fabsf(o[1].x), fabsf(o[1].y))), fmaxf(fmaxf(fabsf(o[2].x), fabsf(o[2].y)), fmaxf(fabsf(o[3].x), fabsf(o[3].y))));
                mx = ::lane_max_16_32(mx);
                if (fq == 0) (xm + (ai * HALF + m * 16) * 4 + wc)[rb * 4] = mx; }
        asm volatile("s_waitcnt lgkmcnt(0)" ::: "memory"); __builtin_amdgcn_s_barrier(); asm volatile("" ::: "memory");
        unsigned char* actp = ACTq + ((size_t)u.tau * 8 + u.pn) * 32768; float* scp = SACT + (size_t)(u.base + u.row0) * 8 + u.pn;
        const unsigned loff = (unsigned)rb * 128u + (unsigned)(wc * 32 + 8 * fq_), soff = (unsigned)rb * 8u, xoff = (unsigned)rb * 4u;
#pragma unroll
        for (int ai = 0; ai < 2; ++ai)
#pragma unroll
            for (int m = 0; m < 4; ++m) { const int rs0 = ai * HALF + m * 16;
                const f32x4 t = *(const PG8_LAS f32x4*)(xm + rs0 * 4 + xoff); const float tmax = fmaxf(fmaxf(t[0], t[1]), fmaxf(t[2], t[3])), inv = tmax > 0.f ? 127.f * __builtin_amdgcn_rcpf(tmax) : 0.f;
                if (rb < u.nrows - rs0) { const f32x2 q0_ = av[ai][m][0] * inv, q1_ = av[ai][m][1] * inv, q2_ = av[ai][m][2] * inv, q3_ = av[ai][m][3] * inv;
                    u32x2 q; q.x = ::pk4_i8(q0_.x, q0_.y, q1_.x, q1_.y); q.y = ::pk4_i8(q2_.x, q2_.y, q3_.x, q3_.y);
                    *(u32x2*)(actp + (size_t)rs0 * 128 + loff) = q;
                    if (wc == 0 && fq == 0) (scp + (size_t)rs0 * 8)[soff] = tmax * (1.f / 127.f); } }
    }
};
struct EpiMoeDown {
    static constexpr bool PERM = true, AFTER_DRAIN = false;
    const float* b_dn; const float* SB; const int* lists; const float* LGT; bf16_t* Y;
    __device__ __forceinline__ void operator()(const f32x4 (&acc)[2][2][4][2], const GUnit& u, int wr, int wc, int fr, int fq, const PG8_LAS float* scb  ) const {
        const int col0 = u.pn * BM + wc * 32 + 8 * ::launder(fq), rb = ::launder(wr * 64 + fr); const float* bp = b_dn + (size_t)u.e * 1024 + col0;
        const int* lp = lists + (size_t)u.e * 32768 + u.row0; const float* gp = LGT + (size_t)u.e * 32768 + u.row0; const float* sp = SB + (size_t)u.e * 1024 + col0;
        f32x4 bv[2][2], sv[2][2];
#pragma unroll
        for (int bj = 0; bj < 2; ++bj)
#pragma unroll
            for (int n = 0; n < 2; ++n) { bv[bj][n] = *(const f32x4*)(bp + bj * HALF + 4 * n); sv[bj][n] = *(const f32x4*)(sp + bj * HALF + 4 * n); }
        int idv[2][4]; float gtv[2][4];
#pragma unroll
        for (int ai = 0; ai < 2; ++ai)
#pragma unroll
            for (int m = 0; m < 4; ++m) { int rr = ai * HALF + m * 16 + rb; rr = rr < u.nrows ? rr : u.nrows - 1; idv[ai][m] = lp[rr]; gtv[ai][m] = gp[rr]; }
#pragma unroll
        for (int ai = 0; ai < 2; ++ai)
#pragma unroll
            for (int m = 0; m < 4; ++m) { const int rs0 = ai * HALF + m * 16;
                if (rb < u.nrows - rs0) { const float gt = gtv[ai][m]; bf16_t* yp = Y + (size_t)idv[ai][m] * 1024 + col0;
                    const float off = scb[rs0 + rb];
#pragma unroll
                    for (int bj = 0; bj < 2; ++bj) *(u32x4*)(yp + bj * HALF) = pack8(((acc[ai][bj][m][0] - off) * sv[bj][0] + bv[bj][0]) * gt, ((acc[ai][bj][m][1] - off) * sv[bj][1] + bv[bj][1]) * gt); } }
    }
};

template <class Epi, class Sched, class Rows, int KE = 1024, bool I8 = false, bool BS = false, bool KTM = false>
__device__ __forceinline__ void gemm_phase_g(int wave_  , PG8_LAS unsigned char* lds, PG8_LAS unsigned char* park  , PG8_LAS unsigned char* spark  , const float* ASC, const bf16_t* A, const bf16_t* Bt, size_t b_estride  , const Sched& S, const Rows& RW, const Epi& E) {
    const int tid = ::tid_of(wave_), wid = wave_, lane = tid & 63, wr = wid >> 2, wc = wid & 3, fr = lane & 15, fq = lane >> 4;
    constexpr int K = KE, nt = K / BK;
    typedef typename AccSel<I8 && !BS>::T acc_t;
    unsigned voffB[2];
#pragma unroll
    for (int i = 0; i < 2; ++i) { int R, C; stage_rc(tid * 16 + i * 8192, R, C); const int Rb = Epi::PERM ? ((R & ~31) + perm32(R & 31)) : R; voffB[i] = (unsigned)(Rb * K + C) * 2u; }
#define PG8_RC(i, R, C) int R, C; stage_rc(::tid_of(wave_) * 16 + (i) * 8192, R, C)
    constexpr size_t kstep = (size_t)(BK * 2), hstep = (size_t)HALF * K * 2, tstep = 2 * hstep, kstepA = KTM ? (size_t)32768 : kstep;
    const unsigned ldsw = (unsigned)wid * 1024u;
    const int aoff = lds_byte(wr * 64 + fr, fq * 8), boff = lds_byte(wc * 32 + fr, fq * 8);
#define PG8_SA(b, h) (((b) * 2 + (h)) * HTB)
#define PG8_SB(b, h) ((4 + (b) * 2 + (h)) * HTB)
#define PG8_STAGE(bufoff, gbase, voff) do { _Pragma("unroll") for (int _i = 0; _i < 2; ++_i) \
        __builtin_amdgcn_global_load_lds((const unsigned*)((const char*)(gbase) + (voff)[_i]), (PG8_LAS unsigned*)(lds + (bufoff) + ldsw + _i * 8192), 16, 0, 0); } while (0)
#define PG8_LDA(dst, b, h) do { _Pragma("unroll") for (int m = 0; m < 4; ++m) _Pragma("unroll") for (int k = 0; k < 2; ++k) dst[m][k] = *(const PG8_LAS bf16x8*)(lds + PG8_SA(b, h) + aoff + m * 2048 + k * 1024); } while (0)
#define PG8_LDB(dst, b, h) do { _Pragma("unroll") for (int n = 0; n < 2; ++n) _Pragma("unroll") for (int k = 0; k < 2; ++k) dst[n][k] = *(const PG8_LAS bf16x8*)(lds + PG8_SB(b, h) + boff + n * 2048 + k * 1024); } while (0)
#define PG8_MMA(ai, bj, At, Bt) do { __builtin_amdgcn_s_setprio(1); _Pragma("unroll") for (int m = 0; m < 4; ++m) _Pragma("unroll") for (int n = 0; n < 2; ++n) _Pragma("unroll") for (int k = 0; k < 2; ++k) \
        acc[ai][bj][m][n] = mma16(Bt[n][k], At[m][k], acc[ai][bj][m][n]); __builtin_amdgcn_s_setprio(0); } while (0)
#define PG8_MMA_BS(ai, bj, At, Bt, sc) do { _Pragma("unroll") for (int m = 0; m < 4; ++m) { i32x4 tq_[2]; __builtin_amdgcn_s_setprio(1); \
        _Pragma("unroll") for (int n = 0; n < 2; ++n) tq_[n] = mma16(Bt[n][0], At[m][0], magic); \
        _Pragma("unroll") for (int n = 0; n < 2; ++n) tq_[n] = mma16(Bt[n][1], At[m][1], tq_[n]); \
        __builtin_amdgcn_s_setprio(0); \
        _Pragma("unroll") for (int n = 0; n < 2; ++n) acc[ai][bj][m][n] = acc[ai][bj][m][n] + __builtin_bit_cast(f32x4, tq_[n]) * sc[m]; } } while (0)
#define PG8_LDSC(sc, ai, kt) do { if constexpr (BS) { _Pragma("unroll") for (int m = 0; m < 4; ++m) sc[m] = *(const PG8_LAS float*)(spark + (ui & 1) * 8192 + (((ai) * HALF + wr * 64 + m * 16 + fr) * 8 + (kt)) * 4); } } while (0)
#define PG8_SSUM(par_) do { const int t_ = ::tid_of(wave_), row_ = t_ >> 1, hf_ = t_ & 1; \
        const f32x4 s4_ = *(const PG8_LAS f32x4*)(spark + (par_) * 8192 + row_ * 32 + hf_ * 16); \
        float sm_ = (s4_.x + s4_.y) + (s4_.z + s4_.w); sm_ += __shfl_xor(sm_, 1); \
        if (hf_ == 0) *(PG8_LAS float*)(spark - 2048 + (par_) * 1024 + row_ * 4) = sm_ * 12582912.f; } while (0)
#define PG8_MM2(ai) do { if constexpr (BS) { PG8_MMA_BS(ai, 0, At, B0, sc); PG8_MMA_BS(ai, 1, At, B1, sc); } else { PG8_MMA(ai, 0, At, B0); PG8_MMA(ai, 1, At, B1); } } while (0)
#define PG8_SPARK(u_, par_) do { if constexpr (BS) __builtin_amdgcn_global_load_lds((const unsigned*)(ASC + (size_t)((u_).base + (u_).row0) * 8 + wid * 256 + lane * 4), (PG8_LAS unsigned*)(spark + (par_) * 8192 + wid * 1024), 16, 0, 0); } while (0)
#define PG8_WAIT_V(n) asm volatile("s_waitcnt vmcnt(" #n ")" ::: "memory")
#define PG8_WAIT_L(n) asm volatile("s_waitcnt lgkmcnt(" #n ")" ::: "memory")
#define PG8_BAR __builtin_amdgcn_s_barrier()
#define PG8_SCHED __builtin_amdgcn_sched_barrier(0)
    GUnit cur, nxt, nn; int ui = 0;
    if (!S.next(0, cur)) return;
    bool has_next = S.next(1, nxt), has_nn = has_next && S.next(2, nn);
    unsigned voC[2][2], voN[2][2];
    PG8_LAS unsigned char* pk = park + wid * 1024;
#define PG8_PARK(u_) do { if constexpr (Rows::LOADS) { _Pragma("unroll") for (int i = 0; i < 2; ++i) { PG8_RC(i, R_, C_); (void)C_; _Pragma("unroll") for (int h = 0; h < 2; ++h) \
        __builtin_amdgcn_global_load_lds((const unsigned*)RW.addr(u_, h * HALF + R_), (PG8_LAS unsigned*)(pk + (h * 2 + i) * 256), 4, 0, 0); } } } while (0)
#define PG8_UNPARK(h, i) (*(const PG8_LAS int*)(pk + ((h) * 2 + (i)) * 256 + lane * 4))
#pragma unroll
    for (int i = 0; i < 2; ++i) { PG8_RC(i, R_, C_);
#pragma unroll
        for (int h = 0; h < 2; ++h) {
            if constexpr (Rows::LOADS) {
                voC[h][i] = Rows::row(RW.raw(cur, h * HALF + R_)) * (unsigned)(K * 2) + (unsigned)C_ * 2u;
                voN[h][i] = has_next ? Rows::row(RW.raw(nxt, h * HALF + R_)) * (unsigned)(K * 2) + (unsigned)C_ * 2u : voC[h][i];
            } else { voC[h][i] = (unsigned)(h * HALF + R_) * (KTM ? 128u : (unsigned)(K * 2)) + (unsigned)C_ * 2u; voN[h][i] = 0u; } } }
    if (has_nn) PG8_PARK(nn);
    acc_t acc[2][2][4][2];
#pragma unroll
    for (int a = 0; a < 2; ++a)
#pragma unroll
        for (int b = 0; b < 2; ++b)
#pragma unroll
            for (int m = 0; m < 4; ++m)
#pragma unroll
                for (int n = 0; n < 2; ++n) acc[a][b][m][n] = acc_t{};
    bf16x8 At[4][2], B0[2][2], B1[2][2]; float sc[4];
    i32x4 magic = {0x4B400000, 0x4B400000, 0x4B400000, 0x4B400000}; asm volatile("" : "+v"(magic));
    const char* cA = (const char*)A; if constexpr (!Rows::LOADS) cA += KTM ? (size_t)cur.tau * 262144 : (size_t)Rows::row(RW.raw0(cur)) * (size_t)(K * 2);
    const char* cB = (const char*)Bt + (size_t)cur.e * b_estride + (size_t)cur.pn * tstep;
    PG8_SPARK(cur, 0); if (has_next) PG8_SPARK(nxt, 1);
    PG8_STAGE(PG8_SB(0, 0), cB, voffB); PG8_STAGE(PG8_SB(0, 1), cB + hstep, voffB); PG8_STAGE(PG8_SA(0, 0), cA, voC[0]); PG8_STAGE(PG8_SA(0, 1), cA, voC[1]);
    if (wr == 1) PG8_BAR;
    PG8_WAIT_V(2); PG8_BAR;
    PG8_STAGE(PG8_SB(1, 0), cB + kstep, voffB); PG8_STAGE(PG8_SA(1, 0), cA + kstepA, voC[0]); PG8_STAGE(PG8_SB(1, 1), cB + hstep + kstep, voffB);
    PG8_WAIT_V(6); PG8_BAR;
    for (;;) {
        const char* nA = cA; if constexpr (!Rows::LOADS) { if (has_next) nA = (const char*)A + (KTM ? (size_t)nxt.tau * 262144 : (size_t)Rows::row(RW.raw0(nxt)) * (size_t)(K * 2)); }
        const char* nB = has_next ? (const char*)Bt + (size_t)nxt.e * b_estride + (size_t)nxt.pn * tstep : cB;
        for (int t = 0; t < nt; t += 2) {
            const bool last = (t == nt - 2);
            const char* a1 = cA + (size_t)(t + 1) * kstepA;
            const char* a2 = last ? nA : cA + (size_t)(t + 2) * kstepA; const char* b2 = last ? nB : cB + (size_t)(t + 2) * kstep;
            const char* a3 = a2 + kstepA; const char* b3 = b2 + kstep;
            unsigned v20[2], v21[2];
#pragma unroll
            for (int i = 0; i < 2; ++i) { if constexpr (Rows::LOADS) { v20[i] = last ? voN[0][i] : voC[0][i]; v21[i] = last ? voN[1][i] : voC[1][i]; } else { v20[i] = voC[0][i]; v21[i] = voC[1][i]; } }
            if constexpr (BS) { if (t == 2) PG8_SSUM(ui & 1); }
            PG8_LDB(B0, 0, 0); PG8_LDB(B1, 0, 1); PG8_SCHED; PG8_LDA(At, 0, 0); PG8_LDSC(sc, 0, t); PG8_STAGE(PG8_SA(1, 1), a1, voC[1]);
            PG8_WAIT_V(8); PG8_WAIT_L(0); PG8_BAR; PG8_MM2(0); PG8_BAR; PG8_SCHED;
            PG8_LDA(At, 0, 1); PG8_LDSC(sc, 1, t); PG8_STAGE(PG8_SB(0, 0), b2, voffB); PG8_STAGE(PG8_SB(0, 1), b2 + hstep, voffB); PG8_STAGE(PG8_SA(0, 0), a2, v20);
            PG8_WAIT_V(8); PG8_WAIT_L(0); PG8_BAR; PG8_MM2(1); PG8_BAR; PG8_SCHED;
            PG8_LDB(B0, 1, 0); PG8_LDB(B1, 1, 1); PG8_SCHED; PG8_LDA(At, 1, 0); PG8_LDSC(sc, 0, t + 1); PG8_STAGE(PG8_SA(0, 1), a2, v21);
            PG8_WAIT_V(8); PG8_WAIT_L(0); PG8_BAR; PG8_MM2(0); PG8_BAR; PG8_SCHED;
            PG8_LDA(At, 1, 1); PG8_LDSC(sc, 1, t + 1); PG8_STAGE(PG8_SB(1, 0), b3, voffB); PG8_STAGE(PG8_SB(1, 1), b3 + hstep, voffB); PG8_STAGE(PG8_SA(1, 0), a3, v20);
            PG8_WAIT_V(8); PG8_WAIT_L(0); PG8_BAR; PG8_MM2(1); PG8_BAR; PG8_SCHED;
        }
        if (wr == 0) PG8_BAR;
        if constexpr (BS) E(acc, cur, wr, wc, fr, fq, (const PG8_LAS float*)(spark - 2048 + (ui & 1) * 1024)); else E(acc, cur, wr, wc, fr, fq);
        if (!has_next) break;
#pragma unroll
        for (int a = 0; a < 2; ++a)
#pragma unroll
            for (int b = 0; b < 2; ++b)
#pragma unroll
                for (int m = 0; m < 4; ++m)
#pragma unroll
                    for (int n = 0; n < 2; ++n) acc[a][b][m][n] = acc_t{};
        cur = nxt; cB = nB; cA = nA; nxt = nn; has_next = has_nn; ++ui;
        has_nn = has_next && S.next(ui + 2, nn);
        if constexpr (Rows::LOADS) {
#pragma unroll
        for (int i = 0; i < 2; ++i) { PG8_RC(i, R_, C_);
#pragma unroll
            for (int h = 0; h < 2; ++h) { voC[h][i] = voN[h][i];
                if (has_next) voN[h][i] = Rows::row(PG8_UNPARK(h, i)) * (unsigned)(K * 2) + (unsigned)C_ * 2u; } }
        }
        if constexpr (Rows::LOADS) { PG8_WAIT_L(0); asm volatile("" ::: "memory"); }
        if (has_nn) PG8_PARK(nn);
        if (has_next) PG8_SPARK(nxt, (ui + 1) & 1);
        if (wr == 1) PG8_BAR;
    }
    PG8_WAIT_V(0);
    PG8_BAR;
#undef PG8_PARK
#undef PG8_MMA_BS
#undef PG8_LDSC
#undef PG8_SSUM
#undef PG8_MM2
#undef PG8_SPARK
#undef PG8_RC
#undef PG8_UNPARK
#undef PG8_SA
#undef PG8_SB
#undef PG8_STAGE
#undef PG8_LDA
#undef PG8_LDB
#undef PG8_MMA
#undef PG8_WAIT_V
#undef PG8_WAIT_L
#undef PG8_BAR
#undef PG8_SCHED
}
}
#include <hip/hip_bf16.h>
#include <cmath>
namespace attn_body {
using bf16=__hip_bfloat16;
using bf16x8=__attribute__((ext_vector_type(8)))short;
using s16x4=__attribute__((ext_vector_type(4)))short;
using f32x16=__attribute__((ext_vector_type(16)))float;
using u32x4=__attribute__((ext_vector_type(4)))unsigned;
typedef float f32x4_t __attribute__((ext_vector_type(4)));
constexpr int BATCH=4,NHEAD=16,SEQ=8192,KVR=SEQ+64,D=64,DM=NHEAD*D;
constexpr int NW=8,QBLK=32,QB=QBLK*NW,KVBLK=64,NQB=SEQ/QB;
constexpr int ATTN_PITCH=DM, ATTN_UNIT_ROWS=QB;
__device__ __forceinline__ int crow(int r,int hi){return (r&3)+8*(r>>2)+4*hi;}
#define SBAR() __builtin_amdgcn_sched_barrier(0)
__device__ __forceinline__ void cmask(f32x16&p0,f32x16&p1,int jb,int qrel,int hi){
  const float NEG=-INFINITY; int kb=64*jb+4*hi;
  #pragma unroll
  for(int r=0;r<16;++r){int kv=kb+(r&3)+8*(r>>2); if(kv>qrel)p0[r]=NEG; if(kv+32>qrel)p1[r]=NEG;}
}

constexpr int NSLOT=3, SLOTB=8192;
constexpr int LDS_K=0, LDS_V=NSLOT*SLOTB, LDS_WS=2*NSLOT*SLOTB, LDS_OST=LDS_WS+NW*64*4, LDS_BIAS=LDS_OST+NW*4096, LDS_KN=LDS_BIAS+KVR*4, LDS_QM=LDS_KN+132*4, LDS_BYTES=LDS_QM+32;
constexpr float SKIP_THR=24.f;
constexpr float C2=0.125f*1.4426950408889634f;
__device__ __forceinline__ void glds16(const void*gsrc,unsigned lds_dst){unsigned keep;
  asm volatile("s_mov_b32 %0, m0\n\ts_mov_b32 m0, %2\n\ts_nop 0\n\tglobal_load_lds_dwordx4 %1, off\n\ts_mov_b32 m0, %0":"=&s"(keep):"v"(gsrc),"s"(lds_dst):"memory");}
__device__ __forceinline__ float max3f(float a,float b,float c){float r;asm("v_max3_f32 %0, %1, %2, %3":"=v"(r):"v"(a),"v"(b),"v"(c));return r;}
__device__ __forceinline__ float max2f(float a,float b){float r;asm("v_max_f32_e32 %0, %1, %2":"=v"(r):"v"(a),"v"(b));return r;}
__device__ __forceinline__ float fadd_s(float a,float b){float r;asm("v_add_f32_e32 %0, %1, %2":"=v"(r):"v"(a),"v"(b));return r;}
__device__ __forceinline__ float fsub_s(float a,float b){float r;asm("v_sub_f32_e32 %0, %1, %2":"=v"(r):"v"(a),"v"(b));return r;}
typedef float f32x2_t __attribute__((ext_vector_type(2))); typedef __bf16 bf16x2_t __attribute__((ext_vector_type(2)));
__device__ __forceinline__ unsigned cvtpk_s(float lo,float hi){f32x2_t v={lo,hi};bf16x2_t b=__builtin_convertvector(v,bf16x2_t);return __builtin_bit_cast(unsigned,b);}
#define WAIT_BAR(N) asm volatile("s_waitcnt vmcnt(" #N ") lgkmcnt(0)\n\ts_barrier":::"memory")

__device__ __forceinline__ void qkt(f32x16&p0,f32x16&p1,const char*Kslot,const bf16x8*qr,int r32,int hi){
  const char*kb=Kslot+hi*1024+r32*16;
  #pragma unroll
  for(int d0=0;d0<4;++d0){
    const bf16x8 b0=*reinterpret_cast<const bf16x8*>(kb+d0*2048);
    const bf16x8 b1=*reinterpret_cast<const bf16x8*>(kb+d0*2048+512);
    {p0=__builtin_amdgcn_mfma_f32_32x32x16_bf16(b0,qr[d0],p0,0,0,0);p1=__builtin_amdgcn_mfma_f32_32x32x16_bf16(b1,qr[d0],p1,0,0,0);}}
}
typedef __attribute__((address_space(3))) const char* lds_cptr;
typedef short v4i16_t __attribute__((ext_vector_type(4)));
__device__ __forceinline__ void kload8(bf16x8*kf,lds_cptr kp){
  kf[0]=*(const __attribute__((address_space(3))) bf16x8*)(kp);      kf[1]=*(const __attribute__((address_space(3))) bf16x8*)(kp+512);
  kf[2]=*(const __attribute__((address_space(3))) bf16x8*)(kp+2048); kf[3]=*(const __attribute__((address_space(3))) bf16x8*)(kp+2560);
  kf[4]=*(const __attribute__((address_space(3))) bf16x8*)(kp+4096); kf[5]=*(const __attribute__((address_space(3))) bf16x8*)(kp+4608);
  kf[6]=*(const __attribute__((address_space(3))) bf16x8*)(kp+6144); kf[7]=*(const __attribute__((address_space(3))) bf16x8*)(kp+6656);
}
__device__ __forceinline__ void kload2(bf16x8*kf,lds_cptr kp,int j){ kf[2*j]=*(const __attribute__((address_space(3))) bf16x8*)(kp+j*2048); kf[2*j+1]=*(const __attribute__((address_space(3))) bf16x8*)(kp+j*2048+512); }
__device__ __forceinline__ s16x4 vtr(lds_cptr p){ return __builtin_bit_cast(s16x4,__builtin_amdgcn_ds_read_tr16_b64_v4i16((__attribute__((address_space(3))) v4i16_t*)p)); }
__device__ __forceinline__ float rowmax(const f32x16&p0,const f32x16&p1){
  float a=max3f(p0[0],p0[1],p1[0]),b=max3f(p0[2],p0[3],p1[1]);a=max3f(a,p1[2],p1[3]);
  #pragma unroll
  for(int r=4;r<16;r+=4){a=max3f(a,p0[r],p0[r+1]);b=max3f(b,p0[r+2],p0[r+3]);a=max3f(a,p1[r],p1[r+1]);b=max3f(b,p1[r+2],p1[r+3]);}
  const float m=max2f(a,b);
  auto rr=__builtin_amdgcn_permlane32_swap(__float_as_uint(m),__float_as_uint(m),false,false);
  return max2f(__uint_as_float(rr[0]),__uint_as_float(rr[1]));
}
__device__ __forceinline__ void pv(f32x16*o,int vb,bf16x8 pa0,bf16x8 pa1,bf16x8 pa2,bf16x8 pa3){
  #pragma unroll
  for(int d0=0;d0<2;++d0){s16x4 lo[4],hi[4];
    #pragma unroll
    for(int ks=0;ks<4;++ks){
      asm volatile("ds_read_b64_tr_b16 %0,%1 offset:%c2":"=&v"(lo[ks]):"v"(vb),"i"(d0*4096+ks*1024):"memory");
      asm volatile("ds_read_b64_tr_b16 %0,%1 offset:%c2":"=&v"(hi[ks]):"v"(vb),"i"(d0*4096+ks*1024+512):"memory");}
    asm volatile("s_waitcnt lgkmcnt(0)":::"memory");SBAR();
    #define PK(k) (bf16x8){lo[k][0],lo[k][1],lo[k][2],lo[k][3],hi[k][0],hi[k][1],hi[k][2],hi[k][3]}
    o[d0]=__builtin_amdgcn_mfma_f32_32x32x16_bf16(pa0,PK(0),o[d0],0,0,0);
    o[d0]=__builtin_amdgcn_mfma_f32_32x32x16_bf16(pa1,PK(1),o[d0],0,0,0);
    o[d0]=__builtin_amdgcn_mfma_f32_32x32x16_bf16(pa2,PK(2),o[d0],0,0,0);
    o[d0]=__builtin_amdgcn_mfma_f32_32x32x16_bf16(pa3,PK(3),o[d0],0,0,0);
    #undef PK
  }
}

#ifndef ATTN_STORE16
#define ATTN_STORE16(p,v) (*(u32x4*)(p)=(v))
#endif
__device__ __forceinline__ int attn_jstart(lds_cptr shm3,int ui,int q0,int lane){
  int jstart;
  { const __attribute__((address_space(3))) float*bl=(const __attribute__((address_space(3))) float*)(shm3+LDS_BIAS),*KN=(const __attribute__((address_space(3))) float*)(shm3+LDS_KN),*QM=(const __attribute__((address_space(3))) float*)(shm3+LDS_QM);
    const int NTf=1+(q0+QB)/KVBLK; const float qm2=QM[ui];
    const float kd2=__builtin_fmaxf(__builtin_fmaxf(KN[NTf-4],KN[NTf-3]),__builtin_fmaxf(KN[NTf-2],KN[NTf-1]));
    const float rhs=bl[64+q0]-__builtin_sqrtf(qm2*kd2)-SKIP_THR;
    unsigned long long mk[3];
    #pragma unroll
    for(int c=0;c<3;++c){ const int j=lane+64*c; bool keep=false;
      if(j<NTf-4){ const float bm=(j==0)?bl[15]:bl[64*j+63]; keep=!(__builtin_sqrtf(qm2*KN[j])+bm<rhs); }
      mk[c]=__ballot(keep); }
    int j0=NTf-4; if(mk[2])j0=128+__builtin_ctzll(mk[2]); if(mk[1])j0=64+__builtin_ctzll(mk[1]); if(mk[0])j0=__builtin_ctzll(mk[0]);
    if(j0>NTf-5)j0=NTf-5; jstart=__builtin_amdgcn_readfirstlane(j0&~1); }
  return jstart;
}
template<int THRL> __device__ __forceinline__ void attn_unit(int ui,int b,int h,int qb,const bf16*Q,const bf16*__restrict__ K,const bf16*__restrict__ V,bf16*O,char*shm,bool pre  ,int nui,int nqb  ){
  const int tid=::launder((int)threadIdx.x),lane=tid&63,r32=lane&31,hi=lane>>5; const int wid=__builtin_amdgcn_readfirstlane(tid>>6);
  const long rowbase=(long)b*SEQ, kvbase=(long)b*KVR; const int q0=qb*QB;
  const bf16*Qw=Q+(rowbase+q0+wid*QBLK)*DM+h*D;
  const lds_cptr shm3=(lds_cptr)shm;
  const int jstart=attn_jstart(shm3,ui,q0,lane);
  const bf16*Kh=K+(kvbase+(long)jstart*KVBLK)*DM+h*D,*Vh=V+(kvbase+(long)jstart*KVBLK)*DM+h*D;
  const unsigned lds0=(unsigned)(uintptr_t)shm;
  float*wsf=(float*)(shm+LDS_WS)+wid*64;
  const bf16*ksrc=Kh+(long)lane*DM+wid*8;
  const bf16*vsrc=Vh+(long)(16*(wid&3)+(lane>>2))*DM+(wid>>2)*32+(lane&3)*8;
  const unsigned kdst=lds0+LDS_K+wid*1024, vdst=lds0+LDS_V+wid*1024;
  #define DMA_K(t,slot) glds16(ksrc+(long)(t)*KVBLK*DM,(unsigned)__builtin_amdgcn_readfirstlane(kdst+(slot)))
  #define DMA_V(t,slot) glds16(vsrc+(long)(t)*KVBLK*DM,(unsigned)__builtin_amdgcn_readfirstlane(vdst+(slot)))
  const int vb0=(int)(lds0+LDS_V)+((lane>>4)&1)*32+(lane&3)*8+(4*hi+((lane&15)>>2))*64;
  const char*Kbase=shm+LDS_K; bf16x8 kf[8];
  const lds_cptr kp0=shm3+LDS_K+hi*1024+r32*16; const lds_cptr vp0=shm3+LDS_V+((lane>>4)&1)*32+(lane&3)*8+(4*hi+((lane&15)>>2))*64;
  const int NT=1+(q0+QB)/KVBLK-jstart;
  if(!pre){DMA_K(0,0);DMA_V(0,0);DMA_K(1,SLOTB);}
  bf16x8 qr[4];
  #pragma unroll
  for(int d0=0;d0<4;++d0)qr[d0]=*reinterpret_cast<const bf16x8*>(&Qw[(long)r32*DM+d0*16+hi*8]);
  const float mhat=*(const __attribute__((address_space(3))) float*)(shm3+LDS_BIAS+(64+q0+wid*QBLK+r32)*4); float l_reg=0.f;f32x16 o[2];o[0]=f32x16{};o[1]=f32x16{};
  const lds_cptr biasp=shm3+LDS_BIAS+jstart*256+hi*16;
  #define BINIT(P0,P1,tn) do{ const lds_cptr bp_=biasp+(tn)*256; _Pragma("unroll") for(int g_=0;g_<4;++g_){ \
      const f32x4_t v0_=*(const __attribute__((address_space(3))) f32x4_t*)(bp_+g_*32)-mhat, v1_=*(const __attribute__((address_space(3))) f32x4_t*)(bp_+128+g_*32)-mhat; \
      P0[4*g_]=v0_[0];P0[4*g_+1]=v0_[1];P0[4*g_+2]=v0_[2];P0[4*g_+3]=v0_[3]; P1[4*g_]=v1_[0];P1[4*g_+1]=v1_[1];P1[4*g_+2]=v1_[2];P1[4*g_+3]=v1_[3]; } }while(0)
  const int qrel=wid*QBLK+r32;
  #define CMASK(P0,P1,t) do{int jb_=(t)-(NT-4); if(jb_>=0)cmask(P0,P1,jb_,qrel,hi);}while(0)
  #define START(P0,P1) do{ _Pragma("unroll") for(int r=0;r<16;++r)P0[r]=__builtin_amdgcn_exp2f(P0[r]); }while(0)
  #define RESC() do{}while(0)
  f32x16 pA0,pA1,pB0,pB1;
  int sl_prev=0,sl_cur=0,sl_next=SLOTB;
  #define ROT() do{sl_prev=sl_cur;sl_cur=sl_next;sl_next=(sl_next==(NSLOT-1)*SLOTB)?0:sl_next+SLOTB;}while(0)
  if(!pre)DMA_K(2,2*SLOTB);
  WAIT_BAR(3);
  BINIT(pA0,pA1,0); qkt(pA0,pA1,Kbase,qr,r32,hi);asm volatile("s_nop 15\n\ts_nop 7":"+v"(pA0),"+v"(pA1));CMASK(pA0,pA1,0);
  START(pA0,pA1);
  BINIT(pB0,pB1,1);
  _Pragma("unroll") for(int r=0;r<16;++r)pA1[r]=__builtin_amdgcn_exp2f(pA1[r]);
  WAIT_BAR(0);
  DMA_K(3,0);DMA_V(1,SLOTB);
  ROT();
  kload8(kf,kp0+sl_cur);
  WAIT_BAR(2);
  s16x4 vlo[8],vhi[8]; u32x4 pw0,pw1,pw2,pw3;
  #define PKW(P,B) cvtpk_s(P[B],P[B+1])
  #define PAF(k) __builtin_bit_cast(bf16x8,pw##k)
  #define VFR(i) (bf16x8){vlo[i][0],vlo[i][1],vlo[i][2],vlo[i][3],vhi[i][0],vhi[i][1],vhi[i][2],vhi[i][3]}
  #define PIN(x) asm volatile("":"+v"(x))
  #define MX3(a,b,c) __builtin_fmaxf(__builtin_fmaxf((a),(b)),(c))
  #define GAPA(MF,A0,A1,A2,A3,W0,W1,PW) do{ MF; sacc+=A0; sacc+=A1; sacc+=A2; sacc+=A3; PIN(sacc); W0; W1; PIN(PW); SBAR(); }while(0)
  #define EX(v) __builtin_amdgcn_exp2f(v)
  #define GAPB(MF,X,B) do{ MF; X[B]=EX(X[B]); X[B+1]=EX(X[B+1]); X[B+2]=EX(X[B+2]); X[B+3]=EX(X[B+3]); PIN(X); SBAR(); }while(0)
  #define VRD(i) do{ vlo[i]=vtr(vp_+(((i)>>2)*4096+((i)&3)*1024)); vhi[i]=vtr(vp_+(((i)>>2)*4096+((i)&3)*1024+512)); }while(0)
  #define KRD(G,j) do{ if(G){ kload2(kf,kp0+sl_next,j); SBAR(); } }while(0)
  #define STEP(C0,C1,P0,P1,t,GK,GV,GL) do{ SBAR(); \
    const lds_cptr vp_=vp0+sl_prev; \
    VRD(0); SBAR(); float sacc=(P0[0]+P0[1]); \
    GAPA(C0=__builtin_amdgcn_mfma_f32_32x32x16_bf16(kf[0],qr[0],C0,0,0,0), P0[2],P0[3],P0[4],P0[5],     pw0[0]=PKW(P0,0), pw0[1]=PKW(P0,2), pw0); \
    VRD(4); SBAR(); GAPA(C1=__builtin_amdgcn_mfma_f32_32x32x16_bf16(kf[1],qr[0],C1,0,0,0), P0[6],P0[7],P0[8],P0[9],     pw0[2]=PKW(P0,4), pw0[3]=PKW(P0,6), pw0); \
    VRD(1); SBAR(); GAPA(C0=__builtin_amdgcn_mfma_f32_32x32x16_bf16(kf[2],qr[1],C0,0,0,0),   P0[10],P0[11],P0[12],P0[13], pw1[0]=PKW(P0,8), pw1[1]=PKW(P0,10), pw1); \
    VRD(5); SBAR(); GAPA(C1=__builtin_amdgcn_mfma_f32_32x32x16_bf16(kf[3],qr[1],C1,0,0,0),   P0[14],P0[15],P1[0],P1[1],   pw1[2]=PKW(P0,12),pw1[3]=PKW(P0,14), pw1); \
    VRD(2); SBAR(); GAPA(C0=__builtin_amdgcn_mfma_f32_32x32x16_bf16(kf[4],qr[2],C0,0,0,0),   P1[2],P1[3],P1[4],P1[5],     pw2[0]=PKW(P1,0), pw2[1]=PKW(P1,2), pw2); \
    VRD(6); SBAR(); GAPA(C1=__builtin_amdgcn_mfma_f32_32x32x16_bf16(kf[5],qr[2],C1,0,0,0),   P1[6],P1[7],P1[8],P1[9],     pw2[2]=PKW(P1,4), pw2[3]=PKW(P1,6), pw2); \
    VRD(3); SBAR(); GAPA(C0=__builtin_amdgcn_mfma_f32_32x32x16_bf16(kf[6],qr[3],C0,0,0,0),   P1[10],P1[11],P1[12],P1[13], pw3[0]=PKW(P1,8), pw3[1]=PKW(P1,10), pw3); \
    VRD(7); SBAR(); GAPA(C1=__builtin_amdgcn_mfma_f32_32x32x16_bf16(kf[7],qr[3],C1,0,0,0),   P1[14],P1[15],0.f,0.f,       pw3[2]=PKW(P1,12),pw3[3]=PKW(P1,14), pw3); \
    l_reg+=sacc; \
    if(GK){DMA_K((t)+3,sl_cur);} if(GV){DMA_V((t)+1,sl_next);} \
    CMASK(C0,C1,t); \
    SBAR(); \
    GAPB(o[0]=__builtin_amdgcn_mfma_f32_32x32x16_bf16(PAF(0),VFR(0),o[0],0,0,0), C0,0); \
    GAPB(o[1]=__builtin_amdgcn_mfma_f32_32x32x16_bf16(PAF(0),VFR(4),o[1],0,0,0), C0,4); \
    KRD(GL,0); GAPB(o[0]=__builtin_amdgcn_mfma_f32_32x32x16_bf16(PAF(1),VFR(1),o[0],0,0,0), C0,8); \
    KRD(GL,1); GAPB(o[1]=__builtin_amdgcn_mfma_f32_32x32x16_bf16(PAF(1),VFR(5),o[1],0,0,0), C0,12); \
    KRD(GL,2); GAPB(o[0]=__builtin_amdgcn_mfma_f32_32x32x16_bf16(PAF(2),VFR(2),o[0],0,0,0), C1,0); \
    KRD(GL,3); GAPB(o[1]=__builtin_amdgcn_mfma_f32_32x32x16_bf16(PAF(2),VFR(6),o[1],0,0,0), C1,4); \
    GAPB(o[0]=__builtin_amdgcn_mfma_f32_32x32x16_bf16(PAF(3),VFR(3),o[0],0,0,0), C1,8); \
    GAPB(o[1]=__builtin_amdgcn_mfma_f32_32x32x16_bf16(PAF(3),VFR(7),o[1],0,0,0), C1,12); \
    if(GL){ BINIT(P0,P1,(t)+1); } \
    }while(0)
  int t=1;
  #undef CMASK
  #define CMASK(P0,P1,t) do{}while(0)
  for(;t+5<NT;t+=2){
    STEP(pB0,pB1,pA0,pA1,t,true,true,true);     WAIT_BAR(2); RESC(); ROT();
    STEP(pA0,pA1,pB0,pB1,t+1,true,true,true);   WAIT_BAR(2); RESC(); ROT();
  }
  #undef CMASK
  #define CMASK(P0,P1,t) do{int jb_=(t)-(NT-4); if(jb_>=0)cmask(P0,P1,jb_,qrel,hi);}while(0)
  #define ENDW(tt) do{ if((tt)+3<NT){WAIT_BAR(2);} else if((tt)+2<NT){WAIT_BAR(1);} else {WAIT_BAR(0);} }while(0)
  for(;t+2<NT;t+=2){
    STEP(pB0,pB1,pA0,pA1,t,(t+3<NT),(t+1<NT),(t+1<NT));       ENDW(t);   RESC(); ROT();
    STEP(pA0,pA1,pB0,pB1,t+1,(t+4<NT),(t+2<NT),(t+2<NT));     ENDW(t+1); RESC(); ROT();
  }
  STEP(pB0,pB1,pA0,pA1,t,false,true,true);       ENDW(t);   RESC(); ROT();
  STEP(pA0,pA1,pB0,pB1,NT-1,false,false,false); RESC();
  { float sacc=pA0[0]+pA0[1]; _Pragma("unroll") for(int r=2;r<16;++r)sacc+=pA0[r]; _Pragma("unroll") for(int r=0;r<16;++r)sacc+=pA1[r]; l_reg+=sacc;
    pw0=(u32x4){PKW(pA0,0),PKW(pA0,2),PKW(pA0,4),PKW(pA0,6)};pw1=(u32x4){PKW(pA0,8),PKW(pA0,10),PKW(pA0,12),PKW(pA0,14)};pw2=(u32x4){PKW(pA1,0),PKW(pA1,2),PKW(pA1,4),PKW(pA1,6)};pw3=(u32x4){PKW(pA1,8),PKW(pA1,10),PKW(pA1,12),PKW(pA1,14)};
    SBAR(); pv(o,vb0+sl_cur,PAF(0),PAF(1),PAF(2),PAF(3)); }
  #undef PKW
  #undef PAF
  #undef VFR
  #undef PIN
  #undef MX3
  #undef GAPA
  #undef GAPB
  #undef EX
  #undef VRD
  #undef KRD
  #undef STEP
  #undef ENDW
  asm volatile("s_waitcnt lgkmcnt(0)\n\ts_barrier":::"memory");
  if(nqb>=0){ const int jn=attn_jstart(shm3,nui,nqb*QB,lane);
    const bf16*Kn=K+(kvbase+(long)jn*KVBLK)*DM+h*D+(long)lane*DM+wid*8; const bf16*Vn=V+(kvbase+(long)jn*KVBLK)*DM+h*D+(long)(16*(wid&3)+(lane>>2))*DM+(wid>>2)*32+(lane&3)*8;
    glds16(Kn,(unsigned)__builtin_amdgcn_readfirstlane(kdst)); glds16(Vn,(unsigned)__builtin_amdgcn_readfirstlane(vdst));
    glds16(Kn+(long)KVBLK*DM,(unsigned)__builtin_amdgcn_readfirstlane(kdst+SLOTB)); glds16(Kn+2L*KVBLK*DM,(unsigned)__builtin_amdgcn_readfirstlane(kdst+2*SLOTB)); }
  {auto rr=__builtin_amdgcn_permlane32_swap(__float_as_uint(l_reg),__float_as_uint(l_reg),false,false);l_reg=__uint_as_float(rr[0])+__uint_as_float(rr[1]);}
  if(hi==0)wsf[32+r32]=l_reg;asm volatile("s_waitcnt lgkmcnt(0)":::"memory");
  float rli[16];
  #pragma unroll
  for(int r=0;r<16;++r)rli[r]=__builtin_amdgcn_rcpf(wsf[32+crow(r,hi)]);
  bf16*Ow=O+(rowbase+q0+wid*QBLK)*DM+h*D;
  { bf16*stg=(bf16*)(shm+LDS_OST)+wid*2048;
    #pragma unroll
    for(int r=0;r<16;++r){const int orow=crow(r,hi);
      #pragma unroll
      for(int d0=0;d0<2;++d0)stg[orow*64+d0*32+r32]=__float2bfloat16(o[d0][r]*rli[r]);}
    asm volatile("s_waitcnt lgkmcnt(0)":::"memory");
    #pragma unroll
    for(int i=0;i<4;++i){const int row=i*8+(lane>>3),ch=lane&7; const u32x4 v=*(const u32x4*)(stg+row*64+ch*8); ATTN_STORE16(Ow+(long)row*DM+ch*8,v);} }
  if(nqb<0)asm volatile("s_waitcnt lgkmcnt(0)\n\ts_barrier":::"memory");
  #undef DMA_K
  #undef DMA_V
  #undef CMASK
  #undef START
  #undef RESC
  #undef ROT
  #undef BINIT
}
constexpr int ATTN_LDS_BYTES=LDS_BYTES;
struct AttnTensors { const bf16* Q; const bf16* K; const bf16* V; bf16* O; const float* KN2; const float* QN2; const float* KNM; };
struct AttnUnit { int bh; int qb; };
struct StaticOrder {
  int vcu;
  __device__ __forceinline__ explicit StaticOrder(int grid,int block):vcu((block%8)*(grid/8)+block/8){}
  __device__ __forceinline__ bool next(int i,AttnUnit&u)const{ if(i>=8)return false; const int s=vcu&3, base=8*(i>>1); u.bh=vcu>>2; u.qb=(i&1)?base+7-s:base+s; return true; }
  __device__ __forceinline__ void a_ready(const AttnUnit&)const{}
  __device__ __forceinline__ void done(const AttnUnit&)const{}
};
template<class Sched,int THRL=8> __device__ __forceinline__ void attn_phase(char*lds,const AttnTensors&T,const float*bias,const Sched&S){
  AttnUnit u;
  if(!S.next(0,u))return;
  typedef __attribute__((address_space(3))) unsigned lds_u32;
  const int tid=::launder((int)threadIdx.x);
  { const f32x4_t*src=(const f32x4_t*)(bias+(long)u.bh*KVR); f32x4_t*dst=(f32x4_t*)(lds+LDS_BIAS);
    for(int i=tid;i<KVR/4;i+=NW*64)dst[i]=src[i];
    if(tid<140)((lds_u32*)((lds_cptr)lds+LDS_KN))[tid]=0u;
    __syncthreads(); }
  { lds_u32*KNu=(lds_u32*)((lds_cptr)lds+LDS_KN),*QMu=(lds_u32*)((lds_cptr)lds+LDS_QM);
    const int bb_=u.bh/NHEAD, hh_=u.bh%NHEAD;
    for(int row=tid;row<KVR;row+=NW*64){ float ss;
      if(row<64){ ss=0.f; if(row<16){ const f32x4_t q4=*(const f32x4_t*)(T.KNM+(row*NHEAD+hh_)*4); ss=(q4[0]+q4[1])+(q4[2]+q4[3]); } }
      else { const f32x2_t h2=*(const f32x2_t*)(T.KN2+((long)hh_*((long)::NB*KVR)+(long)bb_*KVR+row)*2); ss=h2[0]+h2[1]; }
      __hip_atomic_fetch_max(KNu+(row>>6),__float_as_uint(ss),__ATOMIC_RELAXED,__HIP_MEMORY_SCOPE_WORKGROUP); }
    for(int r=tid;r<8*QB;r+=NW*64){ AttnUnit v; if(!S.next(r>>8,v))break;
      const f32x2_t h2=*(const f32x2_t*)(T.QN2+((long)(v.bh%NHEAD)*(long)::M+(long)(v.bh/NHEAD)*SEQ+(long)v.qb*QB+(r&255))*2); const float ss=h2[0]+h2[1];
      __hip_atomic_fetch_max(QMu+(r>>8),__float_as_uint(ss),__ATOMIC_RELAXED,__HIP_MEMORY_SCOPE_WORKGROUP); }
    __syncthreads(); }
  for(int i=0;S.next(i,u);++i){ AttnUnit un; const bool hn=S.next(i+1,un); S.a_ready(u); attn_unit<THRL>(i,u.bh/NHEAD,u.bh%NHEAD,u.qb,T.Q,T.K,T.V,T.O,lds,i>0,i+1,hn?un.qb:-1); S.done(u); }
}
#undef SBAR
#undef WAIT_BAR
}
constexpr int NWAVES = 8;
constexpr int RING_OFF = 0, RING_BYTES = 131072;
constexpr int LDSCTL_OFF = RING_BYTES, MISC_OFF = LDSCTL_OFF + 320;
constexpr int LDS_BYTES = 163840;
constexpr int CW_TMO = 0, CW_CODE = 1;
constexpr int CW_BAR = 4096;
#define GAS __attribute__((address_space(1)))
#define LAS __attribute__((address_space(3)))
typedef unsigned v4u __attribute__((ext_vector_type(4)));
typedef GAS unsigned gu32;
#define RLX_AGENT __ATOMIC_RELAXED, __HIP_MEMORY_SCOPE_AGENT
#define LDS_WAIT() asm volatile("s_waitcnt lgkmcnt(0)" ::: "memory")
#define VM_WAIT() asm volatile("s_waitcnt vmcnt(0)" ::: "memory")
#define XB_TMO      128
#define XB_XCNT(j)  (256  + 64 * (j))
#define XB_XSUB(j)  (1280 + 64 * (j))
#define XB_XGEN(j)  (2304 + 64 * (j))
#define XB_TOP      3328
#define XB_TOPGEN   3392
#define XCD_BAR_WORDS 3456
#define XB_SPIN_CAP (1u << 18)

__device__ __forceinline__ unsigned xb_ld(unsigned* p)              { return __hip_atomic_load(p, __ATOMIC_RELAXED, __HIP_MEMORY_SCOPE_AGENT); }
__device__ __forceinline__ unsigned xb_add(unsigned* p, unsigned v) { return __hip_atomic_fetch_add(p, v, __ATOMIC_RELAXED, __HIP_MEMORY_SCOPE_AGENT); }
__device__ __forceinline__ unsigned xb_xcc_id() { return (unsigned)__builtin_amdgcn_s_getreg((3 << 11) | 20) & 0xFu; }
#define XB_SPIN(cond, bar) do { unsigned _sp = 0; while (cond) { __builtin_amdgcn_s_sleep(1); \
    if ((++_sp & 255u) == 0u) { if (xb_ld(&(bar)[XB_TMO])) break; if (_sp > XB_SPIN_CAP) { atomicAdd(&(bar)[XB_TMO], 1u); break; } } } } while (0)

struct XcdBarrier {
    unsigned* bar; unsigned x;
    volatile LAS unsigned* st;
};

__device__ __forceinline__ XcdBarrier xcd_barrier_post(unsigned* bar, volatile LAS unsigned* st) {
    XcdBarrier b; b.bar = bar; b.x = xb_xcc_id(); b.st = st;
    if (threadIdx.x == 0) (void)xb_add(&bar[XB_XCNT(b.x)], 1u);
    return b;
}
__device__ __forceinline__ void xcd_barrier_complete(unsigned* bar, unsigned x, unsigned& nloc, unsigned& nx) {
    const unsigned G = gridDim.x * gridDim.y * gridDim.z;
    unsigned sum, cnt, mine, sp = 0u;
    for (;;) {
        sum = 0u; cnt = 0u; mine = 0u;
#pragma unroll
        for (unsigned j = 0; j < 16; ++j) { const unsigned c = xb_ld(&bar[XB_XCNT(j)]); sum += c; cnt += (c > 0u) ? 1u : 0u; mine = (j == x) ? c : mine; }
        if (sum == G) break;
        __builtin_amdgcn_s_sleep(1);
        if ((++sp & 255u) == 0u) { if (xb_ld(&bar[XB_TMO])) break; if (sp > XB_SPIN_CAP) { atomicAdd(&bar[XB_TMO], 1u); break; } }
    }
    nloc = mine > 0u ? mine : 1u; nx = cnt > 0u ? cnt : 1u;
}

__device__ __forceinline__ void xcd_barrier(const XcdBarrier& b) {
    asm volatile("s_waitcnt vmcnt(0)" ::: "memory");
    __syncthreads();
    if (threadIdx.x == 0) {
        unsigned* bar = b.bar;
        __builtin_amdgcn_s_waitcnt(0);
        unsigned nloc = b.st[0], nx = b.st[1];
        if (nloc == 0u) { xcd_barrier_complete(bar, b.x, nloc, nx); b.st[0] = nloc; b.st[1] = nx; }
        const unsigned old = xb_add(&bar[XB_XSUB(b.x)], 1u);
        const unsigned gen = old / nloc;
        if (old + 1u == (gen + 1u) * nloc) {
            __builtin_amdgcn_fence(__ATOMIC_RELEASE, "agent");
            asm volatile("s_waitcnt vmcnt(0)" ::: "memory");
            const unsigned og = xb_add(&bar[XB_TOP], 1u);
            const unsigned tg = og / nx;
            if (og + 1u == (tg + 1u) * nx) xb_add(&bar[XB_TOPGEN], 1u);
            else XB_SPIN(xb_ld(&bar[XB_TOPGEN]) == tg, bar);
            __builtin_amdgcn_fence(__ATOMIC_ACQUIRE, "agent");
            xb_add(&bar[XB_XGEN(b.x)], 1u);
            asm volatile("s_waitcnt vmcnt(0)" ::: "memory");
        } else {
            XB_SPIN(xb_ld(&bar[XB_XGEN(b.x)]) == gen, bar);
            __builtin_amdgcn_fence(__ATOMIC_ACQUIRE, "agent");
            asm volatile("s_waitcnt vmcnt(0)" ::: "memory");
        }
    }
    __syncthreads();
}

struct Frame {
    LAS unsigned char* lds;
    volatile LAS unsigned* MISC;
    gu32* ctl;
    int tid, lane, wave, vcu, G;
};
struct Args { const float* in[20]; float* out; unsigned char* ws; int ph_lo, ph_hi; };
struct KA {
    unsigned long long base;
    __device__ __forceinline__ const float* in(int i) const { return (const float*)(const __attribute__((address_space(1))) float*)((const __attribute__((address_space(4))) unsigned long long*)base)[i]; }
    __device__ __forceinline__ float* out() const { return (float*)(__attribute__((address_space(1))) float*)((const __attribute__((address_space(4))) unsigned long long*)base)[20]; }
    __device__ __forceinline__ unsigned char* ws() const { return (unsigned char*)(__attribute__((address_space(1))) unsigned char*)((const __attribute__((address_space(4))) unsigned long long*)base)[21]; }
};
__device__ __forceinline__ KA kargs() {
#if defined(__HIP_DEVICE_COMPILE__)
    unsigned long long p = (unsigned long long)__builtin_amdgcn_kernarg_segment_ptr(); asm volatile("" : "+s"(p));
    return KA{p};
#else
    return KA{0ull};
#endif
}

struct P0Item { const float* W; size_t ldw; bf16_t* WT; };
__device__ __forceinline__ void p0_item_load(const P0Item& it, int lane, f32x4 (&r)[8]) {
#pragma unroll
    for (int i = 0; i < 8; ++i) r[i] = __builtin_nontemporal_load((const f32x4*)(it.W + (size_t)(8 * i + (lane >> 3)) * it.ldw + 4 * (lane & 7)));
}
__device__ __forceinline__ void p0_item_store(const P0Item& it, int K, LAS float* scr, int lane, const f32x4 (&r)[8]) {
#pragma unroll
    for (int i = 0; i < 8; ++i) { LAS float* d = scr + (8 * i + (lane >> 3)) * 33 + 4 * (lane & 7); d[0] = r[i].x; d[1] = r[i].y; d[2] = r[i].z; d[3] = r[i].w; }
    LDS_WAIT(); asm volatile("" ::: "memory");
    const int c = lane & 7;
#pragma unroll
    for (int j = 0; j < 4; ++j) { const int n = (lane >> 3) + 8 * j; const LAS float* s = scr + (8 * c) * 33 + n;
        v4u o; o.x = pk2(s[0 * 33], s[1 * 33]); o.y = pk2(s[2 * 33], s[3 * 33]); o.z = pk2(s[4 * 33], s[5 * 33]); o.w = pk2(s[6 * 33], s[7 * 33]);
        *(GAS v4u*)(it.WT + (size_t)n * K + 8 * c) = o; }
    LDS_WAIT(); asm volatile("" ::: "memory");
}
__device__ __forceinline__ int glu_src_col(int r) { return ((r >> 7) & 1) * 1024 + (r >> 8) * 128 + (r & 127); }

__device__ __forceinline__ void p0_rows_wg(Frame& F, const KA& A, unsigned char* ws) {
    const int lane = F.lane, wave = F.wave, fr = lane & 15, fq = lane >> 4, c0 = wave * 128 + 8 * fq;
    LAS float* xs = (LAS float*)(F.lds + RING_OFF);
    LAS float* pacc = (LAS float*)(F.lds + RING_OFF + 4096);
    f32x4 gv[4][2]; u32x4 wh[4], wl[4];
    { const float* g = A.in(2); const float* wp = A.in(3) + (size_t)c0 * IN_COLS + OFF_F + fr;
#pragma unroll
      for (int s_ = 0; s_ < 4; ++s_) { gv[s_][0] = *(const f32x4*)(g + c0 + 32 * s_); gv[s_][1] = *(const f32x4*)(g + c0 + 32 * s_ + 4);
        float wv[8];
#pragma unroll
        for (int j = 0; j < 8; ++j) wv[j] = wp[(size_t)(32 * s_ + j) * IN_COLS];
        u32x4 h_; h_.x = pk2(wv[0], wv[1]); h_.y = pk2(wv[2], wv[3]); h_.z = pk2(wv[4], wv[5]); h_.w = pk2(wv[6], wv[7]);
        u32x4 l_;
        l_.x = pk2(wv[0] - __builtin_bit_cast(float, h_.x << 16), wv[1] - __builtin_bit_cast(float, h_.x & 0xffff0000u)); l_.y = pk2(wv[2] - __builtin_bit_cast(float, h_.y << 16), wv[3] - __builtin_bit_cast(float, h_.y & 0xffff0000u));
        l_.z = pk2(wv[4] - __builtin_bit_cast(float, h_.z << 16), wv[5] - __builtin_bit_cast(float, h_.z & 0xffff0000u)); l_.w = pk2(wv[6] - __builtin_bit_cast(float, h_.w << 16), wv[7] - __builtin_bit_cast(float, h_.w & 0xffff0000u));
        wh[s_] = h_; wl[s_] = l_; } }
    const float bbh = A.in(4)[OFF_F + 4 * (wave & 3) + (lane & 3)];
    constexpr int NGRP = M / 16 + 1;
    int grp = F.vcu, par = 0; f32x4 h[4][2];
    { const float* src = (grp < M / 16 ? A.in(0) + (size_t)grp * 16 * D : A.in(1)) + (size_t)fr * D + c0;
#pragma unroll
      for (int s_ = 0; s_ < 4; ++s_) { h[s_][0] = *(const f32x4*)(src + 32 * s_); h[s_][1] = *(const f32x4*)(src + 32 * s_ + 4); } }
    for (; grp < NGRP; grp += F.G, par ^= 1) {
        const int nx = grp + F.G; f32x4 hn[4][2];
        if (nx < NGRP) { const float* src = (nx < M / 16 ? A.in(0) + (size_t)nx * 16 * D : A.in(1)) + (size_t)fr * D + c0;
#pragma unroll
            for (int s_ = 0; s_ < 4; ++s_) { hn[s_][0] = *(const f32x4*)(src + 32 * s_); hn[s_][1] = *(const f32x4*)(src + 32 * s_ + 4); } }
        float ss = 0.f, amax = 0.f; f32x4 v[4][2];
#pragma unroll
        for (int s_ = 0; s_ < 4; ++s_)
#pragma unroll
            for (int t = 0; t < 2; ++t) { const f32x4 x_ = h[s_][t]; ss += (x_.x * x_.x + x_.y * x_.y) + (x_.z * x_.z + x_.w * x_.w);
                v[s_][t] = x_ * gv[s_][t]; const f32x4 a_ = __builtin_elementwise_abs(v[s_][t]); amax = fmaxf(amax, fmaxf(fmaxf(a_.x, a_.y), fmaxf(a_.z, a_.w))); }
        ss += __shfl_xor(ss, 16); ss += __shfl_xor(ss, 32);
        amax = fmaxf(amax, __shfl_xor(amax, 16)); amax = fmaxf(amax, __shfl_xor(amax, 32));
        LAS float* xp = xs + par * 256;
        if (fq == 0) { xp[(wave * 16 + fr) * 2] = ss; xp[(wave * 16 + fr) * 2 + 1] = amax; }
        __syncthreads();
        float sst = 0.f, amt = 0.f;
#pragma unroll
        for (int w2 = 0; w2 < NWAVES; ++w2) { sst += xp[(w2 * 16 + fr) * 2]; amt = fmaxf(amt, xp[(w2 * 16 + fr) * 2 + 1]); }
        const float qinv = amt > 0.f ? 127.f / amt : 0.f;
        const bool is_x = grp < M / 16;
        unsigned char* op = (is_x ? ws + WS_XN + (size_t)grp * 16 * D : ws + WS_XNM) + (size_t)fr * D + c0;
        pg8::f32x4 acc = {0.f, 0.f, 0.f, 0.f};
#pragma unroll
        for (int s_ = 0; s_ < 4; ++s_) { const f32x4 v0 = v[s_][0], v1 = v[s_][1];
            u32x4 hi; hi.x = pk2(v0.x, v0.y); hi.y = pk2(v0.z, v0.w); hi.z = pk2(v1.x, v1.y); hi.w = pk2(v1.z, v1.w);
            { const f32x4 q0 = v0 * qinv, q1 = v1 * qinv; u32x2 q8; q8.x = pk4_i8(q0.x, q0.y, q0.z, q0.w); q8.y = pk4_i8(q1.x, q1.y, q1.z, q1.w); *(u32x2*)(op + 32 * s_) = q8; }
            u32x4 lo;
            lo.x = pk2(v0.x - __builtin_bit_cast(float, hi.x << 16), v0.y - __builtin_bit_cast(float, hi.x & 0xffff0000u)); lo.y = pk2(v0.z - __builtin_bit_cast(float, hi.y << 16), v0.w - __builtin_bit_cast(float, hi.y & 0xffff0000u));
            lo.z = pk2(v1.x - __builtin_bit_cast(float, hi.z << 16), v1.y - __builtin_bit_cast(float, hi.z & 0xffff0000u)); lo.w = pk2(v1.z - __builtin_bit_cast(float, hi.w << 16), v1.w - __builtin_bit_cast(float, hi.w & 0xffff0000u));
            const bf16x8 ah = __builtin_bit_cast(bf16x8, hi), al = __builtin_bit_cast(bf16x8, lo), bh = __builtin_bit_cast(bf16x8, wh[s_]), bl = __builtin_bit_cast(bf16x8, wl[s_]);
            acc = __builtin_amdgcn_mfma_f32_16x16x32_bf16(ah, bh, acc, 0, 0, 0); acc = __builtin_amdgcn_mfma_f32_16x16x32_bf16(al, bh, acc, 0, 0, 0); acc = __builtin_amdgcn_mfma_f32_16x16x32_bf16(ah, bl, acc, 0, 0, 0); }
#pragma unroll
        for (int r = 0; r < 4; ++r) pacc[(wave * 4 + r) * 64 + lane] = acc[r];
        __syncthreads();
        if (wave < 4) {
            const int row = lane >> 2, hd = 4 * wave + (lane & 3); float z = 0.f, ssr = 0.f;
#pragma unroll
            for (int w2 = 0; w2 < NWAVES; ++w2) { z += pacc[(w2 * 4 + (row & 3)) * 64 + (row >> 2) * 16 + hd]; ssr += xp[(w2 * 16 + row) * 2]; }
            z = z * rsqrtf(ssr * (1.f / D) + RMS_EPS) + bbh;
            float lf = fminf(z, 0.f) - log1pf(expf(-fabsf(z)));
            (is_x ? (float*)(ws + WS_LOGF) + (size_t)grp * 256 : (float*)(ws + WS_LOGFM))[row * 16 + hd] = lf;
            lf += __shfl_xor(lf, 4); lf += __shfl_xor(lf, 8); lf += __shfl_xor(lf, 16); lf += __shfl_xor(lf, 32);
            if (is_x && lane < 4) ((float*)(ws + WS_GSUM))[grp * 16 + hd] = lf;
        } else if (wave == 4 && fq == 0) {
            ((float*)(ws + WS_RSX) + (is_x ? grp * 16 : M))[fr] = rsqrtf(sst * (1.f / D) + RMS_EPS) * amt * (1.f / 127.f);
        }
#pragma unroll
        for (int s_ = 0; s_ < 4; ++s_) { h[s_][0] = hn[s_][0]; h[s_][1] = hn[s_][1]; }
    }
    __syncthreads();
}

constexpr int I_SQ = 16 * 32, N_ITEMS = 3 * I_SQ, N_STRIPS = NE * 64, N_STRIPS_IN = 224, N_STRIPS_DN = NE * 32;
__device__ __forceinline__ P0Item p0_item(const KA& A, unsigned char* ws, int it) {
    int r = it;
    if (r < 3 * I_SQ) { const int w = r / I_SQ, rr = r % I_SQ, kb = rr / 32, nb = rr % 32; const float* src = w == 0 ? A.in(9) : w == 1 ? A.in(10) : A.in(11); bf16_t* dst = (bf16_t*)(ws + (w == 0 ? WS_WCO_T : w == 1 ? WS_WAO_T : WS_WMIX_T));
        return P0Item{src + (size_t)(64 * kb) * D + 32 * nb, (size_t)D, dst + (size_t)(32 * nb) * D + 64 * kb}; }
    return P0Item{nullptr, 0, nullptr};
}
struct P0Strip { const float* W0; size_t ldw; unsigned char* Wq; float* SB; };
__device__ __forceinline__ void p0_strip_load(const P0Strip& st, int wave, int lane, f32x4 (&r0)[8], f32x4 (&r1)[8]) {
    const P0Item i0{st.W0 + (size_t)(64 * (2 * wave)) * st.ldw, st.ldw, nullptr}, i1{st.W0 + (size_t)(64 * (2 * wave + 1)) * st.ldw, st.ldw, nullptr}; p0_item_load(i0, lane, r0); p0_item_load(i1, lane, r1);
}
__device__ __forceinline__ void p0_strip_finish(const P0Strip& st, LAS unsigned char* ring, int wave, int lane, int parity, const f32x4 (&r0)[8], const f32x4 (&r1)[8]) {
    LAS float* scr = (LAS float*)(ring + wave * 16384);
    f32x4 mx = {0.f, 0.f, 0.f, 0.f};
#pragma unroll
    for (int i = 0; i < 8; ++i) mx = __builtin_elementwise_max(mx, __builtin_elementwise_max(__builtin_elementwise_abs(r0[i]), __builtin_elementwise_abs(r1[i])));
#pragma unroll
    for (int o = 8; o < 64; o <<= 1) { f32x4 t; t.x = __shfl_xor(mx.x, o); t.y = __shfl_xor(mx.y, o); t.z = __shfl_xor(mx.z, o); t.w = __shfl_xor(mx.w, o); mx = __builtin_elementwise_max(mx, t); }
    const int c = lane & 7, xoff = 8448 + 64 + parity * 128;
    if (lane < 8) *(LAS f32x4*)(ring + wave * 16384 + xoff + 16 * lane) = mx;
    __syncthreads();
#pragma unroll
    for (int w2 = 0; w2 < NWAVES; ++w2) mx = __builtin_elementwise_max(mx, *(const LAS f32x4*)(ring + w2 * 16384 + xoff + 16 * c));
    f32x4 inv; inv.x = mx.x > 0.f ? 127.f / mx.x : 0.f; inv.y = mx.y > 0.f ? 127.f / mx.y : 0.f; inv.z = mx.z > 0.f ? 127.f / mx.z : 0.f; inv.w = mx.w > 0.f ? 127.f / mx.w : 0.f;
    if (wave == 0 && lane < 8) *(f32x4*)(st.SB + 4 * lane) = mx * (1.f / 127.f);
#pragma unroll
    for (int half = 0; half < 2; ++half) { const int kb = 2 * wave + half;
#pragma unroll
        for (int i = 0; i < 8; ++i) { const f32x4 q = (half ? r1[i] : r0[i]) * inv; LAS float* d = scr + (8 * i + (lane >> 3)) * 33 + 4 * c; d[0] = q.x; d[1] = q.y; d[2] = q.z; d[3] = q.w; }
        LDS_WAIT(); asm volatile("" ::: "memory");
#pragma unroll
        for (int j = 0; j < 4; ++j) { const int n = (lane >> 3) + 8 * j; const LAS float* sp = scr + (8 * c) * 33 + n;
            u32x2 o; o.x = pk4_i8(sp[0 * 33], sp[1 * 33], sp[2 * 33], sp[3 * 33]); o.y = pk4_i8(sp[4 * 33], sp[5 * 33], sp[6 * 33], sp[7 * 33]);
            *(GAS u32x2*)(st.Wq + (size_t)n * 1024 + 64 * kb + 8 * c) = o; }
        LDS_WAIT(); asm volatile("" ::: "memory");
    }
}
__device__ __forceinline__ bool p0_strip_desc(const KA& A, unsigned char* ws, int vcu, int G, int s, P0Strip& st) {
    const int n_in = (vcu < N_STRIPS_IN) ? (N_STRIPS_IN - vcu + G - 1) / G : 0, n_gu = (vcu < N_STRIPS) ? (N_STRIPS - vcu + G - 1) / G : 0;
    if (s < n_in) { const int drow = 32 * (vcu + s * G), scol = drow < 2048 ? glu_src_col(drow) : (drow < 5120 ? drow : drow + 16);
        st = P0Strip{A.in(3) + scol, (size_t)IN_COLS, ws + WS_WIN_T + (size_t)drow * 1024, (float*)(ws + WS_SBIN) + drow}; return true; }
    s -= n_in;
    if (s < n_gu) { const int gi = (N_STRIPS % (8 * G) == 0) ? ((s >> 3) * G + vcu) * 8 + (s & 7) : vcu + s * G, e = gi >> 6, drow = 32 * (gi & 63);
        st = P0Strip{A.in(15) + (size_t)e * D * 2048 + glu_src_col(drow), (size_t)2048, ws + WS_WGU_T + ((size_t)e * 2048 + drow) * 1024, (float*)(ws + WS_SBGU) + e * 2048 + drow}; return true; }
    s -= n_gu;
    const int gi = (N_STRIPS_DN % (4 * G) == 0) ? ((s >> 2) * G + vcu) * 4 + (s & 3) : vcu + s * G; if (gi >= N_STRIPS_DN) return false;
    const int e = gi >> 5, drow = 32 * (gi & 31);
    st = P0Strip{A.in(17) + (size_t)e * D * D + drow, (size_t)D, ws + WS_WDN_T + ((size_t)e * 1024 + drow) * 1024, (float*)(ws + WS_SBDN) + e * 1024 + drow}; return true;
}
__device__ __forceinline__ void p0_prologue(Frame& F, const KA& A) {
    unsigned char* ws = A.ws();
    LAS float* scr = (LAS float*)(F.lds + RING_OFF + F.wave * 16384);
    const int gw = F.vcu * NWAVES + F.wave, NGW = F.G * NWAVES;
    {
        int it = gw; f32x4 r[8]; P0Item cur{nullptr, 0, nullptr};
        if (it < N_ITEMS) { cur = p0_item(A, ws, it); p0_item_load(cur, F.lane, r); }
        while (it < N_ITEMS) {
            const int nx = it + NGW; f32x4 rn[8]; P0Item nxt{nullptr, 0, nullptr};
            if (nx < N_ITEMS) { nxt = p0_item(A, ws, nx); p0_item_load(nxt, F.lane, rn); }
            p0_item_store(cur, D, scr, F.lane, r);
#pragma unroll
            for (int i = 0; i < 8; ++i) r[i] = rn[i];
            cur = nxt; it = nx;
        }
    }
    {
        P0Strip cur{nullptr, 0, nullptr, nullptr}, nxt{nullptr, 0, nullptr, nullptr}; f32x4 r0[8], r1[8];
        bool have = p0_strip_desc(A, ws, F.vcu, F.G, 0, cur);
        if (have) p0_strip_load(cur, F.wave, F.lane, r0, r1);
        for (int si = 0; have; ++si) {
#pragma unroll
            for (int i = 0; i < 8; ++i) asm volatile("" : "+v"(r0[i]), "+v"(r1[i]));
            f32x4 n0[8], n1[8];
            const bool hn = p0_strip_desc(A, ws, F.vcu, F.G, si + 1, nxt);
            if (hn) p0_strip_load(nxt, F.wave, F.lane, n0, n1);
            p0_strip_finish(cur, F.lds + RING_OFF, F.wave, F.lane, si & 1, r0, r1);
#pragma unroll
            for (int i = 0; i < 8; ++i) { r0[i] = n0[i]; r1[i] = n1[i]; }
            cur = nxt; have = hn;
        }
        __syncthreads();
    }
    p0_rows_wg(F, A, ws);
    for (int i = gw * 64 + F.lane; i < NE * D; i += NGW * 64) {
        const int e = i / D, k = i % D; const float w = A.in(13)[(size_t)k * NE + e]; const unsigned hi = f2bf(w);
        ((bf16_t*)(ws + WS_WR_T))[i] = (bf16_t)hi; ((bf16_t*)(ws + WS_WR_T))[NE * D + i] = (bf16_t)f2bf(w - __builtin_bit_cast(float, hi << 16));
    }
    for (int r = gw; r < 2 * NB * 48; r += NGW) {
        const int kv = r / (NB * 48), rr = r % (NB * 48), b = rr / 48, row = 16 + rr % 48;
        bf16_t* p = (bf16_t*)(ws + (kv ? WS_V : WS_K)) + ((size_t)b * KVROWS + row) * D + 16 * F.lane;
        const v4u z = {0u, 0u, 0u, 0u}; *(GAS v4u*)p = z; *(GAS v4u*)(p + 8) = z;
    }
}

__device__ __forceinline__ void p1_scan(Frame& F, const KA& A) {
    if (F.vcu >= NB * 64) return;
    const int b = F.vcu >> 6, seg = F.vcu & 63, t = F.tid, head = t & 15, pc = t >> 4;
    const float* LOGF = (const float*)(A.ws() + WS_LOGF); const float* LOGFm = (const float*)(A.ws() + WS_LOGFM); const float* GSUM = (const float*)(A.ws() + WS_GSUM);
    float* outb = (float*)(A.ws() + WS_BIAS) + (size_t)(b * NH + head) * KVROWS;
    LAS float* part = (LAS float*)(F.lds + RING_OFF);
    const float* src = LOGF + ((size_t)b * SEQ + seg * 128 + 4 * pc) * 16 + head;
    const float v0 = src[0], v1 = src[16], v2 = src[32], v3 = src[48];
    float pre = 0.f;
    { float gq[16];
#pragma unroll
      for (int i = 0; i < 16; ++i) { const int j = pc + 32 * i; gq[i] = j < seg * 8 ? GSUM[(size_t)(b * (SEQ / 16) + j) * 16 + head] : 0.f; }
#pragma unroll
      for (int i = 0; i < 16; ++i) pre += gq[i]; }
    float cm = 0.f;
    { float mq[NMETA];
#pragma unroll
      for (int j = 0; j < NMETA; ++j) mq[j] = LOGFm[j * 16 + head];
#pragma unroll
      for (int j = 0; j < NMETA; ++j) { cm += mq[j]; if (seg == 0 && pc == 0) outb[j] = -cm * LOG2E; } }
    if (seg == 0) for (int idx = t; idx < NH * 48; idx += NWAVES * 64) ((float*)(A.ws() + WS_BIAS) + (size_t)(b * NH + idx / 48) * KVROWS)[16 + idx % 48] = NEG_BIG;
    pre += __shfl_xor(pre, 16); pre += __shfl_xor(pre, 32);
    const float c0 = v0, c1 = c0 + v1, c2 = c1 + v2, c3 = c2 + v3;
    part[pc * 16 + head] = c3; if (F.lane < 16) part[512 + F.wave * 16 + head] = pre;
    __syncthreads();
    float base = cm;
#pragma unroll
    for (int w = 0; w < NWAVES; ++w) base += part[512 + w * 16 + head];
    for (int c = 0; c < pc; ++c) base += part[c * 16 + head];
    { f32x4 o; o.x = -(base + c0) * LOG2E; o.y = -(base + c1) * LOG2E; o.z = -(base + c2) * LOG2E; o.w = -(base + c3) * LOG2E; *(f32x4*)(outb + 64 + seg * 128 + 4 * pc) = o; }
    __syncthreads();
}
__device__ __forceinline__ void p1_meta(Frame& F, const KA& A) {
    if (F.vcu >= 192) return;
    const int lane = F.lane, fr = lane & 15, fq = lane >> 4;
    const unsigned char* XNm = A.ws() + WS_XNM; const unsigned char* Wq = A.ws() + WS_WIN_T; const float* b_in = A.in(4); const float* SB = (const float*)(A.ws() + WS_SBIN);
    const int kind = F.vcu >> 6, c = F.vcu & 63;
    const int ch0 = 16 * c;
    const int rowA = kind == 0 ? 256 * (ch0 >> 7) + (ch0 & 127) : (kind == 1 ? OFF_K : OFF_V) + ch0;
    const unsigned char* ap = XNm + (size_t)fr * D + 16 * fq; const unsigned char* bp = Wq + (size_t)(rowA + fr) * D + 16 * fq;
    pg8::i32x4 acc0 = {0, 0, 0, 0}, acc1 = {0, 0, 0, 0};
#pragma unroll
    for (int k0 = 0; k0 < D; k0 += 64) {
        const pg8::i32x4 af = *(const pg8::i32x4*)(ap + k0), bf = *(const pg8::i32x4*)(bp + k0);
        acc0 = __builtin_amdgcn_mfma_i32_16x16x64_i8(af, bf, acc0, 0, 0, 0);
        if (kind == 0) { const pg8::i32x4 bg = *(const pg8::i32x4*)(bp + (size_t)128 * D + k0); acc1 = __builtin_amdgcn_mfma_i32_16x16x64_i8(af, bg, acc1, 0, 0, 0); }
    }
    const int ch = ch0 + fr;
    const float* rsx = (const float*)(A.ws() + WS_RSX) + M + 4 * fq;
    const float s0 = SB[rowA + fr], s1 = kind == 0 ? SB[rowA + 128 + fr] : 0.f;
    float v0[4], v1[4];
#pragma unroll
    for (int r = 0; r < 4; ++r) { v0[r] = (float)acc0[r] * (rsx[r] * s0); v1[r] = (float)acc1[r] * (rsx[r] * s1); }
    if (kind == 0) {
        bf16_t* GLUm = (bf16_t*)(A.ws() + WS_GLUM); const float ba = b_in[ch], bb = b_in[1024 + ch];
#pragma unroll
        for (int r = 0; r < 4; ++r) { const float z1 = v0[r] + ba, z2 = v1[r] + bb; GLUm[(size_t)(4 * fq + r) * D + ch] = (bf16_t)f2bf(z1 * (1.f / (1.f + __expf(-z2)))); }
    } else {
        bf16_t* dst = (bf16_t*)(A.ws() + (kind == 1 ? WS_K : WS_V)); const float bb = b_in[(kind == 1 ? OFF_K : OFF_V) + ch];
#pragma unroll
        for (int r = 0; r < 4; ++r) { const bf16_t o = (bf16_t)f2bf(v0[r] + bb);
            if (kind == 1) { float ss = bf2f(o) * bf2f(o);
                ss += __shfl_xor(ss, 1); ss += __shfl_xor(ss, 2); ss += __shfl_xor(ss, 4); ss += __shfl_xor(ss, 8);
                if (fr == 0) ((float*)(A.ws() + WS_KNM))[((4 * fq + r) * NH + (c >> 2)) * 4 + (c & 3)] = ss; }
#pragma unroll
            for (int b2 = 0; b2 < NB; ++b2) dst[((size_t)b2 * KVROWS + 4 * fq + r) * D + ch] = o; }
    }
}

typedef float f32x2_ __attribute__((ext_vector_type(2)));
__device__ __forceinline__ f32x2_ bfpair(unsigned u) { f32x2_ r; r.x = __builtin_bit_cast(float, u << 16); r.y = __builtin_bit_cast(float, u & 0xffff0000u); return r; }
__device__ __forceinline__ float wave_sum16(float (&v)[16], int lane) {
    const bool b5 = lane & 32, b4 = lane & 16, b3 = lane & 8, b2 = lane & 4;
    float a[8];
#pragma unroll
    for (int i = 0; i < 8; ++i) { const float keep = b5 ? v[i + 8] : v[i], give = b5 ? v[i] : v[i + 8]; a[i] = keep + __shfl_xor(give, 32); }
    float c[4];
#pragma unroll
    for (int i = 0; i < 4; ++i) { const float keep = b4 ? a[i + 4] : a[i], give = b4 ? a[i] : a[i + 4]; c[i] = keep + __shfl_xor(give, 16); }
    float d[2];
#pragma unroll
    for (int i = 0; i < 2; ++i) { const float keep = b3 ? c[i + 2] : c[i], give = b3 ? c[i] : c[i + 2]; d[i] = keep + __shfl_xor(give, 8); }
    float e = (b2 ? d[1] : d[0]) + __shfl_xor(b2 ? d[0] : d[1], 4);
    e += __shfl_xor(e, 1); e += __shfl_xor(e, 2);
    return e;
}
__device__ __forceinline__ void p2_conv(Frame& F, const KA& A) {
    const int tid = launder((int)threadIdx.x), c0 = 2 * tid, lane = tid & 63, wave = __builtin_amdgcn_readfirstlane(tid >> 6);
    const bf16_t* GLU = (const bf16_t*)(A.ws() + WS_GLU); const bf16_t* GLUm = (const bf16_t*)(A.ws() + WS_GLUM); bf16_t* U = (bf16_t*)(A.ws() + WS_U);
    LAS float* red = (LAS float*)(F.lds + RING_OFF);
    f32x2_ cw[CONVW];
#pragma unroll
    for (int j = 0; j < CONVW; ++j) cw[j] = *(const f32x2_*)(A.in(5) + (size_t)j * D + c0);
    const f32x2_ cb = *(const f32x2_*)(A.in(6) + c0), lg = *(const f32x2_*)(A.in(7) + c0), lb = *(const f32x2_*)(A.in(8) + c0);
    for (int chunk = F.vcu; chunk < M / 128; chunk += F.G) {
        const int m0 = chunk * 128, b = m0 / SEQ, i0 = m0 % SEQ;
        const bf16_t* src = GLU + (size_t)m0 * D + c0; bf16_t* dst = U + (size_t)m0 * D + c0;
        unsigned raw[8];
#pragma unroll
        for (int q = 0; q < 8; ++q) raw[q] = *(const unsigned*)(src + (size_t)q * D);
        f32x2_ win[32];
#pragma unroll
        for (int s = 0; s < 32; ++s) {
            const int pp = NMETA + i0 - 32 + s;
            unsigned rw = 0u;
            if (pp >= NMETA) rw = *(const unsigned*)(GLU + ((size_t)b * SEQ + (pp - NMETA)) * D + c0);
            else if (pp >= 0) rw = *(const unsigned*)(GLUm + (size_t)pp * D + c0);
            win[s] = bfpair(rw);
        }
#pragma unroll 1
        for (int blk = 0; blk < 4; ++blk) {
#pragma unroll
            for (int s8 = 0; s8 < 4; ++s8) {
                unsigned cur[8];
#pragma unroll
                for (int q = 0; q < 8; ++q) { asm volatile("" : "+v"(raw[q])); cur[q] = raw[q]; }
                { const int nrow = 32 * blk + 8 * s8 + 8;
                  const bf16_t* ns = src + (size_t)(nrow < 128 ? nrow : 120) * D;
#pragma unroll
                  for (int q = 0; q < 8; ++q) raw[q] = __builtin_nontemporal_load((const unsigned*)(ns + (size_t)q * D)); }
                f32x2_ o[8]; float st[16];
#pragma unroll
                for (int q = 0; q < 8; ++q) { const int s = 8 * s8 + q; win[s] = bfpair(cur[q]);
                    f32x2_ acc = cb;
#pragma unroll
                    for (int j = 0; j < CONVW; ++j) acc = win[(s + 2 + j) & 31] * cw[j] + acc;
                    o[q] = acc; st[2 * q] = acc.x + acc.y; st[2 * q + 1] = acc.x * acc.x + acc.y * acc.y; }
                const float tot = wave_sum16(st, lane);
                LAS float* rp = red + (s8 & 1) * 128;
                if ((lane & 3) == 0) rp[wave * 16 + (lane >> 2)] = tot;
                __syncthreads();
                float tsum = 0.f;
#pragma unroll
                for (int w = 0; w < NWAVES; ++w) tsum += rp[w * 16 + ((lane >> 2) & 15)];
                bf16_t* dg = dst + (size_t)(32 * blk + 8 * s8) * D;
#pragma unroll
                for (int q = 0; q < 8; ++q) {
                    const float s1_ = __builtin_bit_cast(float, __builtin_amdgcn_readlane(__builtin_bit_cast(int, tsum), 8 * q)), s2_ = __builtin_bit_cast(float, __builtin_amdgcn_readlane(__builtin_bit_cast(int, tsum), 8 * q + 4));
                    const float mean = s1_ * (1.f / D), var = s2_ * (1.f / D) - mean * mean, rstd = rsqrtf(fmaxf(var, 0.f) + LN_EPS);
                    f32x2_ y = ((o[q] - mean) * rstd) * lg + lb;
                    y.x = y.x * __builtin_amdgcn_rcpf(1.f + __expf(-y.x)); y.y = y.y * __builtin_amdgcn_rcpf(1.f + __expf(-y.y));
                    *(unsigned*)(dg + (size_t)q * D) = pk2(y.x, y.y);
                }
            }
        }
    }
    __syncthreads();
}
__device__ __forceinline__ void p5_router(Frame& F, const KA& A) {
    const int tid = launder((int)threadIdx.x), lane = tid & 63, wave = __builtin_amdgcn_readfirstlane(tid >> 6), fr = lane & 15, fq = lane >> 4;
    const bf16_t* H = (const bf16_t*)(A.ws() + WS_H); unsigned char* HN = A.ws() + WS_GLU;
    float* TOPG = (float*)(A.ws() + WS_TOPG); float* RSTD = (float*)(A.ws() + WS_RSTD); int* lists = (int*)(A.ws() + WS_LISTS); int* cnt = (int*)(A.ws() + WS_CTL) + CW_CNT;
    const bf16_t* Wh = (const bf16_t*)(A.ws() + WS_WR_T); const bf16_t* Wl = Wh + NE * D;
    const float* g = A.in(12); const float* rb = A.in(14);
    LAS int* lcnt = (LAS int*)(F.lds + RING_OFF);
    LAS int* lbase = lcnt + 32; LAS int* ent = lcnt + 64; LAS int* lslot = ent + 512;
    LAS float* erst = (LAS float*)(lslot + 512); LAS float* egt = erst + 512;
    LAS float* lg = egt + 512 + wave * (16 * 33 + 32); LAS float* lr = lg + 16 * 33; LAS float* lq = lr + 16;
    float* LRS = (float*)(A.ws() + WS_LRS); float* LGT = (float*)(A.ws() + WS_LGT);
    const int c0 = wave * 128 + 8 * fq;
    LAS float* xs = (LAS float*)(F.lds + RING_OFF + 32768);
    LAS float* pacc = (LAS float*)(F.lds + RING_OFF + 36864);
    LAS float* lgall = egt + 512;
    f32x4 gv[4][2]; bf16x8 wh0[4], wh1[4], wl0[4], wl1[4];
#pragma unroll
    for (int s_ = 0; s_ < 4; ++s_) { gv[s_][0] = *(const f32x4*)(g + c0 + 32 * s_); gv[s_][1] = *(const f32x4*)(g + c0 + 32 * s_ + 4);
        const bf16_t* whp = Wh + (size_t)fr * D + c0 + 32 * s_; const bf16_t* wlp = Wl + (size_t)fr * D + c0 + 32 * s_;
        wh0[s_] = *(const bf16x8*)whp; wh1[s_] = *(const bf16x8*)(whp + (size_t)16 * D); wl0[s_] = *(const bf16x8*)wlp; wl1[s_] = *(const bf16x8*)(wlp + (size_t)16 * D); }
    for (int chunk = F.vcu; chunk < M / 128; chunk += F.G) {
        if (tid < 32) lcnt[tid] = 0;
        const bf16_t* hp = H + (size_t)(chunk * 128 + fr) * D + c0; unsigned char* hnp = HN + (size_t)(chunk * 128 + fr) * D + c0;
        u32x4 h0r[4], h1r[4];
#pragma unroll
        for (int s_ = 0; s_ < 4; ++s_) { h0r[s_] = *(const u32x4*)(hp + 32 * s_); h1r[s_] = *(const u32x4*)(hp + (size_t)16 * D + 32 * s_); }
        for (int gi = 0; gi < 8; ++gi) {
            u32x4 h2r[4];
            if (gi < 6) {
#pragma unroll
                for (int s_ = 0; s_ < 4; ++s_) h2r[s_] = *(const u32x4*)(hp + (size_t)(gi + 2) * 16 * D + 32 * s_); }
            float ss = 0.f, amax = 0.f; f32x4 v[4][2];
#pragma unroll
            for (int s_ = 0; s_ < 4; ++s_) { f32x4 x0, x1; pg8::unpack8(h0r[s_], x0, x1);
                ss += (x0.x * x0.x + x0.y * x0.y) + (x0.z * x0.z + x0.w * x0.w) + (x1.x * x1.x + x1.y * x1.y) + (x1.z * x1.z + x1.w * x1.w);
                v[s_][0] = x0 * gv[s_][0]; v[s_][1] = x1 * gv[s_][1];
                const f32x4 a0 = __builtin_elementwise_abs(v[s_][0]), a1 = __builtin_elementwise_abs(v[s_][1]);
                amax = fmaxf(amax, fmaxf(fmaxf(fmaxf(a0.x, a0.y), fmaxf(a0.z, a0.w)), fmaxf(fmaxf(a1.x, a1.y), fmaxf(a1.z, a1.w)))); }
            ss += __shfl_xor(ss, 16); ss += __shfl_xor(ss, 32);
            amax = fmaxf(amax, __shfl_xor(amax, 16)); amax = fmaxf(amax, __shfl_xor(amax, 32));
            LAS float* xp = xs + (gi & 1) * 256;
            if (fq == 0) { xp[(wave * 16 + fr) * 2] = ss; xp[(wave * 16 + fr) * 2 + 1] = amax; }
            __syncthreads();
            float sst = 0.f, amt = 0.f;
#pragma unroll
            for (int w2 = 0; w2 < NWAVES; ++w2) { sst += xp[(w2 * 16 + fr) * 2]; amt = fmaxf(amt, xp[(w2 * 16 + fr) * 2 + 1]); }
            const float qinv = amt > 0.f ? 127.f / amt : 0.f;
            pg8::f32x4 acc0 = {0.f, 0.f, 0.f, 0.f}, acc1 = {0.f, 0.f, 0.f, 0.f};
#pragma unroll
            for (int s_ = 0; s_ < 4; ++s_) { const f32x4 v0 = v[s_][0], v1 = v[s_][1];
                u32x4 hi; hi.x = pk2(v0.x, v0.y); hi.y = pk2(v0.z, v0.w); hi.z = pk2(v1.x, v1.y); hi.w = pk2(v1.z, v1.w);
                { const f32x4 q0 = v0 * qinv, q1 = v1 * qinv; u32x2 q8; q8.x = pk4_i8(q0.x, q0.y, q0.z, q0.w); q8.y = pk4_i8(q1.x, q1.y, q1.z, q1.w); *(u32x2*)(hnp + (size_t)gi * 16 * D + 32 * s_) = q8; }
                u32x4 lo;
                lo.x = pk2(v0.x - __builtin_bit_cast(float, hi.x << 16), v0.y - __builtin_bit_cast(float, hi.x & 0xffff0000u)); lo.y = pk2(v0.z - __builtin_bit_cast(float, hi.y << 16), v0.w - __builtin_bit_cast(float, hi.y & 0xffff0000u));
                lo.z = pk2(v1.x - __builtin_bit_cast(float, hi.z << 16), v1.y - __builtin_bit_cast(float, hi.z & 0xffff0000u)); lo.w = pk2(v1.z - __builtin_bit_cast(float, hi.w << 16), v1.w - __builtin_bit_cast(float, hi.w & 0xffff0000u));
                const bf16x8 ah = __builtin_bit_cast(bf16x8, hi), al = __builtin_bit_cast(bf16x8, lo);
                acc0 = __builtin_amdgcn_mfma_f32_16x16x32_bf16(ah, wh0[s_], acc0, 0, 0, 0); acc1 = __builtin_amdgcn_mfma_f32_16x16x32_bf16(ah, wh1[s_], acc1, 0, 0, 0);
                acc0 = __builtin_amdgcn_mfma_f32_16x16x32_bf16(al, wh0[s_], acc0, 0, 0, 0); acc1 = __builtin_amdgcn_mfma_f32_16x16x32_bf16(al, wh1[s_], acc1, 0, 0, 0);
                acc0 = __builtin_amdgcn_mfma_f32_16x16x32_bf16(ah, wl0[s_], acc0, 0, 0, 0); acc1 = __builtin_amdgcn_mfma_f32_16x16x32_bf16(ah, wl1[s_], acc1, 0, 0, 0); }
#pragma unroll
            for (int r = 0; r < 4; ++r) { pacc[(wave * 8 + r) * 64 + lane] = acc0[r]; pacc[(wave * 8 + 4 + r) * 64 + lane] = acc1[r]; }
            __syncthreads();
            {
                float z = 0.f;
#pragma unroll
                for (int w2 = 0; w2 < NWAVES; ++w2) z += pacc[(w2 * 8 + wave) * 64 + lane];
                LAS float* lgg = lgall + gi * (16 * 33 + 32);
                lgg[(4 * fq + (wave & 3)) * 33 + 16 * (wave >> 2) + fr] = z;
                if (wave == 0 && fq == 0) { const float rstd_ = rsqrtf(sst * (1.f / D) + RMS_EPS); lgg[16 * 33 + fr] = rstd_; lgg[16 * 33 + 16 + fr] = rstd_ * amt * (1.f / 127.f); }
            }
#pragma unroll
            for (int s_ = 0; s_ < 4; ++s_) { h0r[s_] = h1r[s_]; h1r[s_] = h2r[s_]; }
        }
        __syncthreads();
        const int m0 = chunk * 128 + wave * 16;
        if (lane < 16) {
            const int m = m0 + lane; const float rstd = lr[lane], rsa = lq[lane];
            float lv[32];
#pragma unroll
            for (int e = 0; e < 32; ++e) lv[e] = lg[lane * 33 + e] * rstd + rb[e];
            int bi[4]; float bv[4];
#pragma unroll
            for (int k = 0; k < 4; ++k) {
                float best = -INFINITY; int idx = 0;
#pragma unroll
                for (int e = 0; e < 32; ++e) if (lv[e] > best) { best = lv[e]; idx = e; }
#pragma unroll
                for (int e = 0; e < 32; ++e) if (e == idx) lv[e] = -INFINITY;
                bi[k] = idx; bv[k] = best;
            }
            const float e1 = __expf(bv[1] - bv[0]), e2 = __expf(bv[2] - bv[0]), e3 = __expf(bv[3] - bv[0]), inv = 1.f / (1.f + e1 + e2 + e3);
            RSTD[m] = rstd;
            *(f32x4*)(TOPG + (size_t)m * 4) = (f32x4){inv, e1 * inv, e2 * inv, e3 * inv};
#pragma unroll
            for (int k = 0; k < 4; ++k) { const int li = (wave * 16 + lane) * 4 + k;
                lslot[li] = __hip_atomic_fetch_add(lcnt + bi[k], 1, __ATOMIC_RELAXED, __HIP_MEMORY_SCOPE_WORKGROUP);
                ent[li] = ((m * 4 + k) << 5) | bi[k]; erst[li] = rsa; egt[li] = (k == 0 ? 1.f : k == 1 ? e1 : k == 2 ? e2 : e3) * inv; }
        }
        __syncthreads();
        if (tid < 32) lbase[tid] = __hip_atomic_fetch_add(cnt + tid, lcnt[tid], __ATOMIC_RELAXED, __HIP_MEMORY_SCOPE_AGENT);
        __syncthreads();
        { const int en = ent[tid], e = en & 31; const size_t sl = (size_t)e * M + lbase[e] + lslot[tid]; lists[sl] = en >> 5; LRS[sl] = erst[tid]; LGT[sl] = egt[tid]; }
        __syncthreads();
    }
}
constexpr int MOE_TAB_OFF = LDSCTL_OFF + 1024, MOE_PARK_OFF = LDSCTL_OFF + 2048, MOE_XM_OFF = LDSCTL_OFF + 10240  , MOE_SPARK_OFF = LDSCTL_OFF + 16384  ;
__device__ __forceinline__ void moe_table(Frame& F, const KA& A) {
    LAS int* tab = (LAS int*)(F.lds + MOE_TAB_OFF);
    if (tid_of(F.wave) == 0) {
        const int* cnt = (const int*)(A.ws() + WS_CTL) + CW_CNT; int tp = 0, bp = 0;
        for (int e = 0; e < NE; ++e) { const int c = cnt[e]; tab[e] = tp; tab[33 + e] = c; tab[65 + e] = bp; tp += (c + 255) >> 8; bp += c; }
        tab[32] = tp;
    }
    __syncthreads();
}
__device__ __forceinline__ void p8_final(Frame& F, const KA& A) {
    const int wave = F.wave, tid = tid_of(wave), lane = tid & 63;
    const bf16_t* H = (const bf16_t*)(A.ws() + WS_H); const bf16_t* Y = (const bf16_t*)(A.ws() + WS_Y); const float* g = A.in(19); float* out = A.out();
    for (int m = F.vcu * NWAVES + wave; m < M; m += F.G * NWAVES) {
        f32x4 v[4]; float ss = 0.f;
#pragma unroll
        for (int j = 0; j < 4; ++j) {
            { const u32x2 hh = __builtin_nontemporal_load((const u32x2*)(H + (size_t)m * D + 4 * lane + 256 * j)); v[j] = (f32x4){__builtin_bit_cast(float, hh.x << 16), __builtin_bit_cast(float, hh.x & 0xffff0000u), __builtin_bit_cast(float, hh.y << 16), __builtin_bit_cast(float, hh.y & 0xffff0000u)}; }
#pragma unroll
            for (int k = 0; k < 4; ++k) { const u32x2 y = __builtin_nontemporal_load((const u32x2*)(Y + ((size_t)m * 4 + k) * D + 4 * lane + 256 * j));
                v[j].x += __builtin_bit_cast(float, y.x << 16); v[j].y += __builtin_bit_cast(float, y.x & 0xffff0000u); v[j].z += __builtin_bit_cast(float, y.y << 16); v[j].w += __builtin_bit_cast(float, y.y & 0xffff0000u); }
            ss += (v[j].x * v[j].x + v[j].y * v[j].y) + (v[j].z * v[j].z + v[j].w * v[j].w);
        }
        ss = wave_sum(ss);
        const float rstd = rsqrtf(ss * (1.f / D) + RMS_EPS);
#pragma unroll
        for (int j = 0; j < 4; ++j) { const f32x4 gv = *(const f32x4*)(g + 4 * lane + 256 * j); __builtin_nontemporal_store((v[j] * rstd) * gv, (f32x4*)(out + (size_t)m * D + 4 * lane + 256 * j)); }
    }
}
constexpr int N_MEGA_PHASES = 9;
__global__ void __launch_bounds__(NWAVES * 64, 2) mega_fwd(Args args) {
    extern __shared__ __attribute__((aligned(16))) unsigned char lds[];
    Frame F;
    F.lds = (LAS unsigned char*)lds;
    F.MISC = (volatile LAS unsigned*)(F.lds + MISC_OFF);
    F.tid = threadIdx.x; F.lane = F.tid & 63; F.wave = __builtin_amdgcn_readfirstlane(F.tid >> 6);
    F.G = gridDim.x; { const int bx = blockIdx.x; F.vcu = (F.G % 8 == 0) ? (bx % 8) * (F.G / 8) + bx / 8 : bx; }
    { const KA A0 = kargs(); F.ctl = (gu32*)(A0.ws() + WS_CTL); }
    for (int u = F.tid; u < (LDS_BYTES - LDSCTL_OFF) / 4; u += NWAVES * 64) ((LAS unsigned*)(F.lds + LDSCTL_OFF))[u] = 0u;
    __syncthreads();
    XcdBarrier bar = xcd_barrier_post((unsigned*)(F.ctl + CW_BAR), F.MISC + 8);
    const int lo = args.ph_lo, hi = args.ph_hi;
#define IN(k) (lo <= (k) && (k) < hi)
#define BOTH(k) (IN(k) && IN((k) + 1))

    if (IN(0)) { const KA A = kargs(); p0_prologue(F, A); if (BOTH(0)) xcd_barrier(bar); }

    if (IN(1)) { const KA A = kargs(); unsigned char* const ws = A.ws();
        p1_scan(F, A);
        if (F.wave == 0) p1_meta(F, A);
        pg8::Gemm g{(const bf16_t*)(ws + WS_XN), (const bf16_t*)(ws + WS_WIN_T), M, 7168, D / 2}; pg8::StaticOrder S; S.init(M, 7168, F.G, (int)blockIdx.x);
        pg8::EpiInProj E{A.in(4), (const float*)(ws + WS_RSX), (const float*)(ws + WS_SBIN), (bf16_t*)(ws + WS_GLU), (bf16_t*)(ws + WS_Q), WS_QSTRIDE / 2, C2, SEQ, (float*)(ws + WS_QN2), (float*)(ws + WS_KN2)};
        pg8::gemm_phase<pg8::EpiInProj, pg8::StaticOrder, true, true, true>(F.lds + RING_OFF, g, S, E);
        if (BOTH(1)) xcd_barrier(bar);
    }

    if (IN(2)) { const KA A = kargs(); unsigned char* const ws = A.ws();
        static_assert(attn_body::ATTN_LDS_BYTES <= RING_BYTES, "attention LDS");
        const attn_body::AttnTensors AT{(const attn_body::bf16*)(ws + WS_Q), (const attn_body::bf16*)(ws + WS_K), (const attn_body::bf16*)(ws + WS_V), (attn_body::bf16*)(ws + WS_Q), (const float*)(ws + WS_KN2), (const float*)(ws + WS_QN2), (const float*)(ws + WS_KNM)};
        const attn_body::StaticOrder S((int)F.G, (int)blockIdx.x);
        attn_body::attn_phase<attn_body::StaticOrder>((char*)lds + RING_OFF, AT, (const float*)(ws + WS_BIAS), S);
        p2_conv(F, A);
        if (BOTH(2)) xcd_barrier(bar);
    }

    if (IN(3)) { const KA A = kargs(); unsigned char* const ws = A.ws();
        pg8::PairOrder S; S.init(M, D, F.G, (int)blockIdx.x);
        pg8::Gemm g{(const bf16_t*)(ws + WS_U), (const bf16_t*)(ws + WS_WCO_T), M, D, D, (const bf16_t*)(ws + WS_Q), (const bf16_t*)(ws + WS_WAO_T)};
        pg8::EpiMerge E{(const bf16_t*)(ws + WS_SGA), (const bf16_t*)(ws + WS_SGB), (bf16_t*)(ws + WS_XN)};
        pg8::gemm_phase<pg8::EpiMerge, pg8::PairOrder, true, true, false, true>(F.lds + RING_OFF, g, S, E);
        if (BOTH(3)) xcd_barrier(bar);
    }

    if (IN(4)) { const KA A = kargs(); unsigned char* const ws = A.ws();
        pg8::Gemm g{(const bf16_t*)(ws + WS_XN), (const bf16_t*)(ws + WS_WMIX_T), M, D, D}; pg8::StaticOrder S; S.init(M, D, F.G, (int)blockIdx.x);
        pg8::EpiResid E{A.in(0), (bf16_t*)(ws + WS_H)};
        pg8::gemm_phase<pg8::EpiResid, pg8::StaticOrder, true, true>(F.lds + RING_OFF, g, S, E);
        if (BOTH(4)) xcd_barrier(bar);
    }

    if (IN(5)) { const KA A = kargs(); p5_router(F, A); if (BOTH(5)) xcd_barrier(bar); }

    if (IN(6)) { const KA A = kargs(); unsigned char* const ws = A.ws();
        moe_table(F, A);
        pg8::MoeOrder S; S.init((const LAS int*)(F.lds + MOE_TAB_OFF), 8, F.G, (int)blockIdx.x);
        pg8::RowsGather RW{(const int*)(ws + WS_LISTS)};
        pg8::EpiMoeGU E{A.in(16), (const float*)(ws + WS_LRS), (const float*)(ws + WS_SBGU), ws + WS_ACT, (float*)(ws + WS_SACT), (LAS float*)(F.lds + MOE_XM_OFF)};
        pg8::gemm_phase_g<pg8::EpiMoeGU, pg8::MoeOrder, pg8::RowsGather, 512, true>(F.wave, F.lds + RING_OFF, F.lds + MOE_PARK_OFF, nullptr, nullptr, (const bf16_t*)(ws + WS_GLU), (const bf16_t*)(ws + WS_WGU_T), (size_t)2048 * 1024, S, RW, E);
        if (BOTH(6)) xcd_barrier(bar);
    }

    if (IN(7)) { const KA A = kargs(); unsigned char* const ws = A.ws();
        moe_table(F, A);
        pg8::MoeOrder S; S.init((const LAS int*)(F.lds + MOE_TAB_OFF), 4, F.G, (F.G % 8 == 0) ? (int)(blockIdx.x % 8) * (int)(F.G / 8) + (int)(blockIdx.x / 8) : (int)blockIdx.x);
        pg8::RowsDense RW{};
        pg8::EpiMoeDown E{A.in(18), (const float*)(ws + WS_SBDN), (const int*)(ws + WS_LISTS), (const float*)(ws + WS_LGT), (bf16_t*)(ws + WS_Y)};
        static_assert(MOE_SPARK_OFF - 2048 >= MOE_XM_OFF, "the down GEMM's row offsets sit in the gate-up exchange area (idle in this phase)");
        pg8::gemm_phase_g<pg8::EpiMoeDown, pg8::MoeOrder, pg8::RowsDense, 512, true, true, true>(F.wave, F.lds + RING_OFF, F.lds + MOE_PARK_OFF, F.lds + MOE_SPARK_OFF, (const float*)(ws + WS_SACT), (const bf16_t*)(ws + WS_ACT), (const bf16_t*)(ws + WS_WDN_T), (size_t)D * 1024, S, RW, E);
        if (BOTH(7)) xcd_barrier(bar);
    }

    if (IN(8)) { const KA A = kargs(); p8_final(F, A); }
#undef IN
#undef BOTH
}
extern "C" void kernel_launch(void* const* d_in, const int* in_sizes, int n_in, void* d_out, int out_size, void* d_ws, size_t ws_size, hipStream_t stream) {
    static int grid = 0;
    if (grid == 0) {
        if (n_in != 20 || in_sizes[0] != M * D || out_size != M * D || ws_size < WS_END) { fprintf(stderr, "kernel_launch: unexpected shapes (n_in %d in0 %d out %d ws %zu)\n", n_in, n_in > 0 ? in_sizes[0] : -1, out_size, ws_size); grid = -1; return; }
        int dev = 0, cus = 0, per_cu = 0;
        if (hipGetDevice(&dev) != hipSuccess || hipDeviceGetAttribute(&cus, hipDeviceAttributeMultiprocessorCount, dev) != hipSuccess) { grid = -1; return; }
        if (hipFuncSetAttribute((const void*)mega_fwd, hipFuncAttributeMaxDynamicSharedMemorySize, LDS_BYTES) != hipSuccess) { fprintf(stderr, "kernel_launch: hipFuncSetAttribute failed\n"); grid = -1; return; }
        if (hipOccupancyMaxActiveBlocksPerMultiprocessor(&per_cu, (const void*)mega_fwd, NWAVES * 64, LDS_BYTES) != hipSuccess || per_cu < 1) { fprintf(stderr, "kernel_launch: occupancy query says %d blocks per CU\n", per_cu); (void)hipGetLastError(); grid = -1; return; }
        grid = cus;
    }
    if (grid < 0) return;
    unsigned char* ws = (unsigned char*)d_ws; float* out = (float*)d_out;

    (void)hipMemsetAsync(ws + WS_CTL, 0, CTL_ZERO_BYTES, stream);
    Args a{};
    for (int i = 0; i < 20; ++i) a.in[i] = (const float*)d_in[i];
    a.out = out; a.ws = ws; a.ph_lo = 0; a.ph_hi = N_MEGA_PHASES;
    hipLaunchKernelGGL(mega_fwd, dim3(grid), dim3(NWAVES * 64), LDS_BYTES, stream, a);
    { const hipError_t le = hipPeekAtLastError(); if (le != hipSuccess) fprintf(stderr, "kernel_launch: launch failed: %s\n", hipGetErrorName(le)); }
}
```

```cpp
#include <hip/hip_runtime.h>
#include <cstdio>
#include <cstdint>

typedef unsigned short bf16_t;
typedef short bf16x8 __attribute__((ext_vector_type(8)));
typedef float f32x4 __attribute__((ext_vector_type(4)));
typedef float f32x16 __attribute__((ext_vector_type(16)));
typedef unsigned u32x4 __attribute__((ext_vector_type(4)));
typedef unsigned u32x2 __attribute__((ext_vector_type(2)));

constexpr int D = 1024, NB = 4, SEQ = 8192, NMETA = 16, M = NB * SEQ;
constexpr int NH = 16, HD = 64, NE = 32, TOPK = 4, NA = M * TOPK;
constexpr int IN_COLS = 7184, OFF_Q = 2048, OFF_K = 3072, OFF_V = 4096, OFF_F = 5120, OFF_GA = 5136, OFF_GB = 6160;
constexpr int CONVW = 31;
constexpr int KVROWS = SEQ + 64;
constexpr float LOG2E = 1.4426950408889634f;
constexpr float C2 = 0.125f * LOG2E;
constexpr float RMS_EPS = 1e-5f, LN_EPS = 1e-5f;
constexpr float NEG_BIG = -1e30f;

constexpr size_t MiB = 1u << 20;
constexpr size_t WS_CTL = 0, CTL_ZERO_BYTES = 1 * MiB;
constexpr size_t WS_LISTS = 4 * MiB;
constexpr size_t WS_TOPI = 8 * MiB;
constexpr size_t WS_TOPG = 8 * MiB + 512 * 1024;
constexpr size_t WS_LOGF = 10 * MiB;
constexpr size_t WS_LOGFM = 12 * MiB;
constexpr size_t WS_BIAS = 13 * MiB;
constexpr size_t WS_RSX = 9 * MiB + 512 * 1024;
constexpr size_t WS_RSTD = 9 * MiB;
constexpr size_t WS_WR_T = 17 * MiB;
constexpr size_t WS_LRS = 20 * MiB, WS_LGT = 24 * MiB;
constexpr size_t WS_SBIN = 18 * MiB + 512 * 1024;
constexpr size_t WS_SBDN = 19 * MiB;
constexpr size_t WS_SACT = 28 * MiB;
constexpr size_t WS_GSUM = 15 * MiB + 512 * 1024;
constexpr size_t WS_KN2 = 52 * MiB;
constexpr size_t WS_QN2 = 57 * MiB;
constexpr size_t WS_KNM = 61 * MiB + 512 * 1024;
constexpr size_t WS_SBGU = 18 * MiB;
constexpr size_t WS_XNM = 16 * MiB;
constexpr size_t WS_GLUM = 16 * MiB + 64 * 1024;
constexpr size_t WS_WIN_T = 32 * MiB, WS_WCO_T = 46 * MiB, WS_WAO_T = 48 * MiB, WS_WMIX_T = 50 * MiB;
constexpr size_t WS_WGU_T = 64 * MiB;
constexpr size_t WS_TMPA = 192 * MiB;
constexpr size_t WS_Y = 192 * MiB;
constexpr size_t WS_XN = 256 * MiB;
constexpr size_t WS_GLU = 320 * MiB;
constexpr size_t WS_Q = 384 * MiB;
constexpr size_t WS_QSTRIDE = 66 * MiB;
constexpr size_t WS_K = WS_Q + WS_QSTRIDE, WS_V = WS_Q + 2 * WS_QSTRIDE;
constexpr size_t WS_SGA = WS_Q + 3 * WS_QSTRIDE, WS_SGB = WS_Q + 4 * WS_QSTRIDE, WS_U = 714 * MiB;
constexpr size_t WS_ACT = 450 * MiB;
constexpr size_t WS_H = 778 * MiB;
constexpr size_t WS_WDN_T = 906 * MiB;
constexpr size_t WS_END = 970 * MiB;
static_assert(WS_SGB + 64 * MiB <= WS_U && WS_ACT + 256 * MiB <= WS_U && WS_ACT >= WS_K && WS_U + 64 * MiB <= WS_H && WS_H + 128 * MiB <= WS_WDN_T, "d_ws map");
constexpr int CW_CNT = 64;

__device__ __forceinline__ unsigned f2bf(float f) { unsigned u = __builtin_bit_cast(unsigned, f); return (u + 0x7fffu + ((u >> 16) & 1u)) >> 16; }
__device__ __forceinline__ float bf2f(unsigned short b) { return __builtin_bit_cast(float, (unsigned)b << 16); }
__device__ __forceinline__ unsigned pk2(float lo, float hi) { return f2bf(lo) | (f2bf(hi) << 16); }
__device__ __forceinline__ unsigned pk4_i8(float a, float b, float c, float d) {
    const int ia = (int)__builtin_rintf(a), ib = (int)__builtin_rintf(b), ic = (int)__builtin_rintf(c), id = (int)__builtin_rintf(d);
    return ((unsigned)ia & 0xffu) | (((unsigned)ib & 0xffu) << 8) | (((unsigned)ic & 0xffu) << 16) | ((unsigned)id << 24);
}
__device__ __forceinline__ float lane_max_16_32(float v) {
    float a = v, b = v; asm volatile("s_nop 1\n\tv_permlane16_swap_b32 %0, %1" : "+v"(a), "+v"(b)); v = fmaxf(a, b);
    a = v; b = v; asm volatile("s_nop 1\n\tv_permlane32_swap_b32 %0, %1" : "+v"(a), "+v"(b)); return fmaxf(a, b);
}
__device__ __forceinline__ float wave_sum(float v) {
#pragma unroll
    for (int o = 1; o < 64; o <<= 1) v += __shfl_xor(v, o);
    return v;
}
__device__ __forceinline__ float sigmoidf_(float z) { return 1.f / (1.f + __expf(-z)); }

__device__ __forceinline__ int launder(int v) { asm volatile("" : "+v"(v)); return v; }
__device__ __forceinline__ int tid_of(int wave) { return launder(wave * 64 + (int)__builtin_amdgcn_mbcnt_hi(~0u, __builtin_amdgcn_mbcnt_lo(~0u, 0u))); }
namespace pg8 {
#define PG8_LAS __attribute__((address_space(3)))
typedef unsigned short bf16_t;
typedef short bf16x8 __attribute__((ext_vector_type(8)));
typedef float f32x4 __attribute__((ext_vector_type(4)));
typedef unsigned u32x4 __attribute__((ext_vector_type(4)));
constexpr int BM = 256, BK = 64, HALF = 128, HTB = HALF * BK * 2  , STAGE_BYTES = 8 * HTB, NXCD = 8, WGM = 8;

__host__ __device__ __forceinline__ int lds_byte(int r, int c) { const int st = (r >> 4) * 2 + (c >> 5), rr = r & 15, cc = c & 31, ob = rr * 64 + cc * 2; return st * 1024 + (ob ^ (((ob >> 9) & 1) << 5)); }
__host__ __device__ __forceinline__ void stage_rc(int b, int& R, int& C) { const int st = b / 1024, sb = b % 1024, swz = sb ^ (((sb >> 9) & 1) << 5); R = (st >> 1) * 16 + swz / 64; C = (st & 1) * 32 + (swz % 64) / 2; }
__host__ __device__ __forceinline__ int perm32(int rho) { const int n = rho >> 4, i = rho & 15; return 8 * (i >> 2) + 4 * n + (i & 3); }

struct Unit { int pm, pn, part; };
struct Gemm { const bf16_t* A; const bf16_t* Bt; int M, N, K; const bf16_t* A2 = nullptr; const bf16_t* Bt2 = nullptr; };

struct StaticOrder {
    int nM, nN, nwg, G, c;
    __host__ __device__ void init(int M, int N, int G_, int c_) { nM = M / BM; nN = N / BM; nwg = nM * nN; G = G_; c = c_; }
    __host__ __device__ bool next(int i, Unit& u) const {
        const long L = (long)i * G + c; if (L >= nwg) return false;
        int wgid = (int)L; { const int q = nwg / NXCD, r = nwg % NXCD, xcd = wgid % NXCD, off = wgid / NXCD; wgid = (xcd < r ? xcd * (q + 1) : r * (q + 1) + (xcd - r) * q) + off; }
        const int nig = WGM * nN, gid = wgid / nig, fm = gid * WGM, gsz = (nM - fm) < WGM ? (nM - fm) : WGM;
        u.pm = fm + ((wgid % nig) % gsz); u.pn = (wgid % nig) / gsz; u.part = 0; return true;
    }
    __device__ __forceinline__ void a_ready(const Unit&) const {}
    __device__ __forceinline__ void done(const Unit&) const {}
};

struct PairOrder {
    StaticOrder base;
    __host__ __device__ void init(int M, int N, int G_, int c_) { base.init(M, N, G_, c_); }
    __host__ __device__ bool next(int i, Unit& u) const { if (!base.next(i >> 1, u)) return false; u.part = i & 1; return true; }
    __device__ __forceinline__ void a_ready(const Unit&) const {}
    __device__ __forceinline__ void done(const Unit&) const {}
};
__device__ __forceinline__ unsigned cvt_pk_bf16(float lo, float hi) { unsigned r; asm volatile("v_cvt_pk_bf16_f32 %0, %1, %2" : "=v"(r) : "v"(lo), "v"(hi)); return r; }
typedef float f32x2 __attribute__((ext_vector_type(2)));
typedef int i32x4 __attribute__((ext_vector_type(4)));
template <bool I8> struct AccSel { typedef f32x4 T; };
template <> struct AccSel<true> { typedef i32x4 T; };
__device__ __forceinline__ f32x4 mma16(bf16x8 b, bf16x8 a, f32x4 c) { return __builtin_amdgcn_mfma_f32_16x16x32_bf16(b, a, c, 0, 0, 0); }
__device__ __forceinline__ i32x4 mma16(bf16x8 b, bf16x8 a, i32x4 c) { return __builtin_amdgcn_mfma_i32_16x16x64_i8(__builtin_bit_cast(i32x4, b), __builtin_bit_cast(i32x4, a), c, 0, 0, 0); }
__device__ __forceinline__ float sigm(float z) { return __builtin_amdgcn_rcpf(1.0f + __expf(-z)); }
__device__ __forceinline__ f32x4 sigm4(f32x4 z) { return (f32x4){sigm(z[0]), sigm(z[1]), sigm(z[2]), sigm(z[3])}; }
__device__ __forceinline__ f32x2 sigm_pk(f32x2 z) { f32x2 e = z * (-1.4426950408889634f); e.x = __builtin_amdgcn_exp2f(e.x); e.y = __builtin_amdgcn_exp2f(e.y); e = e + 1.0f; f32x2 r; r.x = __builtin_amdgcn_rcpf(e.x); r.y = __builtin_amdgcn_rcpf(e.y); return r; }
__device__ __forceinline__ f32x2 lo2(f32x4 v) { return (f32x2){v[0], v[1]}; }
__device__ __forceinline__ f32x2 hi2(f32x4 v) { return (f32x2){v[2], v[3]}; }
__device__ __forceinline__ f32x2 cvt_lo2(i32x4 v) { return (f32x2){(float)v[0], (float)v[1]}; }
__device__ __forceinline__ f32x2 cvt_hi2(i32x4 v) { return (f32x2){(float)v[2], (float)v[3]}; }
__device__ __forceinline__ f32x2 swiglu_pk(f32x2 z1, f32x2 z2) {
    f32x2 gg, up; gg.x = fminf(z1.x, 7.f); gg.y = fminf(z1.y, 7.f); up.x = fminf(fmaxf(z2.x, -7.f), 7.f); up.y = fminf(fmaxf(z2.y, -7.f), 7.f);
    f32x2 e = gg * (-1.702f * 1.4426950408889634f); e.x = __builtin_amdgcn_exp2f(e.x); e.y = __builtin_amdgcn_exp2f(e.y); e = e + 1.0f;
    f32x2 r; r.x = __builtin_amdgcn_rcpf(e.x); r.y = __builtin_amdgcn_rcpf(e.y);
    const f32x2 t = gg * r; return t * up + t; }
__device__ __forceinline__ u32x4 pack8_pk(f32x2 a, f32x2 b, f32x2 c, f32x2 d) { u32x4 w; w.x = cvt_pk_bf16(a.x, a.y); w.y = cvt_pk_bf16(b.x, b.y); w.z = cvt_pk_bf16(c.x, c.y); w.w = cvt_pk_bf16(d.x, d.y); return w; }
__device__ __forceinline__ u32x4 pack8(f32x4 v0, f32x4 v1) { u32x4 w; w.x = cvt_pk_bf16(v0[0], v0[1]); w.y = cvt_pk_bf16(v0[2], v0[3]); w.z = cvt_pk_bf16(v1[0], v1[1]); w.w = cvt_pk_bf16(v1[2], v1[3]); return w; }
__device__ __forceinline__ void unpack8(u32x4 w, f32x4& lo, f32x4& hi) {
    lo = (f32x4){__builtin_bit_cast(float, w.x << 16), __builtin_bit_cast(float, w.x & 0xffff0000u), __builtin_bit_cast(float, w.y << 16), __builtin_bit_cast(float, w.y & 0xffff0000u)};
    hi = (f32x4){__builtin_bit_cast(float, w.z << 16), __builtin_bit_cast(float, w.z & 0xffff0000u), __builtin_bit_cast(float, w.w << 16), __builtin_bit_cast(float, w.w & 0xffff0000u)};
}
struct EpiInProj {
    static constexpr bool PERM = true, AFTER_DRAIN = false;
    const float* b_in; const float* RSX; const float* SB; bf16_t *GLU, *Q; size_t qstride; float qscale; int seq; float* QN2; float* KN2;
    __device__ __forceinline__ void operator()(const i32x4 (&acc)[2][2][4][2], const Unit& u, int wr, int wc, int fr, int fq) const {
        const int row0 = u.pm * BM + wr * 64 + fr;
        const float* sp = SB + u.pn * 256 + wc * 32 + 8 * fq;
        float rs[2][4];
#pragma unroll
        for (int ai = 0; ai < 2; ++ai)
#pragma unroll
            for (int m = 0; m < 4; ++m) rs[ai][m] = RSX[row0 + ai * HALF + m * 16];
        f32x4 sc[2][2];
#pragma unroll
        for (int bj = 0; bj < 2; ++bj)
#pragma unroll
            for (int n = 0; n < 2; ++n) sc[bj][n] = *(const f32x4*)(sp + bj * HALF + 4 * n);
        f32x4 af[2][2][4][2];
#pragma unroll
        for (int ai = 0; ai < 2; ++ai)
#pragma unroll
            for (int bj = 0; bj < 2; ++bj)
#pragma unroll
                for (int m = 0; m < 4; ++m)
#pragma unroll
                    for (int n = 0; n < 2; ++n) { af[ai][bj][m][n] = __builtin_convertvector(acc[ai][bj][m][n], f32x4); asm volatile("" : "+v"(af[ai][bj][m][n])); }
        if (u.pn < 8) {
            const int ch0 = u.pn * 128 + wc * 32 + 8 * fq;
            f32x4 ba[2], bb[2];
#pragma unroll
            for (int n = 0; n < 2; ++n) { ba[n] = *(const f32x4*)(b_in + ch0 + 4 * n); bb[n] = *(const f32x4*)(b_in + 1024 + ch0 + 4 * n); }
#pragma unroll
            for (int ai = 0; ai < 2; ++ai)
#pragma unroll
                for (int m = 0; m < 4; ++m) { const float r_ = rs[ai][m];
                    f32x2 o[4];
#pragma unroll
                    for (int n = 0; n < 2; ++n) { const f32x4 fa = sc[0][n] * r_, fb = sc[1][n] * r_;
                        o[2 * n] = (lo2(af[ai][0][m][n]) * lo2(fa) + lo2(ba[n])) * sigm_pk(lo2(af[ai][1][m][n]) * lo2(fb) + lo2(bb[n]));
                        o[2 * n + 1] = (hi2(af[ai][0][m][n]) * hi2(fa) + hi2(ba[n])) * sigm_pk(hi2(af[ai][1][m][n]) * hi2(fb) + hi2(bb[n])); }
                    __builtin_nontemporal_store(pack8_pk(o[0], o[1], o[2], o[3]), (u32x4*)(GLU + (size_t)(row0 + ai * HALF + m * 16) * 1024 + ch0));
                }
        } else {
            const int kind = (u.pn - 8) >> 2, ct = wc * 32 + 8 * fq, cw = (u.pn & 3) * 256 + ct, bcol = u.pn * 256 + ct + (u.pn >= 20 ? 16 : 0);
            bf16_t* base = Q + (size_t)kind * qstride;
            const int radd = (kind == 1 || kind == 2) ? 64 * ((u.pm * BM) / seq + 1) : 0;
            f32x4 bv[2][2];
#pragma unroll
            for (int bj = 0; bj < 2; ++bj)
#pragma unroll
                for (int n = 0; n < 2; ++n) bv[bj][n] = *(const f32x4*)(b_in + bcol + bj * HALF + 4 * n);
#pragma unroll
            for (int ai = 0; ai < 2; ++ai)
#pragma unroll
                for (int m = 0; m < 4; ++m) { bf16_t* rowp = base + (size_t)(row0 + ai * HALF + m * 16 + radd) * 1024 + cw; const float r_ = rs[ai][m];
#pragma unroll
                    for (int bj = 0; bj < 2; ++bj) { const f32x4 f0 = sc[bj][0] * r_, f1 = sc[bj][1] * r_;
                        f32x2 o0 = lo2(af[ai][bj][m][0]) * lo2(f0) + lo2(bv[bj][0]), o1 = hi2(af[ai][bj][m][0]) * hi2(f0) + hi2(bv[bj][0]), o2 = lo2(af[ai][bj][m][1]) * lo2(f1) + lo2(bv[bj][1]), o3 = hi2(af[ai][bj][m][1]) * hi2(f1) + hi2(bv[bj][1]);
                        if (kind == 0) { o0 = o0 * qscale; o1 = o1 * qscale; o2 = o2 * qscale; o3 = o3 * qscale; } else if (kind >= 3) { o0 = sigm_pk(o0); o1 = sigm_pk(o1); o2 = sigm_pk(o2); o3 = sigm_pk(o3); }
                        const u32x4 w_ = pack8_pk(o0, o1, o2, o3);
                        __builtin_nontemporal_store(w_, (u32x4*)(rowp + bj * HALF));
                        if (kind <= 1) {
                            f32x4 lo, hi; unpack8(w_, lo, hi); lo = lo * lo + hi * hi; float ss = (lo[0] + lo[1]) + (lo[2] + lo[3]);
                            ss += __shfl_xor(ss, 16); ss += __shfl_xor(ss, 32);
                            if (fq == 0) (kind == 0 ? QN2 : KN2)[((size_t)((u.pn & 3) * 4 + bj * 2 + (wc >> 1)) * (kind == 0 ? (size_t)M : (size_t)NB * KVROWS) + (size_t)(row0 + ai * HALF + m * 16 + radd)) * 2 + (wc & 1)] = ss; } } }
        }
    }
};
template <bool HAS_ADD> struct EpiGated {
    static constexpr bool PERM = true, AFTER_DRAIN = false;
    const bf16_t* SG; const bf16_t* ADD; bf16_t* OUT;
    __device__ __forceinline__ void operator()(const f32x4 (&acc)[2][2][4][2], const Unit& u, int wr, int wc, int fr, int fq) const {
        const int row0 = u.pm * BM + wr * 64 + fr, col0 = u.pn * BM + wc * 32 + 8 * fq;
#pragma unroll
        for (int ai = 0; ai < 2; ++ai)
#pragma unroll
            for (int m = 0; m < 4; ++m) { const size_t off = (size_t)(row0 + ai * HALF + m * 16) * 1024 + col0;
#pragma unroll
                for (int bj = 0; bj < 2; ++bj) { f32x4 g0, g1; unpack8(*(const u32x4*)(SG + off + bj * HALF), g0, g1);
                    f32x4 v0 = acc[ai][bj][m][0] * g0, v1 = acc[ai][bj][m][1] * g1;
                    if (HAS_ADD) { f32x4 t0, t1; unpack8(*(const u32x4*)(ADD + off + bj * HALF), t0, t1); v0 = v0 + t0; v1 = v1 + t1; }
                    *(u32x4*)(OUT + off + bj * HALF) = pack8(v0, v1); } }
    }
};
struct EpiMerge {
    static constexpr bool PERM = true, AFTER_DRAIN = false; static constexpr int NREL = 16;
    const bf16_t* SGA; const bf16_t* SGB; bf16_t* OUT;
    __device__ __forceinline__ void mid(f32x4 (&acc)[2][2][4][2], const Unit& u, int wr, int wc, int fr, int fq) const {
        const int row0 = u.pm * BM + wr * 64 + fr, col0 = u.pn * BM + wc * 32 + 8 * fq;
#pragma unroll
        for (int ai = 0; ai < 2; ++ai) {
#pragma unroll
            for (int m = 0; m < 4; ++m) { const size_t off = (size_t)(row0 + ai * HALF + m * 16) * 1024 + col0;
#pragma unroll
                for (int bj = 0; bj < 2; ++bj) { f32x4 a0, a1, b0, b1; unpack8(*(const u32x4*)(SGA + off + bj * HALF), a0, a1); unpack8(*(const u32x4*)(SGB + off + bj * HALF), b0, b1);
#pragma unroll
                    for (int i = 0; i < 4; ++i) { a0[i] *= __builtin_amdgcn_rcpf(fmaxf(b0[i], 1e-30f)); a1[i] *= __builtin_amdgcn_rcpf(fmaxf(b1[i], 1e-30f)); }
                    acc[ai][bj][m][0] = acc[ai][bj][m][0] * a0; acc[ai][bj][m][1] = acc[ai][bj][m][1] * a1; } }
            asm volatile("" ::: "memory");
        }
    }
    __device__ __forceinline__ void operator()(const f32x4 (&acc)[2][2][4][2], const Unit& u, int wr, int wc, int fr, int fq) const {
        const int row0 = u.pm * BM + wr * 64 + fr, col0 = u.pn * BM + wc * 32 + 8 * fq;
#pragma unroll
        for (int ai = 0; ai < 2; ++ai)
#pragma unroll
            for (int m = 0; m < 4; ++m) { const size_t off = (size_t)(row0 + ai * HALF + m * 16) * 1024 + col0;
#pragma unroll
                for (int bj = 0; bj < 2; ++bj) { f32x4 b0, b1; unpack8(*(const u32x4*)(SGB + off + bj * HALF), b0, b1);
#pragma unroll
                    for (int i = 0; i < 4; ++i) { b0[i] = fmaxf(b0[i], 1e-30f); b1[i] = fmaxf(b1[i], 1e-30f); }
                    *(u32x4*)(OUT + off + bj * HALF) = pack8(acc[ai][bj][m][0] * b0, acc[ai][bj][m][1] * b1); } }
    }
};
struct EpiResid {
    static constexpr bool PERM = true, AFTER_DRAIN = false;
    const float* X; bf16_t* H;
    __device__ __forceinline__ void operator()(const f32x4 (&acc)[2][2][4][2], const Unit& u, int wr, int wc, int fr, int fq) const {
        const int row0 = u.pm * BM + wr * 64 + fr, col0 = u.pn * BM + wc * 32 + 8 * fq;
#pragma unroll
        for (int ai = 0; ai < 2; ++ai)
#pragma unroll
            for (int m = 0; m < 4; ++m) { const size_t off = (size_t)(row0 + ai * HALF + m * 16) * 1024 + col0;
#pragma unroll
                for (int bj = 0; bj < 2; ++bj) { const f32x4 x0 = *(const f32x4*)(X + off + bj * HALF), x1 = *(const f32x4*)(X + off + bj * HALF + 4);
                    *(u32x4*)(H + off + bj * HALF) = pack8(x0 + acc[ai][bj][m][0], x1 + acc[ai][bj][m][1]); } }
    }
};
template <class Epi, class Sched, bool ALIGN_EPI = false, bool SP2 = false, bool I8 = false, bool DUAL = false>
__device__ __forceinline__ void gemm_phase(PG8_LAS unsigned char* lds, const Gemm g, const Sched& S, const Epi& E) {
    const int tid = ::launder((int)threadIdx.x), wid = __builtin_amdgcn_readfirstlane(tid >> 6), lane = tid & 63, wr = wid >> 2, wc = wid & 3, fr = lane & 15, fq = lane >> 4;
    const int K = g.K, nt = K / BK;
    unsigned voffA[2], voffB[2];
#pragma unroll
    for (int i = 0; i < 2; ++i) { int R, C; stage_rc(tid * 16 + i * 8192, R, C); const int Rb = Epi::PERM ? ((R & ~31) + perm32(R & 31)) : R;
        voffA[i] = (unsigned)(R * K + C) * 2u; voffB[i] = (unsigned)(Rb * K + C) * 2u; }
    const size_t kstep = (size_t)(BK * 2);
    const size_t hstep = (size_t)HALF * K * 2;
    const size_t tstep = 2 * hstep;
    const unsigned ldsw = (unsigned)wid * 1024u;
    const int aoff = lds_byte(wr * 64 + fr, fq * 8), boff = lds_byte(wc * 32 + fr, fq * 8);
#define PG8_SA(b, h) (((b) * 2 + (h)) * HTB)
#define PG8_SB(b, h) ((4 + (b) * 2 + (h)) * HTB)
#define PG8_STAGE(bufoff, gbase, voff) do { _Pragma("unroll") for (int _i = 0; _i < 2; ++_i) \
        __builtin_amdgcn_global_load_lds((const unsigned*)((const char*)(gbase) + (voff)[_i]), (PG8_LAS unsigned*)(lds + (bufoff) + ldsw + _i * 8192), 16, 0, 0); } while (0)
#define PG8_LDA(dst, b, h) do { _Pragma("unroll") for (int m = 0; m < 4; ++m) _Pragma("unroll") for (int k = 0; k < 2; ++k) dst[m][k] = *(const PG8_LAS bf16x8*)(lds + PG8_SA(b, h) + aoff + m * 2048 + k * 1024); } while (0)
#define PG8_LDB(dst, b, h) do { _Pragma("unroll") for (int n = 0; n < 2; ++n) _Pragma("unroll") for (int k = 0; k < 2; ++k) dst[n][k] = *(const PG8_LAS bf16x8*)(lds + PG8_SB(b, h) + boff + n * 2048 + k * 1024); } while (0)
#define PG8_MMA(ai, bj, At, Bt) do { __builtin_amdgcn_s_setprio(1); _Pragma("unroll") for (int m = 0; m < 4; ++m) _Pragma("unroll") for (int n = 0; n < 2; ++n) _Pragma("unroll") for (int k = 0; k < 2; ++k) \
        acc[ai][bj][m][n] = mma16(Bt[n][k], At[m][k], acc[ai][bj][m][n]); __builtin_amdgcn_s_setprio(0); } while (0)
#define PG8_WAIT_V(n) asm volatile("s_waitcnt vmcnt(" #n ")" ::: "memory")
#define PG8_WAIT_L(n) asm volatile("s_waitcnt lgkmcnt(" #n ")" ::: "memory")
#define PG8_BAR __builtin_amdgcn_s_barrier()
#define PG8_SCHED __builtin_amdgcn_sched_barrier(0)
    Unit cur, nxt; int ui = 0;
    if (!S.next(0, cur)) return;
    typedef typename AccSel<I8>::T acc_t; acc_t acc[2][2][4][2];
#pragma unroll
    for (int a = 0; a < 2; ++a)
#pragma unroll
        for (int b = 0; b < 2; ++b)
#pragma unroll
            for (int m = 0; m < 4; ++m)
#pragma unroll
                for (int n = 0; n < 2; ++n) acc[a][b][m][n] = acc_t{};
    bf16x8 At[4][2], B0[2][2], B1[2][2];
    const char* cA = (const char*)((DUAL && cur.part) ? g.A2 : g.A) + (size_t)cur.pm * tstep; const char* cB = (const char*)((DUAL && cur.part) ? g.Bt2 : g.Bt) + (size_t)cur.pn * tstep;
    S.a_ready(cur);
    if constexpr (SP2) {
        PG8_STAGE(PG8_SB(0, 0), cB, voffB); PG8_STAGE(PG8_SB(0, 1), cB + hstep, voffB); PG8_STAGE(PG8_SA(0, 0), cA, voffA); PG8_STAGE(PG8_SA(0, 1), cA + hstep, voffA);
        if (wr == 1) PG8_BAR;
        PG8_WAIT_V(2); PG8_BAR;
        PG8_STAGE(PG8_SB(1, 0), cB + kstep, voffB); PG8_STAGE(PG8_SA(1, 0), cA + kstep, voffA); PG8_STAGE(PG8_SB(1, 1), cB + hstep + kstep, voffB);
        PG8_WAIT_V(6); PG8_BAR;
    } else {
        PG8_STAGE(PG8_SB(0, 0), cB, voffB); PG8_STAGE(PG8_SA(0, 0), cA, voffA); PG8_STAGE(PG8_SB(0, 1), cB + hstep, voffB); PG8_STAGE(PG8_SA(0, 1), cA + hstep, voffA);
        if (wr == 1) PG8_BAR;
        PG8_WAIT_V(4); PG8_BAR;
        PG8_STAGE(PG8_SB(1, 0), cB + kstep, voffB); PG8_STAGE(PG8_SA(1, 0), cA + kstep, voffA); PG8_STAGE(PG8_SB(1, 1), cB + hstep + kstep, voffB);
        PG8_WAIT_V(6); PG8_BAR;
    }
    for (;;) {
        const bool has_next = S.next(ui + 1, nxt);
        const char* nA = has_next ? (const char*)((DUAL && nxt.part) ? g.A2 : g.A) + (size_t)nxt.pm * tstep : cA; const char* nB = has_next ? (const char*)((DUAL && nxt.part) ? g.Bt2 : g.Bt) + (size_t)nxt.pn * tstep : cB;
        for (int t = 0; t < nt; t += 2) {
            const bool last = (t == nt - 2);
            const char* a1 = cA + (size_t)(t + 1) * kstep;
            const char* a2 = last ? nA : cA + (size_t)(t + 2) * kstep; const char* b2 = last ? nB : cB + (size_t)(t + 2) * kstep;
            const char* a3 = a2 + kstep; const char* b3 = b2 + kstep;
            if (last && has_next) S.a_ready(nxt);
            if constexpr (SP2) {
            PG8_LDB(B0, 0, 0); PG8_LDB(B1, 0, 1); PG8_SCHED; PG8_LDA(At, 0, 0); PG8_STAGE(PG8_SA(1, 1), a1 + hstep, voffA);
            PG8_WAIT_V(8); PG8_WAIT_L(0); PG8_BAR; PG8_MMA(0, 0, At, B0); PG8_MMA(0, 1, At, B1); PG8_BAR; PG8_SCHED;
            PG8_LDA(At, 0, 1); PG8_STAGE(PG8_SB(0, 0), b2, voffB); PG8_STAGE(PG8_SB(0, 1), b2 + hstep, voffB); PG8_STAGE(PG8_SA(0, 0), a2, voffA);
            PG8_WAIT_V(8); PG8_WAIT_L(0); PG8_BAR; PG8_MMA(1, 0, At, B0); PG8_MMA(1, 1, At, B1); PG8_BAR; PG8_SCHED;
            PG8_LDB(B0, 1, 0); PG8_LDB(B1, 1, 1); PG8_SCHED; PG8_LDA(At, 1, 0); PG8_STAGE(PG8_SA(0, 1), a2 + hstep, voffA);
            PG8_WAIT_V(8); PG8_WAIT_L(0); PG8_BAR; PG8_MMA(0, 0, At, B0); PG8_MMA(0, 1, At, B1); PG8_BAR; PG8_SCHED;
            PG8_LDA(At, 1, 1); PG8_STAGE(PG8_SB(1, 0), b3, voffB); PG8_STAGE(PG8_SB(1, 1), b3 + hstep, voffB); PG8_STAGE(PG8_SA(1, 0), a3, voffA);
            PG8_WAIT_V(8); PG8_WAIT_L(0); PG8_BAR; PG8_MMA(1, 0, At, B0); PG8_MMA(1, 1, At, B1); PG8_BAR; PG8_SCHED;
            } else {
            PG8_LDB(B0, 0, 0); PG8_SCHED; PG8_LDA(At, 0, 0); PG8_STAGE(PG8_SA(1, 1), a1 + hstep, voffA);
            PG8_WAIT_L(8); PG8_BAR; PG8_WAIT_L(0); PG8_MMA(0, 0, At, B0); PG8_BAR; PG8_SCHED;
            PG8_LDB(B1, 0, 1); PG8_STAGE(PG8_SB(0, 0), b2, voffB);
            PG8_BAR; PG8_WAIT_L(0); PG8_MMA(0, 1, At, B1); PG8_BAR;
            PG8_LDA(At, 0, 1); PG8_STAGE(PG8_SA(0, 0), a2, voffA);
            PG8_BAR; PG8_WAIT_L(0); PG8_MMA(1, 0, At, B0); PG8_BAR; PG8_SCHED;
            PG8_STAGE(PG8_SB(0, 1), b2 + hstep, voffB);
            PG8_WAIT_V(6); PG8_BAR; PG8_MMA(1, 1, At, B1); PG8_BAR;
            PG8_LDB(B0, 1, 0); PG8_SCHED; PG8_LDA(At, 1, 0); PG8_STAGE(PG8_SA(0, 1), a2 + hstep, voffA);
            PG8_WAIT_L(8); PG8_BAR; PG8_WAIT_L(0); PG8_MMA(0, 0, At, B0); PG8_BAR; PG8_SCHED;
            PG8_LDB(B1, 1, 1); PG8_STAGE(PG8_SB(1, 0), b3, voffB);
            PG8_BAR; PG8_WAIT_L(0); PG8_MMA(0, 1, At, B1); PG8_BAR;
            PG8_LDA(At, 1, 1); PG8_STAGE(PG8_SA(1, 0), a3, voffA);
            PG8_BAR; PG8_WAIT_L(0); PG8_MMA(1, 0, At, B0); PG8_BAR; PG8_SCHED;
            PG8_STAGE(PG8_SB(1, 1), b3 + hstep, voffB);
            PG8_WAIT_V(6); PG8_BAR; PG8_MMA(1, 1, At, B1); PG8_BAR;
            }
        }
        if constexpr (ALIGN_EPI) { if (wr == 0) PG8_BAR; }
        bool keep_acc = false;
        if constexpr (DUAL) { if (cur.part == 0) { E.mid(acc, cur, wr, wc, fr, fq); keep_acc = true; } else E(acc, cur, wr, wc, fr, fq); }
        else if constexpr (!Epi::AFTER_DRAIN) { E(acc, cur, wr, wc, fr, fq); S.done(cur); }
        if (!has_next) break;
        if (!keep_acc) {
#pragma unroll
        for (int a = 0; a < 2; ++a)
#pragma unroll
            for (int b = 0; b < 2; ++b)
#pragma unroll
                for (int m = 0; m < 4; ++m)
#pragma unroll
                    for (int n = 0; n < 2; ++n) acc[a][b][m][n] = acc_t{};
        }
        cur = nxt; cA = nA; cB = nB; ++ui;
        if constexpr (ALIGN_EPI) { if (wr == 1) PG8_BAR; }
    }
    PG8_WAIT_V(0);
    if constexpr (!ALIGN_EPI) { if (wr == 0) PG8_BAR; }
    PG8_BAR;
    if constexpr (Epi::AFTER_DRAIN) { E.fused(acc, cur, wr, wc, fr, fq, lds, wid, lane); S.done(cur); }
#undef PG8_SA
#undef PG8_SB
#undef PG8_STAGE
#undef PG8_LDA
#undef PG8_LDB
#undef PG8_MMA
#undef PG8_WAIT_V
#undef PG8_WAIT_L
#undef PG8_BAR
#undef PG8_SCHED
}
}
namespace pg8 {
struct GUnit { int e, row0, nrows, pn, cntm1, base, tau; };
struct MoeOrder {
    const PG8_LAS int* tab; int npn, G, c, total;
    __device__ __forceinline__ void init(const PG8_LAS int* t, int npn_, int G_, int c_) { tab = t; npn = npn_; G = G_; c = c_; total = __builtin_amdgcn_readfirstlane(t[32]) * npn_; }
    __device__ __forceinline__ bool next(int i, GUnit& u) const {
        const int L = i * G + c; if (L >= total) return false;
        const int tau = L / npn; u.pn = L % npn;
        int e = 0;
#pragma unroll
        for (int j = 1; j < 32; ++j) e += (__builtin_amdgcn_readfirstlane(tab[j]) <= tau) ? 1 : 0;
        const int cn = __builtin_amdgcn_readfirstlane(tab[33 + e]), t0 = __builtin_amdgcn_readfirstlane(tab[e]);
        u.e = e; u.row0 = (tau - t0) * 256; u.nrows = (cn - u.row0) < 256 ? (cn - u.row0) : 256; u.cntm1 = cn - 1; u.base = __builtin_amdgcn_readfirstlane(tab[65 + e]); u.tau = tau;
        return true;
    }
};
struct RowsGather {
    static constexpr bool LOADS = true;
    const int* lists;
    __device__ __forceinline__ int raw0(const GUnit&) const { return 0; }
    __device__ __forceinline__ const int* addr(const GUnit& u, int R) const { int s = u.row0 + R; s = s < u.cntm1 ? s : u.cntm1; return lists + (size_t)u.e * 32768 + s; }
    __device__ __forceinline__ int raw(const GUnit& u, int R) const { int s = u.row0 + R; s = s < u.cntm1 ? s : u.cntm1; return lists[(size_t)u.e * 32768 + s]; }
    static __device__ __forceinline__ unsigned row(int raw) { return (unsigned)raw >> 2; }
};
struct RowsDense {
    static constexpr bool LOADS = false;
    __device__ __forceinline__ const int* addr(const GUnit&, int) const { return nullptr; }
    __device__ __forceinline__ int raw0(const GUnit& u) const { return u.base + u.row0; }
    __device__ __forceinline__ int raw(const GUnit& u, int R) const { int s = u.row0 + R; s = s < u.cntm1 ? s : u.cntm1; return u.base + s; }
    static __device__ __forceinline__ unsigned row(int raw) { return (unsigned)raw; }
};
struct EpiMoeGU {
    static constexpr bool PERM = true, AFTER_DRAIN = false;
    const float* b_gu; const float* LRS; const float* SB; unsigned char* ACTq; float* SACT; PG8_LAS float* xm;
    __device__ __forceinline__ void operator()(const i32x4 (&acc)[2][2][4][2], const GUnit& u, int wr, int wc, int fr, int fq) const {
        const int fq_ = ::launder(fq), ch0 = u.pn * 128 + wc * 32 + 8 * fq_, rb = ::launder(wr * 64 + fr); const float* bp = b_gu + (size_t)u.e * 2048 + ch0;
        const float* sp = SB + (size_t)u.e * 2048 + u.pn * 256 + wc * 32 + 8 * fq_;
        const float* lrs = LRS + (size_t)u.e * 32768 + u.row0;
        f32x4 bg[2], bu[2], sg[2], su[2];
#pragma unroll
        for (int n = 0; n < 2; ++n) { bg[n] = *(const f32x4*)(bp + 4 * n); bu[n] = *(const f32x4*)(bp + 1024 + 4 * n); sg[n] = *(const f32x4*)(sp + 4 * n); su[n] = *(const f32x4*)(sp + HALF + 4 * n); }
        float rsv[2][4];
#pragma unroll
        for (int ai = 0; ai < 2; ++ai)
#pragma unroll
            for (int m = 0; m < 4; ++m) { int rr = ai * HALF + m * 16 + rb; rr = rr < u.nrows ? rr : u.nrows - 1; rsv[ai][m] = lrs[rr]; }
        f32x4 af[2][2][4][2];
#pragma unroll
        for (int ai = 0; ai < 2; ++ai)
#pragma unroll
            for (int bj = 0; bj < 2; ++bj)
#pragma unroll
                for (int m = 0; m < 4; ++m)
#pragma unroll
                    for (int n = 0; n < 2; ++n) { af[ai][bj][m][n] = __builtin_convertvector(acc[ai][bj][m][n], f32x4); asm volatile("" : "+v"(af[ai][bj][m][n])); }
        f32x2 av[2][4][4];
#pragma unroll
        for (int ai = 0; ai < 2; ++ai)
#pragma unroll
            for (int m = 0; m < 4; ++m) { const float rs = rsv[ai][m];
                const f32x4 sgr[2] = {sg[0] * rs, sg[1] * rs}, sur[2] = {su[0] * rs, su[1] * rs};
                f32x2 o[4];
#pragma unroll
                for (int n = 0; n < 2; ++n) {
                    o[2 * n] = swiglu_pk(lo2(af[ai][0][m][n]) * lo2(sgr[n]) + lo2(bg[n]), lo2(af[ai][1][m][n]) * lo2(sur[n]) + lo2(bu[n]));
                    o[2 * n + 1] = swiglu_pk(hi2(af[ai][0][m][n]) * hi2(sgr[n]) + hi2(bg[n]), hi2(af[ai][1][m][n]) * hi2(sur[n]) + hi2(bu[n])); }
                av[ai][m][0] = o[0]; av[ai][m][1] = o[1]; av[ai][m][2] = o[2]; av[ai][m][3] = o[3];
                float mx = fmaxf(fmaxf(fmaxf(fabsf(o[0].x), fabsf(o[0].y)), fmaxf(fabsf(o[1].x), fabsf(o[1].y))), fmaxf(fmaxf(fabsf(o[2].x), fabsf(o[2].y)), fmaxf(fabsf(o[3].x), fabsf(o[3].y))));
                mx = ::lane_max_16_32(mx);
                if (fq == 0) (xm + (ai * HALF + m * 16) * 4 + wc)[rb * 4] = mx; }
        asm volatile("s_waitcnt lgkmcnt(0)" ::: "memory"); __builtin_amdgcn_s_barrier(); asm volatile("" ::: "memory");
        unsigned char* actp = ACTq + ((size_t)u.tau * 8 + u.pn) * 32768; float* scp = SACT + (size_t)(u.base + u.row0) * 8 + u.pn;
        const unsigned loff = (unsigned)rb * 128u + (unsigned)(wc * 32 + 8 * fq_), soff = (unsigned)rb * 8u, xoff = (unsigned)rb * 4u;
#pragma unroll
        for (int ai = 0; ai < 2; ++ai)
#pragma unroll
            for (int m = 0; m < 4; ++m) { const int rs0 = ai * HALF + m * 16;
                const f32x4 t = *(const PG8_LAS f32x4*)(xm + rs0 * 4 + xoff); const float tmax = fmaxf(fmaxf(t[0], t[1]), fmaxf(t[2], t[3])), inv = tmax > 0.f ? 127.f * __builtin_amdgcn_rcpf(tmax) : 0.f;
                if (rb < u.nrows - rs0) { const f32x2 q0_ = av[ai][m][0] * inv, q1_ = av[ai][m][1] * inv, q2_ = av[ai][m][2] * inv, q3_ = av[ai][m][3] * inv;
                    u32x2 q; q.x = ::pk4_i8(q0_.x, q0_.y, q1_.x, q1_.y); q.y = ::pk4_i8(q2_.x, q2_.y, q3_.x, q3_.y);
                    *(u32x2*)(actp + (size_t)rs0 * 128 + loff) = q;
                    if (wc == 0 && fq == 0) (scp + (size_t)rs0 * 8)[soff] = tmax * (1.f / 127.f); } }
    }
};
struct EpiMoeDown {
    static constexpr bool PERM = true, AFTER_DRAIN = false;
    const float* b_dn; const float* SB; const int* lists; const float* LGT; bf16_t* Y;
    __device__ __forceinline__ void operator()(const f32x4 (&acc)[2][2][4][2], const GUnit& u, int wr, int wc, int fr, int fq, const PG8_LAS float* scb  ) const {
        const int col0 = u.pn * BM + wc * 32 + 8 * ::launder(fq), rb = ::launder(wr * 64 + fr); const float* bp = b_dn + (size_t)u.e * 1024 + col0;
        const int* lp = lists + (size_t)u.e * 32768 + u.row0; const float* gp = LGT + (size_t)u.e * 32768 + u.row0; const float* sp = SB + (size_t)u.e * 1024 + col0;
        f32x4 bv[2][2], sv[2][2];
#pragma unroll
        for (int bj = 0; bj < 2; ++bj)
#pragma unroll
            for (int n = 0; n < 2; ++n) { bv[bj][n] = *(const f32x4*)(bp + bj * HALF + 4 * n); sv[bj][n] = *(const f32x4*)(sp + bj * HALF + 4 * n); }
        int idv[2][4]; float gtv[2][4];
#pragma unroll
        for (int ai = 0; ai < 2; ++ai)
#pragma unroll
            for (int m = 0; m < 4; ++m) { int rr = ai * HALF + m * 16 + rb; rr = rr < u.nrows ? rr : u.nrows - 1; idv[ai][m] = lp[rr]; gtv[ai][m] = gp[rr]; }
#pragma unroll
        for (int ai = 0; ai < 2; ++ai)
#pragma unroll
            for (int m = 0; m < 4; ++m) { const int rs0 = ai * HALF + m * 16;
                if (rb < u.nrows - rs0) { const float gt = gtv[ai][m]; bf16_t* yp = Y + (size_t)idv[ai][m] * 1024 + col0;
                    const float off = scb[rs0 + rb];
#pragma unroll
                    for (int bj = 0; bj < 2; ++bj) *(u32x4*)(yp + bj * HALF) = pack8(((acc[ai][bj][m][0] - off) * sv[bj][0] + bv[bj][0]) * gt, ((acc[ai][bj][m][1] - off) * sv[bj][1] + bv[bj][1]) * gt); } }
    }
};

template <class Epi, class Sched, class Rows, int KE = 1024, bool I8 = false, bool BS = false, bool KTM = false>
__device__ __forceinline__ void gemm_phase_g(int wave_  , PG8_LAS unsigned char* lds, PG8_LAS unsigned char* park  , PG8_LAS unsigned char* spark  , const float* ASC, const bf16_t* A, const bf16_t* Bt, size_t b_estride  , const Sched& S, const Rows& RW, const Epi& E) {
    const int tid = ::tid_of(wave_), wid = wave_, lane = tid & 63, wr = wid >> 2, wc = wid & 3, fr = lane & 15, fq = lane >> 4;
    constexpr int K = KE, nt = K / BK;
    typedef typename AccSel<I8 && !BS>::T acc_t;
    unsigned voffB[2];
#pragma unroll
    for (int i = 0; i < 2; ++i) { int R, C; stage_rc(tid * 16 + i * 8192, R, C); const int Rb = Epi::PERM ? ((R & ~31) + perm32(R & 31)) : R; voffB[i] = (unsigned)(Rb * K + C) * 2u; }
#define PG8_RC(i, R, C) int R, C; stage_rc(::tid_of(wave_) * 16 + (i) * 8192, R, C)
    constexpr size_t kstep = (size_t)(BK * 2), hstep = (size_t)HALF * K * 2, tstep = 2 * hstep, kstepA = KTM ? (size_t)32768 : kstep;
    const unsigned ldsw = (unsigned)wid * 1024u;
    const int aoff = lds_byte(wr * 64 + fr, fq * 8), boff = lds_byte(wc * 32 + fr, fq * 8);
#define PG8_SA(b, h) (((b) * 2 + (h)) * HTB)
#define PG8_SB(b, h) ((4 + (b) * 2 + (h)) * HTB)
#define PG8_STAGE(bufoff, gbase, voff) do { _Pragma("unroll") for (int _i = 0; _i < 2; ++_i) \
        __builtin_amdgcn_global_load_lds((const unsigned*)((const char*)(gbase) + (voff)[_i]), (PG8_LAS unsigned*)(lds + (bufoff) + ldsw + _i * 8192), 16, 0, 0); } while (0)
#define PG8_LDA(dst, b, h) do { _Pragma("unroll") for (int m = 0; m < 4; ++m) _Pragma("unroll") for (int k = 0; k < 2; ++k) dst[m][k] = *(const PG8_LAS bf16x8*)(lds + PG8_SA(b, h) + aoff + m * 2048 + k * 1024); } while (0)
#define PG8_LDB(dst, b, h) do { _Pragma("unroll") for (int n = 0; n < 2; ++n) _Pragma("unroll") for (int k = 0; k < 2; ++k) dst[n][k] = *(const PG8_LAS bf16x8*)(lds + PG8_SB(b, h) + boff + n * 2048 + k * 1024); } while (0)
#define PG8_MMA(ai, bj, At, Bt) do { __builtin_amdgcn_s_setprio(1); _Pragma("unroll") for (int m = 0; m < 4; ++m) _Pragma("unroll") for (int n = 0; n < 2; ++n) _Pragma("unroll") for (int k = 0; k < 2; ++k) \
        acc[ai][bj][m][n] = mma16(Bt[n][k], At[m][k], acc[ai][bj][m][n]); __builtin_amdgcn_s_setprio(0); } while (0)
#define PG8_MMA_BS(ai, bj, At, Bt, sc) do { _Pragma("unroll") for (int m = 0; m < 4; ++m) { i32x4 tq_[2]; __builtin_amdgcn_s_setprio(1); \
        _Pragma("unroll") for (int n = 0; n < 2; ++n) tq_[n] = mma16(Bt[n][0], At[m][0], magic); \
        _Pragma("unroll") for (int n = 0; n < 2; ++n) tq_[n] = mma16(Bt[n][1], At[m][1], tq_[n]); \
        __builtin_amdgcn_s_setprio(0); \
        _Pragma("unroll") for (int n = 0; n < 2; ++n) acc[ai][bj][m][n] = acc[ai][bj][m][n] + __builtin_bit_cast(f32x4, tq_[n]) * sc[m]; } } while (0)
#define PG8_LDSC(sc, ai, kt) do { if constexpr (BS) { _Pragma("unroll") for (int m = 0; m < 4; ++m) sc[m] = *(const PG8_LAS float*)(spark + (ui & 1) * 8192 + (((ai) * HALF + wr * 64 + m * 16 + fr) * 8 + (kt)) * 4); } } while (0)
#define PG8_SSUM(par_) do { const int t_ = ::tid_of(wave_), row_ = t_ >> 1, hf_ = t_ & 1; \
        const f32x4 s4_ = *(const PG8_LAS f32x4*)(spark + (par_) * 8192 + row_ * 32 + hf_ * 16); \
        float sm_ = (s4_.x + s4_.y) + (s4_.z + s4_.w); sm_ += __shfl_xor(sm_, 1); \
        if (hf_ == 0) *(PG8_LAS float*)(spark - 2048 + (par_) * 1024 + row_ * 4) = sm_ * 12582912.f; } while (0)
#define PG8_MM2(ai) do { if constexpr (BS) { PG8_MMA_BS(ai, 0, At, B0, sc); PG8_MMA_BS(ai, 1, At, B1, sc); } else { PG8_MMA(ai, 0, At, B0); PG8_MMA(ai, 1, At, B1); } } while (0)
#define PG8_SPARK(u_, par_) do { if constexpr (BS) __builtin_amdgcn_global_load_lds((const unsigned*)(ASC + (size_t)((u_).base + (u_).row0) * 8 + wid * 256 + lane * 4), (PG8_LAS unsigned*)(spark + (par_) * 8192 + wid * 1024), 16, 0, 0); } while (0)
#define PG8_WAIT_V(n) asm volatile("s_waitcnt vmcnt(" #n ")" ::: "memory")
#define PG8_WAIT_L(n) asm volatile("s_waitcnt lgkmcnt(" #n ")" ::: "memory")
#define PG8_BAR __builtin_amdgcn_s_barrier()
#define PG8_SCHED __builtin_amdgcn_sched_barrier(0)
    GUnit cur, nxt, nn; int ui = 0;
    if (!S.next(0, cur)) return;
    bool has_next = S.next(1, nxt), has_nn = has_next && S.next(2, nn);
    unsigned voC[2][2], voN[2][2];
    PG8_LAS unsigned char* pk = park + wid * 1024;
#define PG8_PARK(u_) do { if constexpr (Rows::LOADS) { _Pragma("unroll") for (int i = 0; i < 2; ++i) { PG8_RC(i, R_, C_); (void)C_; _Pragma("unroll") for (int h = 0; h < 2; ++h) \
        __builtin_amdgcn_global_load_lds((const unsigned*)RW.addr(u_, h * HALF + R_), (PG8_LAS unsigned*)(pk + (h * 2 + i) * 256), 4, 0, 0); } } } while (0)
#define PG8_UNPARK(h, i) (*(const PG8_LAS int*)(pk + ((h) * 2 + (i)) * 256 + lane * 4))
#pragma unroll
    for (int i = 0; i < 2; ++i) { PG8_RC(i, R_, C_);
#pragma unroll
        for (int h = 0; h < 2; ++h) {
            if constexpr (Rows::LOADS) {
                voC[h][i] = Rows::row(RW.raw(cur, h * HALF + R_)) * (unsigned)(K * 2) + (unsigned)C_ * 2u;
                voN[h][i] = has_next ? Rows::row(RW.raw(nxt, h * HALF + R_)) * (unsigned)(K * 2) + (unsigned)C_ * 2u : voC[h][i];
            } else { voC[h][i] = (unsigned)(h * HALF + R_) * (KTM ? 128u : (unsigned)(K * 2)) + (unsigned)C_ * 2u; voN[h][i] = 0u; } } }
    if (has_nn) PG8_PARK(nn);
    acc_t acc[2][2][4][2];
#pragma unroll
    for (int a = 0; a < 2; ++a)
#pragma unroll
        for (int b = 0; b < 2; ++b)
#pragma unroll
            for (int m = 0; m < 4; ++m)
#pragma unroll
                for (int n = 0; n < 2; ++n) acc[a][b][m][n] = acc_t{};
    bf16x8 At[4][2], B0[2][2], B1[2][2]; float sc[4];
    i32x4 magic = {0x4B400000, 0x4B400000, 0x4B400000, 0x4B400000}; asm volatile("" : "+v"(magic));
    const char* cA = (const char*)A; if constexpr (!Rows::LOADS) cA += KTM ? (size_t)cur.tau * 262144 : (size_t)Rows::row(RW.raw0(cur)) * (size_t)(K * 2);
    const char* cB = (const char*)Bt + (size_t)cur.e * b_estride + (size_t)cur.pn * tstep;
    PG8_SPARK(cur, 0); if (has_next) PG8_SPARK(nxt, 1);
    PG8_STAGE(PG8_SB(0, 0), cB, voffB); PG8_STAGE(PG8_SB(0, 1), cB + hstep, voffB); PG8_STAGE(PG8_SA(0, 0), cA, voC[0]); PG8_STAGE(PG8_SA(0, 1), cA, voC[1]);
    if (wr == 1) PG8_BAR;
    PG8_WAIT_V(2); PG8_BAR;
    PG8_STAGE(PG8_SB(1, 0), cB + kstep, voffB); PG8_STAGE(PG8_SA(1, 0), cA + kstepA, voC[0]); PG8_STAGE(PG8_SB(1, 1), cB + hstep + kstep, voffB);
    PG8_WAIT_V(6); PG8_BAR;
    for (;;) {
        const char* nA = cA; if constexpr (!Rows::LOADS) { if (has_next) nA = (const char*)A + (KTM ? (size_t)nxt.tau * 262144 : (size_t)Rows::row(RW.raw0(nxt)) * (size_t)(K * 2)); }
        const char* nB = has_next ? (const char*)Bt + (size_t)nxt.e * b_estride + (size_t)nxt.pn * tstep : cB;
        for (int t = 0; t < nt; t += 2) {
            const bool last = (t == nt - 2);
            const char* a1 = cA + (size_t)(t + 1) * kstepA;
            const char* a2 = last ? nA : cA + (size_t)(t + 2) * kstepA; const char* b2 = last ? nB : cB + (size_t)(t + 2) * kstep;
            const char* a3 = a2 + kstepA; const char* b3 = b2 + kstep;
            unsigned v20[2], v21[2];
#pragma unroll
            for (int i = 0; i < 2; ++i) { if constexpr (Rows::LOADS) { v20[i] = last ? voN[0][i] : voC[0][i]; v21[i] = last ? voN[1][i] : voC[1][i]; } else { v20[i] = voC[0][i]; v21[i] = voC[1][i]; } }
            if constexpr (BS) { if (t == 2) PG8_SSUM(ui & 1); }
            PG8_LDB(B0, 0, 0); PG8_LDB(B1, 0, 1); PG8_SCHED; PG8_LDA(At, 0, 0); PG8_LDSC(sc, 0, t); PG8_STAGE(PG8_SA(1, 1), a1, voC[1]);
            PG8_WAIT_V(8); PG8_WAIT_L(0); PG8_BAR; PG8_MM2(0); PG8_BAR; PG8_SCHED;
            PG8_LDA(At, 0, 1); PG8_LDSC(sc, 1, t); PG8_STAGE(PG8_SB(0, 0), b2, voffB); PG8_STAGE(PG8_SB(0, 1), b2 + hstep, voffB); PG8_STAGE(PG8_SA(0, 0), a2, v20);
            PG8_WAIT_V(8); PG8_WAIT_L(0); PG8_BAR; PG8_MM2(1); PG8_BAR; PG8_SCHED;
            PG8_LDB(B0, 1, 0); PG8_LDB(B1, 1, 1); PG8_SCHED; PG8_LDA(At, 1, 0); PG8_LDSC(sc, 0, t + 1); PG8_STAGE(PG8_SA(0, 1), a2, v21);
            PG8_WAIT_V(8); PG8_WAIT_L(0); PG8_BAR; PG8_MM2(0); PG8_BAR; PG8_SCHED;
            PG8_LDA(At, 1, 1); PG8_LDSC(sc, 1, t + 1); PG8_STAGE(PG8_SB(1, 0), b3, voffB); PG8_STAGE(PG8_SB(1, 1), b3 + hstep, voffB); PG8_STAGE(PG8_SA(1, 0), a3, v20);
            PG8_WAIT_V(8); PG8_WAIT_L(0); PG8_BAR; PG8_MM2(1); PG8_BAR; PG8_SCHED;
        }
        if (wr == 0) PG8_BAR;
        if constexpr (BS) E(acc, cur, wr, wc, fr, fq, (const PG8_LAS float*)(spark - 2048 + (ui & 1) * 1024)); else E(acc, cur, wr, wc, fr, fq);
        if (!has_next) break;
#pragma unroll
        for (int a = 0; a < 2; ++a)
#pragma unroll
            for (int b = 0; b < 2; ++b)
#pragma unroll
                for (int m = 0; m < 4; ++m)
#pragma unroll
                    for (int n = 0; n < 2; ++n) acc[a][b][m][n] = acc_t{};
        cur = nxt; cB = nB; cA = nA; nxt = nn; has_next = has_nn; ++ui;
        has_nn = has_next && S.next(ui + 2, nn);
        if constexpr (Rows::LOADS) {
#pragma unroll
        for (int i = 0; i < 2; ++i) { PG8_RC(i, R_, C_);
#pragma unroll
            for (int h = 0; h < 2; ++h) { voC[h][i] = voN[h][i];
                if (has_next) voN[h][i] = Rows::row(PG8_UNPARK(h, i)) * (unsigned)(K * 2) + (unsigned)C_ * 2u; } }
        }
        if constexpr (Rows::LOADS) { PG8_WAIT_L(0); asm volatile("" ::: "memory"); }
        if (has_nn) PG8_PARK(nn);
        if (has_next) PG8_SPARK(nxt, (ui + 1) & 1);
        if (wr == 1) PG8_BAR;
    }
    PG8_WAIT_V(0);
    PG8_BAR;
#undef PG8_PARK
#undef PG8_MMA_BS
#undef PG8_LDSC
#undef PG8_SSUM
#undef PG8_MM2
#undef PG8_SPARK
#undef PG8_RC
#undef PG8_UNPARK
#undef PG8_SA
#undef PG8_SB
#undef PG8_STAGE
#undef PG8_LDA
#undef PG8_LDB
#undef PG8_MMA
#undef PG8_WAIT_V
#undef PG8_WAIT_L
#undef PG8_BAR
#undef PG8_SCHED
}
}
#include <hip/hip_bf16.h>
#include <cmath>
namespace attn_body {
using bf16=__hip_bfloat16;
using bf16x8=__attribute__((ext_vector_type(8)))short;
using s16x4=__attribute__((ext_vector_type(4)))short;
using f32x16=__attribute__((ext_vector_type(16)))float;
using u32x4=__attribute__((ext_vector_type(4)))unsigned;
typedef float f32x4_t __attribute__((ext_vector_type(4)));
constexpr int BATCH=4,NHEAD=16,SEQ=8192,KVR=SEQ+64,D=64,DM=NHEAD*D;
constexpr int NW=8,QBLK=32,QB=QBLK*NW,KVBLK=64,NQB=SEQ/QB;
constexpr int ATTN_PITCH=DM, ATTN_UNIT_ROWS=QB;
__device__ __forceinline__ int crow(int r,int hi){return (r&3)+8*(r>>2)+4*hi;}
#define SBAR() __builtin_amdgcn_sched_barrier(0)
__device__ __forceinline__ void cmask(f32x16&p0,f32x16&p1,int jb,int qrel,int hi){
  const float NEG=-INFINITY; int kb=64*jb+4*hi;
  #pragma unroll
  for(int r=0;r<16;++r){int kv=kb+(r&3)+8*(r>>2); if(kv>qrel)p0[r]=NEG; if(kv+32>qrel)p1[r]=NEG;}
}

constexpr int NSLOT=3, SLOTB=8192;
constexpr int LDS_K=0, LDS_V=NSLOT*SLOTB, LDS_WS=2*NSLOT*SLOTB, LDS_OST=LDS_WS+NW*64*4, LDS_BIAS=LDS_OST+NW*4096, LDS_KN=LDS_BIAS+KVR*4, LDS_QM=LDS_KN+132*4, LDS_BYTES=LDS_QM+32;
constexpr float SKIP_THR=24.f;
constexpr float C2=0.125f*1.4426950408889634f;
__device__ __forceinline__ void glds16(const void*gsrc,unsigned lds_dst){unsigned keep;
  asm volatile("s_mov_b32 %0, m0\n\ts_mov_b32 m0, %2\n\ts_nop 0\n\tglobal_load_lds_dwordx4 %1, off\n\ts_mov_b32 m0, %0":"=&s"(keep):"v"(gsrc),"s"(lds_dst):"memory");}
__device__ __forceinline__ float max3f(float a,float b,float c){float r;asm("v_max3_f32 %0, %1, %2, %3":"=v"(r):"v"(a),"v"(b),"v"(c));return r;}
__device__ __forceinline__ float max2f(float a,float b){float r;asm("v_max_f32_e32 %0, %1, %2":"=v"(r):"v"(a),"v"(b));return r;}
__device__ __forceinline__ float fadd_s(float a,float b){float r;asm("v_add_f32_e32 %0, %1, %2":"=v"(r):"v"(a),"v"(b));return r;}
__device__ __forceinline__ float fsub_s(float a,float b){float r;asm("v_sub_f32_e32 %0, %1, %2":"=v"(r):"v"(a),"v"(b));return r;}
typedef float f32x2_t __attribute__((ext_vector_type(2))); typedef __bf16 bf16x2_t __attribute__((ext_vector_type(2)));
__device__ __forceinline__ unsigned cvtpk_s(float lo,float hi){f32x2_t v={lo,hi};bf16x2_t b=__builtin_convertvector(v,bf16x2_t);return __builtin_bit_cast(unsigned,b);}
#define WAIT_BAR(N) asm volatile("s_waitcnt vmcnt(" #N ") lgkmcnt(0)\n\ts_barrier":::"memory")

__device__ __forceinline__ void qkt(f32x16&p0,f32x16&p1,const char*Kslot,const bf16x8*qr,int r32,int hi){
  const char*kb=Kslot+hi*1024+r32*16;
  #pragma unroll
  for(int d0=0;d0<4;++d0){
    const bf16x8 b0=*reinterpret_cast<const bf16x8*>(kb+d0*2048);
    const bf16x8 b1=*reinterpret_cast<const bf16x8*>(kb+d0*2048+512);
    {p0=__builtin_amdgcn_mfma_f32_32x32x16_bf16(b0,qr[d0],p0,0,0,0);p1=__builtin_amdgcn_mfma_f32_32x32x16_bf16(b1,qr[d0],p1,0,0,0);}}
}
typedef __attribute__((address_space(3))) const char* lds_cptr;
typedef short v4i16_t __attribute__((ext_vector_type(4)));
__device__ __forceinline__ void kload8(bf16x8*kf,lds_cptr kp){
  kf[0]=*(const __attribute__((address_space(3))) bf16x8*)(kp);      kf[1]=*(const __attribute__((address_space(3))) bf16x8*)(kp+512);
  kf[2]=*(const __attribute__((address_space(3))) bf16x8*)(kp+2048); kf[3]=*(const __attribute__((address_space(3))) bf16x8*)(kp+2560);
  kf[4]=*(const __attribute__((address_space(3))) bf16x8*)(kp+4096); kf[5]=*(const __attribute__((address_space(3))) bf16x8*)(kp+4608);
  kf[6]=*(const __attribute__((address_space(3))) bf16x8*)(kp+6144); kf[7]=*(const __attribute__((address_space(3))) bf16x8*)(kp+6656);
}
__device__ __forceinline__ void kload2(bf16x8*kf,lds_cptr kp,int j){ kf[2*j]=*(const __attribute__((address_space(3))) bf16x8*)(kp+j*2048); kf[2*j+1]=*(const __attribute__((address_space(3))) bf16x8*)(kp+j*2048+512); }
__device__ __forceinline__ s16x4 vtr(lds_cptr p){ return __builtin_bit_cast(s16x4,__builtin_amdgcn_ds_read_tr16_b64_v4i16((__attribute__((address_space(3))) v4i16_t*)p)); }
__device__ __forceinline__ float rowmax(const f32x16&p0,const f32x16&p1){
  float a=max3f(p0[0],p0[1],p1[0]),b=max3f(p0[2],p0[3],p1[1]);a=max3f(a,p1[2],p1[3]);
  #pragma unroll
  for(int r=4;r<16;r+=4){a=max3f(a,p0[r],p0[r+1]);b=max3f(b,p0[r+2],p0[r+3]);a=max3f(a,p1[r],p1[r+1]);b=max3f(b,p1[r+2],p1[r+3]);}
  const float m=max2f(a,b);
  auto rr=__builtin_amdgcn_permlane32_swap(__float_as_uint(m),__float_as_uint(m),false,false);
  return max2f(__uint_as_float(rr[0]),__uint_as_float(rr[1]));
}
__device__ __forceinline__ void pv(f32x16*o,int vb,bf16x8 pa0,bf16x8 pa1,bf16x8 pa2,bf16x8 pa3){
  #pragma unroll
  for(int d0=0;d0<2;++d0){s16x4 lo[4],hi[4];
    #pragma unroll
    for(int ks=0;ks<4;++ks){
      asm volatile("ds_read_b64_tr_b16 %0,%1 offset:%c2":"=&v"(lo[ks]):"v"(vb),"i"(d0*4096+ks*1024):"memory");
      asm volatile("ds_read_b64_tr_b16 %0,%1 offset:%c2":"=&v"(hi[ks]):"v"(vb),"i"(d0*4096+ks*1024+512):"memory");}
    asm volatile("s_waitcnt lgkmcnt(0)":::"memory");SBAR();
    #define PK(k) (bf16x8){lo[k][0],lo[k][1],lo[k][2],lo[k][3],hi[k][0],hi[k][1],hi[k][2],hi[k][3]}
    o[d0]=__builtin_amdgcn_mfma_f32_32x32x16_bf16(pa0,PK(0),o[d0],0,0,0);
    o[d0]=__builtin_amdgcn_mfma_f32_32x32x16_bf16(pa1,PK(1),o[d0],0,0,0);
    o[d0]=__builtin_amdgcn_mfma_f32_32x32x16_bf16(pa2,PK(2),o[d0],0,0,0);
    o[d0]=__builtin_amdgcn_mfma_f32_32x32x16_bf16(pa3,PK(3),o[d0],0,0,0);
    #undef PK
  }
}

#ifndef ATTN_STORE16
#define ATTN_STORE16(p,v) (*(u32x4*)(p)=(v))
#endif
__device__ __forceinline__ int attn_jstart(lds_cptr shm3,int ui,int q0,int lane){
  int jstart;
  { const __attribute__((address_space(3))) float*bl=(const __attribute__((address_space(3))) float*)(shm3+LDS_BIAS),*KN=(const __attribute__((address_space(3))) float*)(shm3+LDS_KN),*QM=(const __attribute__((address_space(3))) float*)(shm3+LDS_QM);
    const int NTf=1+(q0+QB)/KVBLK; const float qm2=QM[ui];
    const float kd2=__builtin_fmaxf(__builtin_fmaxf(KN[NTf-4],KN[NTf-3]),__builtin_fmaxf(KN[NTf-2],KN[NTf-1]));
    const float rhs=bl[64+q0]-__builtin_sqrtf(qm2*kd2)-SKIP_THR;
    unsigned long long mk[3];
    #pragma unroll
    for(int c=0;c<3;++c){ const int j=lane+64*c; bool keep=false;
      if(j<NTf-4){ const float bm=(j==0)?bl[15]:bl[64*j+63]; keep=!(__builtin_sqrtf(qm2*KN[j])+bm<rhs); }
      mk[c]=__ballot(keep); }
    int j0=NTf-4; if(mk[2])j0=128+__builtin_ctzll(mk[2]); if(mk[1])j0=64+__builtin_ctzll(mk[1]); if(mk[0])j0=__builtin_ctzll(mk[0]);
    if(j0>NTf-5)j0=NTf-5; jstart=__builtin_amdgcn_readfirstlane(j0&~1); }
  return jstart;
}
template<int THRL> __device__ __forceinline__ void attn_unit(int ui,int b,int h,int qb,const bf16*Q,const bf16*__restrict__ K,const bf16*__restrict__ V,bf16*O,char*shm,bool pre  ,int nui,int nqb  ){
  const int tid=::launder((int)threadIdx.x),lane=tid&63,r32=lane&31,hi=lane>>5; const int wid=__builtin_amdgcn_readfirstlane(tid>>6);
  const long rowbase=(long)b*SEQ, kvbase=(long)b*KVR; const int q0=qb*QB;
  const bf16*Qw=Q+(rowbase+q0+wid*QBLK)*DM+h*D;
  const lds_cptr shm3=(lds_cptr)shm;
  const int jstart=attn_jstart(shm3,ui,q0,lane);
  const bf16*Kh=K+(kvbase+(long)jstart*KVBLK)*DM+h*D,*Vh=V+(kvbase+(long)jstart*KVBLK)*DM+h*D;
  const unsigned lds0=(unsigned)(uintptr_t)shm;
  float*wsf=(float*)(shm+LDS_WS)+wid*64;
  const bf16*ksrc=Kh+(long)lane*DM+wid*8;
  const bf16*vsrc=Vh+(long)(16*(wid&3)+(lane>>2))*DM+(wid>>2)*32+(lane&3)*8;
  const unsigned kdst=lds0+LDS_K+wid*1024, vdst=lds0+LDS_V+wid*1024;
  #define DMA_K(t,slot) glds16(ksrc+(long)(t)*KVBLK*DM,(unsigned)__builtin_amdgcn_readfirstlane(kdst+(slot)))
  #define DMA_V(t,slot) glds16(vsrc+(long)(t)*KVBLK*DM,(unsigned)__builtin_amdgcn_readfirstlane(vdst+(slot)))
  const int vb0=(int)(lds0+LDS_V)+((lane>>4)&1)*32+(lane&3)*8+(4*hi+((lane&15)>>2))*64;
  const char*Kbase=shm+LDS_K; bf16x8 kf[8];
  const lds_cptr kp0=shm3+LDS_K+hi*1024+r32*16; const lds_cptr vp0=shm3+LDS_V+((lane>>4)&1)*32+(lane&3)*8+(4*hi+((lane&15)>>2))*64;
  const int NT=1+(q0+QB)/KVBLK-jstart;
  if(!pre){DMA_K(0,0);DMA_V(0,0);DMA_K(1,SLOTB);}
  bf16x8 qr[4];
  #pragma unroll
  for(int d0=0;d0<4;++d0)qr[d0]=*reinterpret_cast<const bf16x8*>(&Qw[(long)r32*DM+d0*16+hi*8]);
  const float mhat=*(const __attribute__((address_space(3))) float*)(shm3+LDS_BIAS+(64+q0+wid*QBLK+r32)*4); float l_reg=0.f;f32x16 o[2];o[0]=f32x16{};o[1]=f32x16{};
  const lds_cptr biasp=shm3+LDS_BIAS+jstart*256+hi*16;
  #define BINIT(P0,P1,tn) do{ const lds_cptr bp_=biasp+(tn)*256; _Pragma("unroll") for(int g_=0;g_<4;++g_){ \
      const f32x4_t v0_=*(const __attribute__((address_space(3))) f32x4_t*)(bp_+g_*32)-mhat, v1_=*(const __attribute__((address_space(3))) f32x4_t*)(bp_+128+g_*32)-mhat; \
      P0[4*g_]=v0_[0];P0[4*g_+1]=v0_[1];P0[4*g_+2]=v0_[2];P0[4*g_+3]=v0_[3]; P1[4*g_]=v1_[0];P1[4*g_+1]=v1_[1];P1[4*g_+2]=v1_[2];P1[4*g_+3]=v1_[3]; } }while(0)
  const int qrel=wid*QBLK+r32;
  #define CMASK(P0,P1,t) do{int jb_=(t)-(NT-4); if(jb_>=0)cmask(P0,P1,jb_,qrel,hi);}while(0)
  #define START(P0,P1) do{ _Pragma("unroll") for(int r=0;r<16;++r)P0[r]=__builtin_amdgcn_exp2f(P0[r]); }while(0)
  #define RESC() do{}while(0)
  f32x16 pA0,pA1,pB0,pB1;
  int sl_prev=0,sl_cur=0,sl_next=SLOTB;
  #define ROT() do{sl_prev=sl_cur;sl_cur=sl_next;sl_next=(sl_next==(NSLOT-1)*SLOTB)?0:sl_next+SLOTB;}while(0)
  if(!pre)DMA_K(2,2*SLOTB);
  WAIT_BAR(3);
  BINIT(pA0,pA1,0); qkt(pA0,pA1,Kbase,qr,r32,hi);asm volatile("s_nop 15\n\ts_nop 7":"+v"(pA0),"+v"(pA1));CMASK(pA0,pA1,0);
  START(pA0,pA1);
  BINIT(pB0,pB1,1);
  _Pragma("unroll") for(int r=0;r<16;++r)pA1[r]=__builtin_amdgcn_exp2f(pA1[r]);
  WAIT_BAR(0);
  DMA_K(3,0);DMA_V(1,SLOTB);
  ROT();
  kload8(kf,kp0+sl_cur);
  WAIT_BAR(2);
  s16x4 vlo[8],vhi[8]; u32x4 pw0,pw1,pw2,pw3;
  #define PKW(P,B) cvtpk_s(P[B],P[B+1])
  #define PAF(k) __builtin_bit_cast(bf16x8,pw##k)
  #define VFR(i) (bf16x8){vlo[i][0],vlo[i][1],vlo[i][2],vlo[i][3],vhi[i][0],vhi[i][1],vhi[i][2],vhi[i][3]}
  #define PIN(x) asm volatile("":"+v"(x))
  #define MX3(a,b,c) __builtin_fmaxf(__builtin_fmaxf((a),(b)),(c))
  #define GAPA(MF,A0,A1,A2,A3,W0,W1,PW) do{ MF; sacc+=A0; sacc+=A1; sacc+=A2; sacc+=A3; PIN(sacc); W0; W1; PIN(PW); SBAR(); }while(0)
  #define EX(v) __builtin_amdgcn_exp2f(v)
  #define GAPB(MF,X,B) do{ MF; X[B]=EX(X[B]); X[B+1]=EX(X[B+1]); X[B+2]=EX(X[B+2]); X[B+3]=EX(X[B+3]); PIN(X); SBAR(); }while(0)
  #define VRD(i) do{ vlo[i]=vtr(vp_+(((i)>>2)*4096+((i)&3)*1024)); vhi[i]=vtr(vp_+(((i)>>2)*4096+((i)&3)*1024+512)); }while(0)
  #define KRD(G,j) do{ if(G){ kload2(kf,kp0+sl_next,j); SBAR(); } }while(0)
  #define STEP(C0,C1,P0,P1,t,GK,GV,GL) do{ SBAR(); \
    const lds_cptr vp_=vp0+sl_prev; \
    VRD(0); SBAR(); float sacc=(P0[0]+P0[1]); \
    GAPA(C0=__builtin_amdgcn_mfma_f32_32x32x16_bf16(kf[0],qr[0],C0,0,0,0), P0[2],P0[3],P0[4],P0[5],     pw0[0]=PKW(P0,0), pw0[1]=PKW(P0,2), pw0); \
    VRD(4); SBAR(); GAPA(C1=__builtin_amdgcn_mfma_f32_32x32x16_bf16(kf[1],qr[0],C1,0,0,0), P0[6],P0[7],P0[8],P0[9],     pw0[2]=PKW(P0,4), pw0[3]=PKW(P0,6), pw0); \
    VRD(1); SBAR(); GAPA(C0=__builtin_amdgcn_mfma_f32_32x32x16_bf16(kf[2],qr[1],C0,0,0,0),   P0[10],P0[11],P0[12],P0[13], pw1[0]=PKW(P0,8), pw1[1]=PKW(P0,10), pw1); \
    VRD(5); SBAR(); GAPA(C1=__builtin_amdgcn_mfma_f32_32x32x16_bf16(kf[3],qr[1],C1,0,0,0),   P0[14],P0[15],P1[0],P1[1],   pw1[2]=PKW(P0,12),pw1[3]=PKW(P0,14), pw1); \
    VRD(2); SBAR(); GAPA(C0=__builtin_amdgcn_mfma_f32_32x32x16_bf16(kf[4],qr[2],C0,0,0,0),   P1[2],P1[3],P1[4],P1[5],     pw2[0]=PKW(P1,0), pw2[1]=PKW(P1,2), pw2); \
    VRD(6); SBAR(); GAPA(C1=__builtin_amdgcn_mfma_f32_32x32x16_bf16(kf[5],qr[2],C1,0,0,0),   P1[6],P1[7],P1[8],P1[9],     pw2[2]=PKW(P1,4), pw2[3]=PKW(P1,6), pw2); \
    VRD(3); SBAR(); GAPA(C0=__builtin_amdgcn_mfma_f32_32x32x16_bf16(kf[6],qr[3],C0,0,0,0),   P1[10],P1[11],P1[12],P1[13], pw3[0]=PKW(P1,8), pw3[1]=PKW(P1,10), pw3); \
    VRD(7); SBAR(); GAPA(C1=__builtin_amdgcn_mfma_f32_32x32x16_bf16(kf[7],qr[3],C1,0,0,0),   P1[14],P1[15],0.f,0.f,       pw3[2]=PKW(P1,12),pw3[3]=PKW(P1,14), pw3); \
    l_reg+=sacc; \
    if(GK){DMA_K((t)+3,sl_cur);} if(GV){DMA_V((t)+1,sl_next);} \
    CMASK(C0,C1,t); \
    SBAR(); \
    GAPB(o[0]=__builtin_amdgcn_mfma_f32_32x32x16_bf16(PAF(0),VFR(0),o[0],0,0,0), C0,0); \
    GAPB(o[1]=__builtin_amdgcn_mfma_f32_32x32x16_bf16(PAF(0),VFR(4),o[1],0,0,0), C0,4); \
    KRD(GL,0); GAPB(o[0]=__builtin_amdgcn_mfma_f32_32x32x16_bf16(PAF(1),VFR(1),o[0],0,0,0), C0,8); \
    KRD(GL,1); GAPB(o[1]=__builtin_amdgcn_mfma_f32_32x32x16_bf16(PAF(1),VFR(5),o[1],0,0,0), C0,12); \
    KRD(GL,2); GAPB(o[0]=__builtin_amdgcn_mfma_f32_32x32x16_bf16(PAF(2),VFR(2),o[0],0,0,0), C1,0); \
    KRD(GL,3); GAPB(o[1]=__builtin_amdgcn_mfma_f32_32x32x16_bf16(PAF(2),VFR(6),o[1],0,0,0), C1,4); \
    GAPB(o[0]=__builtin_amdgcn_mfma_f32_32x32x16_bf16(PAF(3),VFR(3),o[0],0,0,0), C1,8); \
    GAPB(o[1]=__builtin_amdgcn_mfma_f32_32x32x16_bf16(PAF(3),VFR(7),o[1],0,0,0), C1,12); \
    if(GL){ BINIT(P0,P1,(t)+1); } \
    }while(0)
  int t=1;
  #undef CMASK
  #define CMASK(P0,P1,t) do{}while(0)
  for(;t+5<NT;t+=2){
    STEP(pB0,pB1,pA0,pA1,t,true,true,true);     WAIT_BAR(2); RESC(); ROT();
    STEP(pA0,pA1,pB0,pB1,t+1,true,true,true);   WAIT_BAR(2); RESC(); ROT();
  }
  #undef CMASK
  #define CMASK(P0,P1,t) do{int jb_=(t)-(NT-4); if(jb_>=0)cmask(P0,P1,jb_,qrel,hi);}while(0)
  #define ENDW(tt) do{ if((tt)+3<NT){WAIT_BAR(2);} else if((tt)+2<NT){WAIT_BAR(1);} else {WAIT_BAR(0);} }while(0)
  for(;t+2<NT;t+=2){
    STEP(pB0,pB1,pA0,pA1,t,(t+3<NT),(t+1<NT),(t+1<NT));       ENDW(t);   RESC(); ROT();
    STEP(pA0,pA1,pB0,pB1,t+1,(t+4<NT),(t+2<NT),(t+2<NT));     ENDW(t+1); RESC(); ROT();
  }
  STEP(pB0,pB1,pA0,pA1,t,false,true,true);       ENDW(t);   RESC(); ROT();
  STEP(pA0,pA1,pB0,pB1,NT-1,false,false,false); RESC();
  { float sacc=pA0[0]+pA0[1]; _Pragma("unroll") for(int r=2;r<16;++r)sacc+=pA0[r]; _Pragma("unroll") for(int r=0;r<16;++r)sacc+=pA1[r]; l_reg+=sacc;
    pw0=(u32x4){PKW(pA0,0),PKW(pA0,2),PKW(pA0,4),PKW(pA0,6)};pw1=(u32x4){PKW(pA0,8),PKW(pA0,10),PKW(pA0,12),PKW(pA0,14)};pw2=(u32x4){PKW(pA1,0),PKW(pA1,2),PKW(pA1,4),PKW(pA1,6)};pw3=(u32x4){PKW(pA1,8),PKW(pA1,10),PKW(pA1,12),PKW(pA1,14)};
    SBAR(); pv(o,vb0+sl_cur,PAF(0),PAF(1),PAF(2),PAF(3)); }
  #undef PKW
  #undef PAF
  #undef VFR
  #undef PIN
  #undef MX3
  #undef GAPA
  #undef GAPB
  #undef EX
  #undef VRD
  #undef KRD
  #undef STEP
  #undef ENDW
  asm volatile("s_waitcnt lgkmcnt(0)\n\ts_barrier":::"memory");
  if(nqb>=0){ const int jn=attn_jstart(shm3,nui,nqb*QB,lane);
    const bf16*Kn=K+(kvbase+(long)jn*KVBLK)*DM+h*D+(long)lane*DM+wid*8; const bf16*Vn=V+(kvbase+(long)jn*KVBLK)*DM+h*D+(long)(16*(wid&3)+(lane>>2))*DM+(wid>>2)*32+(lane&3)*8;
    glds16(Kn,(unsigned)__builtin_amdgcn_readfirstlane(kdst)); glds16(Vn,(unsigned)__builtin_amdgcn_readfirstlane(vdst));
    glds16(Kn+(long)KVBLK*DM,(unsigned)__builtin_amdgcn_readfirstlane(kdst+SLOTB)); glds16(Kn+2L*KVBLK*DM,(unsigned)__builtin_amdgcn_readfirstlane(kdst+2*SLOTB)); }
  {auto rr=__builtin_amdgcn_permlane32_swap(__float_as_uint(l_reg),__float_as_uint(l_reg),false,false);l_reg=__uint_as_float(rr[0])+__uint_as_float(rr[1]);}
  if(hi==0)wsf[32+r32]=l_reg;asm volatile("s_waitcnt lgkmcnt(0)":::"memory");
  float rli[16];
  #pragma unroll
  for(int r=0;r<16;++r)rli[r]=__builtin_amdgcn_rcpf(wsf[32+crow(r,hi)]);
  bf16*Ow=O+(rowbase+q0+wid*QBLK)*DM+h*D;
  { bf16*stg=(bf16*)(shm+LDS_OST)+wid*2048;
    #pragma unroll
    for(int r=0;r<16;++r){const int orow=crow(r,hi);
      #pragma unroll
      for(int d0=0;d0<2;++d0)stg[orow*64+d0*32+r32]=__float2bfloat16(o[d0][r]*rli[r]);}
    asm volatile("s_waitcnt lgkmcnt(0)":::"memory");
    #pragma unroll
    for(int i=0;i<4;++i){const int row=i*8+(lane>>3),ch=lane&7; const u32x4 v=*(const u32x4*)(stg+row*64+ch*8); ATTN_STORE16(Ow+(long)row*DM+ch*8,v);} }
  if(nqb<0)asm volatile("s_waitcnt lgkmcnt(0)\n\ts_barrier":::"memory");
  #undef DMA_K
  #undef DMA_V
  #undef CMASK
  #undef START
  #undef RESC
  #undef ROT
  #undef BINIT
}
constexpr int ATTN_LDS_BYTES=LDS_BYTES;
struct AttnTensors { const bf16* Q; const bf16* K; const bf16* V; bf16* O; const float* KN2; const float* QN2; const float* KNM; };
struct AttnUnit { int bh; int qb; };
struct StaticOrder {
  int vcu;
  __device__ __forceinline__ explicit StaticOrder(int grid,int block):vcu((block%8)*(grid/8)+block/8){}
  __device__ __forceinline__ bool next(int i,AttnUnit&u)const{ if(i>=8)return false; const int s=vcu&3, base=8*(i>>1); u.bh=vcu>>2; u.qb=(i&1)?base+7-s:base+s; return true; }
  __device__ __forceinline__ void a_ready(const AttnUnit&)const{}
  __device__ __forceinline__ void done(const AttnUnit&)const{}
};
template<class Sched,int THRL=8> __device__ __forceinline__ void attn_phase(char*lds,const AttnTensors&T,const float*bias,const Sched&S){
  AttnUnit u;
  if(!S.next(0,u))return;
  typedef __attribute__((address_space(3))) unsigned lds_u32;
  const int tid=::launder((int)threadIdx.x);
  { const f32x4_t*src=(const f32x4_t*)(bias+(long)u.bh*KVR); f32x4_t*dst=(f32x4_t*)(lds+LDS_BIAS);
    for(int i=tid;i<KVR/4;i+=NW*64)dst[i]=src[i];
    if(tid<140)((lds_u32*)((lds_cptr)lds+LDS_KN))[tid]=0u;
    __syncthreads(); }
  { lds_u32*KNu=(lds_u32*)((lds_cptr)lds+LDS_KN),*QMu=(lds_u32*)((lds_cptr)lds+LDS_QM);
    const int bb_=u.bh/NHEAD, hh_=u.bh%NHEAD;
    for(int row=tid;row<KVR;row+=NW*64){ float ss;
      if(row<64){ ss=0.f; if(row<16){ const f32x4_t q4=*(const f32x4_t*)(T.KNM+(row*NHEAD+hh_)*4); ss=(q4[0]+q4[1])+(q4[2]+q4[3]); } }
      else { const f32x2_t h2=*(const f32x2_t*)(T.KN2+((long)hh_*((long)::NB*KVR)+(long)bb_*KVR+row)*2); ss=h2[0]+h2[1]; }
      __hip_atomic_fetch_max(KNu+(row>>6),__float_as_uint(ss),__ATOMIC_RELAXED,__HIP_MEMORY_SCOPE_WORKGROUP); }
    for(int r=tid;r<8*QB;r+=NW*64){ AttnUnit v; if(!S.next(r>>8,v))break;
      const f32x2_t h2=*(const f32x2_t*)(T.QN2+((long)(v.bh%NHEAD)*(long)::M+(long)(v.bh/NHEAD)*SEQ+(long)v.qb*QB+(r&255))*2); const float ss=h2[0]+h2[1];
      __hip_atomic_fetch_max(QMu+(r>>8),__float_as_uint(ss),__ATOMIC_RELAXED,__HIP_MEMORY_SCOPE_WORKGROUP); }
    __syncthreads(); }
  for(int i=0;S.next(i,u);++i){ AttnUnit un; const bool hn=S.next(i+1,un); S.a_ready(u); attn_unit<THRL>(i,u.bh/NHEAD,u.bh%NHEAD,u.qb,T.Q,T.K,T.V,T.O,lds,i>0,i+1,hn?un.qb:-1); S.done(u); }
}
#undef SBAR
#undef WAIT_BAR
}
constexpr int NWAVES = 8;
constexpr int RING_OFF = 0, RING_BYTES = 131072;
constexpr int LDSCTL_OFF = RING_BYTES, MISC_OFF = LDSCTL_OFF + 320;
constexpr int LDS_BYTES = 163840;
constexpr int CW_TMO = 0, CW_CODE = 1;
constexpr int CW_BAR = 4096;
#define GAS __attribute__((address_space(1)))
#define LAS __attribute__((address_space(3)))
typedef unsigned v4u __attribute__((ext_vector_type(4)));
typedef GAS unsigned gu32;
#define RLX_AGENT __ATOMIC_RELAXED, __HIP_MEMORY_SCOPE_AGENT
#define LDS_WAIT() asm volatile("s_waitcnt lgkmcnt(0)" ::: "memory")
#define VM_WAIT() asm volatile("s_waitcnt vmcnt(0)" ::: "memory")
#define XB_TMO      128
#define XB_XCNT(j)  (256  + 64 * (j))
#define XB_XSUB(j)  (1280 + 64 * (j))
#define XB_XGEN(j)  (2304 + 64 * (j))
#define XB_TOP      3328
#define XB_TOPGEN   3392
#define XCD_BAR_WORDS 3456
#define XB_SPIN_CAP (1u << 18)

__device__ __forceinline__ unsigned xb_ld(unsigned* p)              { return __hip_atomic_load(p, __ATOMIC_RELAXED, __HIP_MEMORY_SCOPE_AGENT); }
__device__ __forceinline__ unsigned xb_add(unsigned* p, unsigned v) { return __hip_atomic_fetch_add(p, v, __ATOMIC_RELAXED, __HIP_MEMORY_SCOPE_AGENT); }
__device__ __forceinline__ unsigned xb_xcc_id() { return (unsigned)__builtin_amdgcn_s_getreg((3 << 11) | 20) & 0xFu; }
#define XB_SPIN(cond, bar) do { unsigned _sp = 0; while (cond) { __builtin_amdgcn_s_sleep(1); \
    if ((++_sp & 255u) == 0u) { if (xb_ld(&(bar)[XB_TMO])) break; if (_sp > XB_SPIN_CAP) { atomicAdd(&(bar)[XB_TMO], 1u); break; } } } } while (0)

struct XcdBarrier {
    unsigned* bar; unsigned x;
    volatile LAS unsigned* st;
};

__device__ __forceinline__ XcdBarrier xcd_barrier_post(unsigned* bar, volatile LAS unsigned* st) {
    XcdBarrier b; b.bar = bar; b.x = xb_xcc_id(); b.st = st;
    if (threadIdx.x == 0) (void)xb_add(&bar[XB_XCNT(b.x)], 1u);
    return b;
}
__device__ __forceinline__ void xcd_barrier_complete(unsigned* bar, unsigned x, unsigned& nloc, unsigned& nx) {
    const unsigned G = gridDim.x * gridDim.y * gridDim.z;
    unsigned sum, cnt, mine, sp = 0u;
    for (;;) {
        sum = 0u; cnt = 0u; mine = 0u;
#pragma unroll
        for (unsigned j = 0; j < 16; ++j) { const unsigned c = xb_ld(&bar[XB_XCNT(j)]); sum += c; cnt += (c > 0u) ? 1u : 0u; mine = (j == x) ? c : mine; }
        if (sum == G) break;
        __builtin_amdgcn_s_sleep(1);
        if ((++sp & 255u) == 0u) { if (xb_ld(&bar[XB_TMO])) break; if (sp > XB_SPIN_CAP) { atomicAdd(&bar[XB_TMO], 1u); break; } }
    }
    nloc = mine > 0u ? mine : 1u; nx = cnt > 0u ? cnt : 1u;
}

__device__ __forceinline__ void xcd_barrier(const XcdBarrier& b) {
    asm volatile("s_waitcnt vmcnt(0)" ::: "memory");
    __syncthreads();
    if (threadIdx.x == 0) {
        unsigned* bar = b.bar;
        __builtin_amdgcn_s_waitcnt(0);
        unsigned nloc = b.st[0], nx = b.st[1];
        if (nloc == 0u) { xcd_barrier_complete(bar, b.x, nloc, nx); b.st[0] = nloc; b.st[1] = nx; }
        const unsigned old = xb_add(&bar[XB_XSUB(b.x)], 1u);
        const unsigned gen = old / nloc;
        if (old + 1u == (gen + 1u) * nloc) {
            __builtin_amdgcn_fence(__ATOMIC_RELEASE, "agent");
            asm volatile("s_waitcnt vmcnt(0)" ::: "memory");
            const unsigned og = xb_add(&bar[XB_TOP], 1u);
            const unsigned tg = og / nx;
            if (og + 1u == (tg + 1u) * nx) xb_add(&bar[XB_TOPGEN], 1u);
            else XB_SPIN(xb_ld(&bar[XB_TOPGEN]) == tg, bar);
            __builtin_amdgcn_fence(__ATOMIC_ACQUIRE, "agent");
            xb_add(&bar[XB_XGEN(b.x)], 1u);
            asm volatile("s_waitcnt vmcnt(0)" ::: "memory");
        } else {
            XB_SPIN(xb_ld(&bar[XB_XGEN(b.x)]) == gen, bar);
            __builtin_amdgcn_fence(__ATOMIC_ACQUIRE, "agent");
            asm volatile("s_waitcnt vmcnt(0)" ::: "memory");
        }
    }
    __syncthreads();
}

struct Frame {
    LAS unsigned char* lds;
    volatile LAS unsigned* MISC;
    gu32* ctl;
    int tid, lane, wave, vcu, G;
};
struct Args { const float* in[20]; float* out; unsigned char* ws; int ph_lo, ph_hi; };
struct KA {
    unsigned long long base;
    __device__ __forceinline__ const float* in(int i) const { return (const float*)(const __attribute__((address_space(1))) float*)((const __attribute__((address_space(4))) unsigned long long*)base)[i]; }
    __device__ __forceinline__ float* out() const { return (float*)(__attribute__((address_space(1))) float*)((const __attribute__((address_space(4))) unsigned long long*)base)[20]; }
    __device__ __forceinline__ unsigned char* ws() const { return (unsigned char*)(__attribute__((address_space(1))) unsigned char*)((const __attribute__((address_space(4))) unsigned long long*)base)[21]; }
};
__device__ __forceinline__ KA kargs() {
#if defined(__HIP_DEVICE_COMPILE__)
    unsigned long long p = (unsigned long long)__builtin_amdgcn_kernarg_segment_ptr(); asm volatile("" : "+s"(p));
    return KA{p};
#else
    return KA{0ull};
#endif
}

struct P0Item { const float* W; size_t ldw; bf16_t* WT; };
__device__ __forceinline__ void p0_item_load(const P0Item& it, int lane, f32x4 (&r)[8]) {
#pragma unroll
    for (int i = 0; i < 8; ++i) r[i] = __builtin_nontemporal_load((const f32x4*)(it.W + (size_t)(8 * i + (lane >> 3)) * it.ldw + 4 * (lane & 7)));
}
__device__ __forceinline__ void p0_item_store(const P0Item& it, int K, LAS float* scr, int lane, const f32x4 (&r)[8]) {
#pragma unroll
    for (int i = 0; i < 8; ++i) { LAS float* d = scr + (8 * i + (lane >> 3)) * 33 + 4 * (lane & 7); d[0] = r[i].x; d[1] = r[i].y; d[2] = r[i].z; d[3] = r[i].w; }
    LDS_WAIT(); asm volatile("" ::: "memory");
    const int c = lane & 7;
#pragma unroll
    for (int j = 0; j < 4; ++j) { const int n = (lane >> 3) + 8 * j; const LAS float* s = scr + (8 * c) * 33 + n;
        v4u o; o.x = pk2(s[0 * 33], s[1 * 33]); o.y = pk2(s[2 * 33], s[3 * 33]); o.z = pk2(s[4 * 33], s[5 * 33]); o.w = pk2(s[6 * 33], s[7 * 33]);
        *(GAS v4u*)(it.WT + (size_t)n * K + 8 * c) = o; }
    LDS_WAIT(); asm volatile("" ::: "memory");
}
__device__ __forceinline__ int glu_src_col(int r) { return ((r >> 7) & 1) * 1024 + (r >> 8) * 128 + (r & 127); }

__device__ __forceinline__ void p0_rows_wg(Frame& F, const KA& A, unsigned char* ws) {
    const int lane = F.lane, wave = F.wave, fr = lane & 15, fq = lane >> 4, c0 = wave * 128 + 8 * fq;
    LAS float* xs = (LAS float*)(F.lds + RING_OFF);
    LAS float* pacc = (LAS float*)(F.lds + RING_OFF + 4096);
    f32x4 gv[4][2]; u32x4 wh[4], wl[4];
    { const float* g = A.in(2); const float* wp = A.in(3) + (size_t)c0 * IN_COLS + OFF_F + fr;
#pragma unroll
      for (int s_ = 0; s_ < 4; ++s_) { gv[s_][0] = *(const f32x4*)(g + c0 + 32 * s_); gv[s_][1] = *(const f32x4*)(g + c0 + 32 * s_ + 4);
        float wv[8];
#pragma unroll
        for (int j = 0; j < 8; ++j) wv[j] = wp[(size_t)(32 * s_ + j) * IN_COLS];
        u32x4 h_; h_.x = pk2(wv[0], wv[1]); h_.y = pk2(wv[2], wv[3]); h_.z = pk2(wv[4], wv[5]); h_.w = pk2(wv[6], wv[7]);
        u32x4 l_;
        l_.x = pk2(wv[0] - __builtin_bit_cast(float, h_.x << 16), wv[1] - __builtin_bit_cast(float, h_.x & 0xffff0000u)); l_.y = pk2(wv[2] - __builtin_bit_cast(float, h_.y << 16), wv[3] - __builtin_bit_cast(float, h_.y & 0xffff0000u));
        l_.z = pk2(wv[4] - __builtin_bit_cast(float, h_.z << 16), wv[5] - __builtin_bit_cast(float, h_.z & 0xffff0000u)); l_.w = pk2(wv[6] - __builtin_bit_cast(float, h_.w << 16), wv[7] - __builtin_bit_cast(float, h_.w & 0xffff0000u));
        wh[s_] = h_; wl[s_] = l_; } }
    const float bbh = A.in(4)[OFF_F + 4 * (wave & 3) + (lane & 3)];
    constexpr int NGRP = M / 16 + 1;
    int grp = F.vcu, par = 0; f32x4 h[4][2];
    { const float* src = (grp < M / 16 ? A.in(0) + (size_t)grp * 16 * D : A.in(1)) + (size_t)fr * D + c0;
#pragma unroll
      for (int s_ = 0; s_ < 4; ++s_) { h[s_][0] = *(const f32x4*)(src + 32 * s_); h[s_][1] = *(const f32x4*)(src + 32 * s_ + 4); } }
    for (; grp < NGRP; grp += F.G, par ^= 1) {
        const int nx = grp + F.G; f32x4 hn[4][2];
        if (nx < NGRP) { const float* src = (nx < M / 16 ? A.in(0) + (size_t)nx * 16 * D : A.in(1)) + (size_t)fr * D + c0;
#pragma unroll
            for (int s_ = 0; s_ < 4; ++s_) { hn[s_][0] = *(const f32x4*)(src + 32 * s_); hn[s_][1] = *(const f32x4*)(src + 32 * s_ + 4); } }
        float ss = 0.f, amax = 0.f; f32x4 v[4][2];
#pragma unroll
        for (int s_ = 0; s_ < 4; ++s_)
#pragma unroll
            for (int t = 0; t < 2; ++t) { const f32x4 x_ = h[s_][t]; ss += (x_.x * x_.x + x_.y * x_.y) + (x_.z * x_.z + x_.w * x_.w);
                v[s_][t] = x_ * gv[s_][t]; const f32x4 a_ = __builtin_elementwise_abs(v[s_][t]); amax = fmaxf(amax, fmaxf(fmaxf(a_.x, a_.y), fmaxf(a_.z, a_.w))); }
        ss += __shfl_xor(ss, 16); ss += __shfl_xor(ss, 32);
        amax = fmaxf(amax, __shfl_xor(amax, 16)); amax = fmaxf(amax, __shfl_xor(amax, 32));
        LAS float* xp = xs + par * 256;
        if (fq == 0) { xp[(wave * 16 + fr) * 2] = ss; xp[(wave * 16 + fr) * 2 + 1] = amax; }
        __syncthreads();
        float sst = 0.f, amt = 0.f;
#pragma unroll
        for (int w2 = 0; w2 < NWAVES; ++w2) { sst += xp[(w2 * 16 + fr) * 2]; amt = fmaxf(amt, xp[(w2 * 16 + fr) * 2 + 1]); }
        const float qinv = amt > 0.f ? 127.f / amt : 0.f;
        const bool is_x = grp < M / 16;
        unsigned char* op = (is_x ? ws + WS_XN + (size_t)grp * 16 * D : ws + WS_XNM) + (size_t)fr * D + c0;
        pg8::f32x4 acc = {0.f, 0.f, 0.f, 0.f};
#pragma unroll
        for (int s_ = 0; s_ < 4; ++s_) { const f32x4 v0 = v[s_][0], v1 = v[s_][1];
            u32x4 hi; hi.x = pk2(v0.x, v0.y); hi.y = pk2(v0.z, v0.w); hi.z = pk2(v1.x, v1.y); hi.w = pk2(v1.z, v1.w);
            { const f32x4 q0 = v0 * qinv, q1 = v1 * qinv; u32x2 q8; q8.x = pk4_i8(q0.x, q0.y, q0.z, q0.w); q8.y = pk4_i8(q1.x, q1.y, q1.z, q1.w); *(u32x2*)(op + 32 * s_) = q8; }
            u32x4 lo;
            lo.x = pk2(v0.x - __builtin_bit_cast(float, hi.x << 16), v0.y - __builtin_bit_cast(float, hi.x & 0xffff0000u)); lo.y = pk2(v0.z - __builtin_bit_cast(float, hi.y << 16), v0.w - __builtin_bit_cast(float, hi.y & 0xffff0000u));
            lo.z = pk2(v1.x - __builtin_bit_cast(float, hi.z << 16), v1.y - __builtin_bit_cast(float, hi.z & 0xffff0000u)); lo.w = pk2(v1.z - __builtin_bit_cast(float, hi.w << 16), v1.w - __builtin_bit_cast(float, hi.w & 0xffff0000u));
            const bf16x8 ah = __builtin_bit_cast(bf16x8, hi), al = __builtin_bit_cast(bf16x8, lo), bh = __builtin_bit_cast(bf16x8, wh[s_]), bl = __builtin_bit_cast(bf16x8, wl[s_]);
            acc = __builtin_amdgcn_mfma_f32_16x16x32_bf16(ah, bh, acc, 0, 0, 0); acc = __builtin_amdgcn_mfma_f32_16x16x32_bf16(al, bh, acc, 0, 0, 0); acc = __builtin_amdgcn_mfma_f32_16x16x32_bf16(ah, bl, acc, 0, 0, 0); }
#pragma unroll
        for (int r = 0; r < 4; ++r) pacc[(wave * 4 + r) * 64 + lane] = acc[r];
        __syncthreads();
        if (wave < 4) {
            const int row = lane >> 2, hd = 4 * wave + (lane & 3); float z = 0.f, ssr = 0.f;
#pragma unroll
            for (int w2 = 0; w2 < NWAVES; ++w2) { z += pacc[(w2 * 4 + (row & 3)) * 64 + (row >> 2) * 16 + hd]; ssr += xp[(w2 * 16 + row) * 2]; }
            z = z * rsqrtf(ssr * (1.f / D) + RMS_EPS) + bbh;
            float lf = fminf(z, 0.f) - log1pf(expf(-fabsf(z)));
            (is_x ? (float*)(ws + WS_LOGF) + (size_t)grp * 256 : (float*)(ws + WS_LOGFM))[row * 16 + hd] = lf;
            lf += __shfl_xor(lf, 4); lf += __shfl_xor(lf, 8); lf += __shfl_xor(lf, 16); lf += __shfl_xor(lf, 32);
            if (is_x && lane < 4) ((float*)(ws + WS_GSUM))[grp * 16 + hd] = lf;
        } else if (wave == 4 && fq == 0) {
            ((float*)(ws + WS_RSX) + (is_x ? grp * 16 : M))[fr] = rsqrtf(sst * (1.f / D) + RMS_EPS) * amt * (1.f / 127.f);
        }
#pragma unroll
        for (int s_ = 0; s_ < 4; ++s_) { h[s_][0] = hn[s_][0]; h[s_][1] = hn[s_][1]; }
    }
    __syncthreads();
}

constexpr int I_SQ = 16 * 32, N_ITEMS = 3 * I_SQ, N_STRIPS = NE * 64, N_STRIPS_IN = 224, N_STRIPS_DN = NE * 32;
__device__ __forceinline__ P0Item p0_item(const KA& A, unsigned char* ws, int it) {
    int r = it;
    if (r < 3 * I_SQ) { const int w = r / I_SQ, rr = r % I_SQ, kb = rr / 32, nb = rr % 32; const float* src = w == 0 ? A.in(9) : w == 1 ? A.in(10) : A.in(11); bf16_t* dst = (bf16_t*)(ws + (w == 0 ? WS_WCO_T : w == 1 ? WS_WAO_T : WS_WMIX_T));
        return P0Item{src + (size_t)(64 * kb) * D + 32 * nb, (size_t)D, dst + (size_t)(32 * nb) * D + 64 * kb}; }
    return P0Item{nullptr, 0, nullptr};
}
struct P0Strip { const float* W0; size_t ldw; unsigned char* Wq; float* SB; };
__device__ __forceinline__ void p0_strip_load(const P0Strip& st, int wave, int lane, f32x4 (&r0)[8], f32x4 (&r1)[8]) {
    const P0Item i0{st.W0 + (size_t)(64 * (2 * wave)) * st.ldw, st.ldw, nullptr}, i1{st.W0 + (size_t)(64 * (2 * wave + 1)) * st.ldw, st.ldw, nullptr}; p0_item_load(i0, lane, r0); p0_item_load(i1, lane, r1);
}
__device__ __forceinline__ void p0_strip_finish(const P0Strip& st, LAS unsigned char* ring, int wave, int lane, int parity, const f32x4 (&r0)[8], const f32x4 (&r1)[8]) {
    LAS float* scr = (LAS float*)(ring + wave * 16384);
    f32x4 mx = {0.f, 0.f, 0.f, 0.f};
#pragma unroll
    for (int i = 0; i < 8; ++i) mx = __builtin_elementwise_max(mx, __builtin_elementwise_max(__builtin_elementwise_abs(r0[i]), __builtin_elementwise_abs(r1[i])));
#pragma unroll
    for (int o = 8; o < 64; o <<= 1) { f32x4 t; t.x = __shfl_xor(mx.x, o); t.y = __shfl_xor(mx.y, o); t.z = __shfl_xor(mx.z, o); t.w = __shfl_xor(mx.w, o); mx = __builtin_elementwise_max(mx, t); }
    const int c = lane & 7, xoff = 8448 + 64 + parity * 128;
    if (lane < 8) *(LAS f32x4*)(ring + wave * 16384 + xoff + 16 * lane) = mx;
    __syncthreads();
#pragma unroll
    for (int w2 = 0; w2 < NWAVES; ++w2) mx = __builtin_elementwise_max(mx, *(const LAS f32x4*)(ring + w2 * 16384 + xoff + 16 * c));
    f32x4 inv; inv.x = mx.x > 0.f ? 127.f / mx.x : 0.f; inv.y = mx.y > 0.f ? 127.f / mx.y : 0.f; inv.z = mx.z > 0.f ? 127.f / mx.z : 0.f; inv.w = mx.w > 0.f ? 127.f / mx.w : 0.f;
    if (wave == 0 && lane < 8) *(f32x4*)(st.SB + 4 * lane) = mx * (1.f / 127.f);
#pragma unroll
    for (int half = 0; half < 2; ++half) { const int kb = 2 * wave + half;
#pragma unroll
        for (int i = 0; i < 8; ++i) { const f32x4 q = (half ? r1[i] : r0[i]) * inv; LAS float* d = scr + (8 * i + (lane >> 3)) * 33 + 4 * c; d[0] = q.x; d[1] = q.y; d[2] = q.z; d[3] = q.w; }
        LDS_WAIT(); asm volatile("" ::: "memory");
#pragma unroll
        for (int j = 0; j < 4; ++j) { const int n = (lane >> 3) + 8 * j; const LAS float* sp = scr + (8 * c) * 33 + n;
            u32x2 o; o.x = pk4_i8(sp[0 * 33], sp[1 * 33], sp[2 * 33], sp[3 * 33]); o.y = pk4_i8(sp[4 * 33], sp[5 * 33], sp[6 * 33], sp[7 * 33]);
            *(GAS u32x2*)(st.Wq + (size_t)n * 1024 + 64 * kb + 8 * c) = o; }
        LDS_WAIT(); asm volatile("" ::: "memory");
    }
}
__device__ __forceinline__ bool p0_strip_desc(const KA& A, unsigned char* ws, int vcu, int G, int s, P0Strip& st) {
    const int n_in = (vcu < N_STRIPS_IN) ? (N_STRIPS_IN - vcu + G - 1) / G : 0, n_gu = (vcu < N_STRIPS) ? (N_STRIPS - vcu + G - 1) / G : 0;
    if (s < n_in) { const int drow = 32 * (vcu + s * G), scol = drow < 2048 ? glu_src_col(drow) : (drow < 5120 ? drow : drow + 16);
        st = P0Strip{A.in(3) + scol, (size_t)IN_COLS, ws + WS_WIN_T + (size_t)drow * 1024, (float*)(ws + WS_SBIN) + drow}; return true; }
    s -= n_in;
    if (s < n_gu) { const int gi = (N_STRIPS % (8 * G) == 0) ? ((s >> 3) * G + vcu) * 8 + (s & 7) : vcu + s * G, e = gi >> 6, drow = 32 * (gi & 63);
        st = P0Strip{A.in(15) + (size_t)e * D * 2048 + glu_src_col(drow), (size_t)2048, ws + WS_WGU_T + ((size_t)e * 2048 + drow) * 1024, (float*)(ws + WS_SBGU) + e * 2048 + drow}; return true; }
    s -= n_gu;
    const int gi = (N_STRIPS_DN % (4 * G) == 0) ? ((s >> 2) * G + vcu) * 4 + (s & 3) : vcu + s * G; if (gi >= N_STRIPS_DN) return false;
    const int e = gi >> 5, drow = 32 * (gi & 31);
    st = P0Strip{A.in(17) + (size_t)e * D * D + drow, (size_t)D, ws + WS_WDN_T + ((size_t)e * 1024 + drow) * 1024, (float*)(ws + WS_SBDN) + e * 1024 + drow}; return true;
}
__device__ __forceinline__ void p0_prologue(Frame& F, const KA& A) {
    unsigned char* ws = A.ws();
    LAS float* scr = (LAS float*)(F.lds + RING_OFF + F.wave * 16384);
    const int gw = F.vcu * NWAVES + F.wave, NGW = F.G * NWAVES;
    {
        int it = gw; f32x4 r[8]; P0Item cur{nullptr, 0, nullptr};
        if (it < N_ITEMS) { cur = p0_item(A, ws, it); p0_item_load(cur, F.lane, r); }
        while (it < N_ITEMS) {
            const int nx = it + NGW; f32x4 rn[8]; P0Item nxt{nullptr, 0, nullptr};
            if (nx < N_ITEMS) { nxt = p0_item(A, ws, nx); p0_item_load(nxt, F.lane, rn); }
            p0_item_store(cur, D, scr, F.lane, r);
#pragma unroll
            for (int i = 0; i < 8; ++i) r[i] = rn[i];
            cur = nxt; it = nx;
        }
    }
    {
        P0Strip cur{nullptr, 0, nullptr, nullptr}, nxt{nullptr, 0, nullptr, nullptr}; f32x4 r0[8], r1[8];
        bool have = p0_strip_desc(A, ws, F.vcu, F.G, 0, cur);
        if (have) p0_strip_load(cur, F.wave, F.lane, r0, r1);
        for (int si = 0; have; ++si) {
#pragma unroll
            for (int i = 0; i < 8; ++i) asm volatile("" : "+v"(r0[i]), "+v"(r1[i]));
            f32x4 n0[8], n1[8];
            const bool hn = p0_strip_desc(A, ws, F.vcu, F.G, si + 1, nxt);
            if (hn) p0_strip_load(nxt, F.wave, F.lane, n0, n1);
            p0_strip_finish(cur, F.lds + RING_OFF, F.wave, F.lane, si & 1, r0, r1);
#pragma unroll
            for (int i = 0; i < 8; ++i) { r0[i] = n0[i]; r1[i] = n1[i]; }
            cur = nxt; have = hn;
        }
        __syncthreads();
    }
    p0_rows_wg(F, A, ws);
    for (int i = gw * 64 + F.lane; i < NE * D; i += NGW * 64) {
        const int e = i / D, k = i % D; const float w = A.in(13)[(size_t)k * NE + e]; const unsigned hi = f2bf(w);
        ((bf16_t*)(ws + WS_WR_T))[i] = (bf16_t)hi; ((bf16_t*)(ws + WS_WR_T))[NE * D + i] = (bf16_t)f2bf(w - __builtin_bit_cast(float, hi << 16));
    }
    for (int r = gw; r < 2 * NB * 48; r += NGW) {
        const int kv = r / (NB * 48), rr = r % (NB * 48), b = rr / 48, row = 16 + rr % 48;
        bf16_t* p = (bf16_t*)(ws + (kv ? WS_V : WS_K)) + ((size_t)b * KVROWS + row) * D + 16 * F.lane;
        const v4u z = {0u, 0u, 0u, 0u}; *(GAS v4u*)p = z; *(GAS v4u*)(p + 8) = z;
    }
}

__device__ __forceinline__ void p1_scan(Frame& F, const KA& A) {
    if (F.vcu >= NB * 64) return;
    const int b = F.vcu >> 6, seg = F.vcu & 63, t = F.tid, head = t & 15, pc = t >> 4;
    const float* LOGF = (const float*)(A.ws() + WS_LOGF); const float* LOGFm = (const float*)(A.ws() + WS_LOGFM); const float* GSUM = (const float*)(A.ws() + WS_GSUM);
    float* outb = (float*)(A.ws() + WS_BIAS) + (size_t)(b * NH + head) * KVROWS;
    LAS float* part = (LAS float*)(F.lds + RING_OFF);
    const float* src = LOGF + ((size_t)b * SEQ + seg * 128 + 4 * pc) * 16 + head;
    const float v0 = src[0], v1 = src[16], v2 = src[32], v3 = src[48];
    float pre = 0.f;
    { float gq[16];
#pragma unroll
      for (int i = 0; i < 16; ++i) { const int j = pc + 32 * i; gq[i] = j < seg * 8 ? GSUM[(size_t)(b * (SEQ / 16) + j) * 16 + head] : 0.f; }
#pragma unroll
      for (int i = 0; i < 16; ++i) pre += gq[i]; }
    float cm = 0.f;
    { float mq[NMETA];
#pragma unroll
      for (int j = 0; j < NMETA; ++j) mq[j] = LOGFm[j * 16 + head];
#pragma unroll
      for (int j = 0; j < NMETA; ++j) { cm += mq[j]; if (seg == 0 && pc == 0) outb[j] = -cm * LOG2E; } }
    if (seg == 0) for (int idx = t; idx < NH * 48; idx += NWAVES * 64) ((float*)(A.ws() + WS_BIAS) + (size_t)(b * NH + idx / 48) * KVROWS)[16 + idx % 48] = NEG_BIG;
    pre += __shfl_xor(pre, 16); pre += __shfl_xor(pre, 32);
    const float c0 = v0, c1 = c0 + v1, c2 = c1 + v2, c3 = c2 + v3;
    part[pc * 16 + head] = c3; if (F.lane < 16) part[512 + F.wave * 16 + head] = pre;
    __syncthreads();
    float base = cm;
#pragma unroll
    for (int w = 0; w < NWAVES; ++w) base += part[512 + w * 16 + head];
    for (int c = 0; c < pc; ++c) base += part[c * 16 + head];
    { f32x4 o; o.x = -(base + c0) * LOG2E; o.y = -(base + c1) * LOG2E; o.z = -(base + c2) * LOG2E; o.w = -(base + c3) * LOG2E; *(f32x4*)(outb + 64 + seg * 128 + 4 * pc) = o; }
    __syncthreads();
}
__device__ __forceinline__ void p1_meta(Frame& F, const KA& A) {
    if (F.vcu >= 192) return;
    const int lane = F.lane, fr = lane & 15, fq = lane >> 4;
    const unsigned char* XNm = A.ws() + WS_XNM; const unsigned char* Wq = A.ws() + WS_WIN_T; const float* b_in = A.in(4); const float* SB = (const float*)(A.ws() + WS_SBIN);
    const int kind = F.vcu >> 6, c = F.vcu & 63;
    const int ch0 = 16 * c;
    const int rowA = kind == 0 ? 256 * (ch0 >> 7) + (ch0 & 127) : (kind == 1 ? OFF_K : OFF_V) + ch0;
    const unsigned char* ap = XNm + (size_t)fr * D + 16 * fq; const unsigned char* bp = Wq + (size_t)(rowA + fr) * D + 16 * fq;
    pg8::i32x4 acc0 = {0, 0, 0, 0}, acc1 = {0, 0, 0, 0};
#pragma unroll
    for (int k0 = 0; k0 < D; k0 += 64) {
        const pg8::i32x4 af = *(const pg8::i32x4*)(ap + k0), bf = *(const pg8::i32x4*)(bp + k0);
        acc0 = __builtin_amdgcn_mfma_i32_16x16x64_i8(af, bf, acc0, 0, 0, 0);
        if (kind == 0) { const pg8::i32x4 bg = *(const pg8::i32x4*)(bp + (size_t)128 * D + k0); acc1 = __builtin_amdgcn_mfma_i32_16x16x64_i8(af, bg, acc1, 0, 0, 0); }
    }
    const int ch = ch0 + fr;
    const float* rsx = (const float*)(A.ws() + WS_RSX) + M + 4 * fq;
    const float s0 = SB[rowA + fr], s1 = kind == 0 ? SB[rowA + 128 + fr] : 0.f;
    float v0[4], v1[4];
#pragma unroll
    for (int r = 0; r < 4; ++r) { v0[r] = (float)acc0[r] * (rsx[r] * s0); v1[r] = (float)acc1[r] * (rsx[r] * s1); }
    if (kind == 0) {
        bf16_t* GLUm = (bf16_t*)(A.ws() + WS_GLUM); const float ba = b_in[ch], bb = b_in[1024 + ch];
#pragma unroll
        for (int r = 0; r < 4; ++r) { const float z1 = v0[r] + ba, z2 = v1[r] + bb; GLUm[(size_t)(4 * fq + r) * D + ch] = (bf16_t)f2bf(z1 * (1.f / (1.f + __expf(-z2)))); }
    } else {
        bf16_t* dst = (bf16_t*)(A.ws() + (kind == 1 ? WS_K : WS_V)); const float bb = b_in[(kind == 1 ? OFF_K : OFF_V) + ch];
#pragma unroll
        for (int r = 0; r < 4; ++r) { const bf16_t o = (bf16_t)f2bf(v0[r] + bb);
            if (kind == 1) { float ss = bf2f(o) * bf2f(o);
                ss += __shfl_xor(ss, 1); ss += __shfl_xor(ss, 2); ss += __shfl_xor(ss, 4); ss += __shfl_xor(ss, 8);
                if (fr == 0) ((float*)(A.ws() + WS_KNM))[((4 * fq + r) * NH + (c >> 2)) * 4 + (c & 3)] = ss; }
#pragma unroll
            for (int b2 = 0; b2 < NB; ++b2) dst[((size_t)b2 * KVROWS + 4 * fq + r) * D + ch] = o; }
    }
}

typedef float f32x2_ __attribute__((ext_vector_type(2)));
__device__ __forceinline__ f32x2_ bfpair(unsigned u) { f32x2_ r; r.x = __builtin_bit_cast(float, u << 16); r.y = __builtin_bit_cast(float, u & 0xffff0000u); return r; }
__device__ __forceinline__ float wave_sum16(float (&v)[16], int lane) {
    const bool b5 = lane & 32, b4 = lane & 16, b3 = lane & 8, b2 = lane & 4;
    float a[8];
#pragma unroll
    for (int i = 0; i < 8; ++i) { const float keep = b5 ? v[i + 8] : v[i], give = b5 ? v[i] : v[i + 8]; a[i] = keep + __shfl_xor(give, 32); }
    float c[4];
#pragma unroll
    for (int i = 0; i < 4; ++i) { const float keep = b4 ? a[i + 4] : a[i], give = b4 ? a[i] : a[i + 4]; c[i] = keep + __shfl_xor(give, 16); }
    float d[2];
#pragma unroll
    for (int i = 0; i < 2; ++i) { const float keep = b3 ? c[i + 2] : c[i], give = b3 ? c[i] : c[i + 2]; d[i] = keep + __shfl_xor(give, 8); }
    float e = (b2 ? d[1] : d[0]) + __shfl_xor(b2 ? d[0] : d[1], 4);
    e += __shfl_xor(e, 1); e += __shfl_xor(e, 2);
    return e;
}
__device__ __forceinline__ void p2_conv(Frame& F, const KA& A) {
    const int tid = launder((int)threadIdx.x), c0 = 2 * tid, lane = tid & 63, wave = __builtin_amdgcn_readfirstlane(tid >> 6);
    const bf16_t* GLU = (const bf16_t*)(A.ws() + WS_GLU); const bf16_t* GLUm = (const bf16_t*)(A.ws() + WS_GLUM); bf16_t* U = (bf16_t*)(A.ws() + WS_U);
    LAS float* red = (LAS float*)(F.lds + RING_OFF);
    f32x2_ cw[CONVW];
#pragma unroll
    for (int j = 0; j < CONVW; ++j) cw[j] = *(const f32x2_*)(A.in(5) + (size_t)j * D + c0);
    const f32x2_ cb = *(const f32x2_*)(A.in(6) + c0), lg = *(const f32x2_*)(A.in(7) + c0), lb = *(const f32x2_*)(A.in(8) + c0);
    for (int chunk = F.vcu; chunk < M / 128; chunk += F.G) {
        const int m0 = chunk * 128, b = m0 / SEQ, i0 = m0 % SEQ;
        const bf16_t* src = GLU + (size_t)m0 * D + c0; bf16_t* dst = U + (size_t)m0 * D + c0;
        unsigned raw[8];
#pragma unroll
        for (int q = 0; q < 8; ++q) raw[q] = *(const unsigned*)(src + (size_t)q * D);
        f32x2_ win[32];
#pragma unroll
        for (int s = 0; s < 32; ++s) {
            const int pp = NMETA + i0 - 32 + s;
            unsigned rw = 0u;
            if (pp >= NMETA) rw = *(const unsigned*)(GLU + ((size_t)b * SEQ + (pp - NMETA)) * D + c0);
            else if (pp >= 0) rw = *(const unsigned*)(GLUm + (size_t)pp * D + c0);
            win[s] = bfpair(rw);
        }
#pragma unroll 1
        for (int blk = 0; blk < 4; ++blk) {
#pragma unroll
            for (int s8 = 0; s8 < 4; ++s8) {
                unsigned cur[8];
#pragma unroll
                for (int q = 0; q < 8; ++q) cur[q] = raw[q];
                { const int nrow = 32 * blk + 8 * s8 + 8;
                  const bf16_t* ns = src + (size_t)(nrow < 128 ? nrow : 120) * D;
#pragma unroll
                  for (int q = 0; q < 8; ++q) raw[q] = __builtin_nontemporal_load((const unsigned*)(ns + (size_t)q * D)); }
                f32x2_ o[8]; float st[16];
#pragma unroll
                for (int q = 0; q < 8; ++q) { const int s = 8 * s8 + q; win[s] = bfpair(cur[q]);
                    f32x2_ acc = cb;
#pragma unroll
                    for (int j = 0; j < CONVW; ++j) acc = win[(s + 2 + j) & 31] * cw[j] + acc;
                    o[q] = acc; st[2 * q] = acc.x + acc.y; st[2 * q + 1] = acc.x * acc.x + acc.y * acc.y; }
                const float tot = wave_sum16(st, lane);
                LAS float* rp = red + (s8 & 1) * 128;
                if ((lane & 3) == 0) rp[wave * 16 + (lane >> 2)] = tot;
                __syncthreads();
                float tsum = 0.f;
#pragma unroll
                for (int w = 0; w < NWAVES; ++w) tsum += rp[w * 16 + ((lane >> 2) & 15)];
                bf16_t* dg = dst + (size_t)(32 * blk + 8 * s8) * D;
#pragma unroll
                for (int q = 0; q < 8; ++q) {
                    const float s1_ = __builtin_bit_cast(float, __builtin_amdgcn_readlane(__builtin_bit_cast(int, tsum), 8 * q)), s2_ = __builtin_bit_cast(float, __builtin_amdgcn_readlane(__builtin_bit_cast(int, tsum), 8 * q + 4));
                    const float mean = s1_ * (1.f / D), var = s2_ * (1.f / D) - mean * mean, rstd = rsqrtf(fmaxf(var, 0.f) + LN_EPS);
                    f32x2_ y = ((o[q] - mean) * rstd) * lg + lb;
                    y.x = y.x * __builtin_amdgcn_rcpf(1.f + __expf(-y.x)); y.y = y.y * __builtin_amdgcn_rcpf(1.f + __expf(-y.y));
                    *(unsigned*)(dg + (size_t)q * D) = pk2(y.x, y.y);
                }
            }
        }
    }
    __syncthreads();
}
__device__ __forceinline__ void p5_router(Frame& F, const KA& A) {
    const int tid = launder((int)threadIdx.x), lane = tid & 63, wave = __builtin_amdgcn_readfirstlane(tid >> 6), fr = lane & 15, fq = lane >> 4;
    const bf16_t* H = (const bf16_t*)(A.ws() + WS_H); unsigned char* HN = A.ws() + WS_GLU;
    float* TOPG = (float*)(A.ws() + WS_TOPG); float* RSTD = (float*)(A.ws() + WS_RSTD); int* lists = (int*)(A.ws() + WS_LISTS); int* cnt = (int*)(A.ws() + WS_CTL) + CW_CNT;
    const bf16_t* Wh = (const bf16_t*)(A.ws() + WS_WR_T); const bf16_t* Wl = Wh + NE * D;
    const float* g = A.in(12); const float* rb = A.in(14);
    LAS int* lcnt = (LAS int*)(F.lds + RING_OFF);
    LAS int* lbase = lcnt + 32; LAS int* ent = lcnt + 64; LAS int* lslot = ent + 512;
    LAS float* erst = (LAS float*)(lslot + 512); LAS float* egt = erst + 512;
    LAS float* lg = egt + 512 + wave * (16 * 33 + 32); LAS float* lr = lg + 16 * 33; LAS float* lq = lr + 16;
    float* LRS = (float*)(A.ws() + WS_LRS); float* LGT = (float*)(A.ws() + WS_LGT);
    const int c0 = wave * 128 + 8 * fq;
    LAS float* xs = (LAS float*)(F.lds + RING_OFF + 32768);
    LAS float* pacc = (LAS float*)(F.lds + RING_OFF + 36864);
    LAS float* lgall = egt + 512;
    f32x4 gv[4][2]; bf16x8 wh0[4], wh1[4], wl0[4], wl1[4];
#pragma unroll
    for (int s_ = 0; s_ < 4; ++s_) { gv[s_][0] = *(const f32x4*)(g + c0 + 32 * s_); gv[s_][1] = *(const f32x4*)(g + c0 + 32 * s_ + 4);
        const bf16_t* whp = Wh + (size_t)fr * D + c0 + 32 * s_; const bf16_t* wlp = Wl + (size_t)fr * D + c0 + 32 * s_;
        wh0[s_] = *(const bf16x8*)whp; wh1[s_] = *(const bf16x8*)(whp + (size_t)16 * D); wl0[s_] = *(const bf16x8*)wlp; wl1[s_] = *(const bf16x8*)(wlp + (size_t)16 * D); }
    for (int chunk = F.vcu; chunk < M / 128; chunk += F.G) {
        if (tid < 32) lcnt[tid] = 0;
        const bf16_t* hp = H + (size_t)(chunk * 128 + fr) * D + c0; unsigned char* hnp = HN + (size_t)(chunk * 128 + fr) * D + c0;
        u32x4 h0r[4], h1r[4];
#pragma unroll
        for (int s_ = 0; s_ < 4; ++s_) { h0r[s_] = *(const u32x4*)(hp + 32 * s_); h1r[s_] = *(const u32x4*)(hp + (size_t)16 * D + 32 * s_); }
        for (int gi = 0; gi < 8; ++gi) {
            u32x4 h2r[4];
            if (gi < 6) {
#pragma unroll
                for (int s_ = 0; s_ < 4; ++s_) h2r[s_] = *(const u32x4*)(hp + (size_t)(gi + 2) * 16 * D + 32 * s_); }
            float ss = 0.f, amax = 0.f; f32x4 v[4][2];
#pragma unroll
            for (int s_ = 0; s_ < 4; ++s_) { f32x4 x0, x1; pg8::unpack8(h0r[s_], x0, x1);
                ss += (x0.x * x0.x + x0.y * x0.y) + (x0.z * x0.z + x0.w * x0.w) + (x1.x * x1.x + x1.y * x1.y) + (x1.z * x1.z + x1.w * x1.w);
                v[s_][0] = x0 * gv[s_][0]; v[s_][1] = x1 * gv[s_][1];
                const f32x4 a0 = __builtin_elementwise_abs(v[s_][0]), a1 = __builtin_elementwise_abs(v[s_][1]);
                amax = fmaxf(amax, fmaxf(fmaxf(fmaxf(a0.x, a0.y), fmaxf(a0.z, a0.w)), fmaxf(fmaxf(a1.x, a1.y), fmaxf(a1.z, a1.w)))); }
            ss += __shfl_xor(ss, 16); ss += __shfl_xor(ss, 32);
            amax = fmaxf(amax, __shfl_xor(amax, 16)); amax = fmaxf(amax, __shfl_xor(amax, 32));
            LAS float* xp = xs + (gi & 1) * 256;
            if (fq == 0) { xp[(wave * 16 + fr) * 2] = ss; xp[(wave * 16 + fr) * 2 + 1] = amax; }
            __syncthreads();
            float sst = 0.f, amt = 0.f;
#pragma unroll
            for (int w2 = 0; w2 < NWAVES; ++w2) { sst += xp[(w2 * 16 + fr) * 2]; amt = fmaxf(amt, xp[(w2 * 16 + fr) * 2 + 1]); }
            const float qinv = amt > 0.f ? 127.f / amt : 0.f;
            pg8::f32x4 acc0 = {0.f, 0.f, 0.f, 0.f}, acc1 = {0.f, 0.f, 0.f, 0.f};
#pragma unroll
            for (int s_ = 0; s_ < 4; ++s_) { const f32x4 v0 = v[s_][0], v1 = v[s_][1];
                u32x4 hi; hi.x = pk2(v0.x, v0.y); hi.y = pk2(v0.z, v0.w); hi.z = pk2(v1.x, v1.y); hi.w = pk2(v1.z, v1.w);
                { const f32x4 q0 = v0 * qinv, q1 = v1 * qinv; u32x2 q8; q8.x = pk4_i8(q0.x, q0.y, q0.z, q0.w); q8.y = pk4_i8(q1.x, q1.y, q1.z, q1.w); *(u32x2*)(hnp + (size_t)gi * 16 * D + 32 * s_) = q8; }
                u32x4 lo;
                lo.x = pk2(v0.x - __builtin_bit_cast(float, hi.x << 16), v0.y - __builtin_bit_cast(float, hi.x & 0xffff0000u)); lo.y = pk2(v0.z - __builtin_bit_cast(float, hi.y << 16), v0.w - __builtin_bit_cast(float, hi.y & 0xffff0000u));
                lo.z = pk2(v1.x - __builtin_bit_cast(float, hi.z << 16), v1.y - __builtin_bit_cast(float, hi.z & 0xffff0000u)); lo.w = pk2(v1.z - __builtin_bit_cast(float, hi.w << 16), v1.w - __builtin_bit_cast(float, hi.w & 0xffff0000u));
                const bf16x8 ah = __builtin_bit_cast(bf16x8, hi), al = __builtin_bit_cast(bf16x8, lo);
                acc0 = __builtin_amdgcn_mfma_f32_16x16x32_bf16(ah, wh0[s_], acc0, 0, 0, 0); acc1 = __builtin_amdgcn_mfma_f32_16x16x32_bf16(ah, wh1[s_], acc1, 0, 0, 0);
                acc0 = __builtin_amdgcn_mfma_f32_16x16x32_bf16(al, wh0[s_], acc0, 0, 0, 0); acc1 = __builtin_amdgcn_mfma_f32_16x16x32_bf16(al, wh1[s_], acc1, 0, 0, 0);
                acc0 = __builtin_amdgcn_mfma_f32_16x16x32_bf16(ah, wl0[s_], acc0, 0, 0, 0); acc1 = __builtin_amdgcn_mfma_f32_16x16x32_bf16(ah, wl1[s_], acc1, 0, 0, 0); }
#pragma unroll
            for (int r = 0; r < 4; ++r) { pacc[(wave * 8 + r) * 64 + lane] = acc0[r]; pacc[(wave * 8 + 4 + r) * 64 + lane] = acc1[r]; }
            __syncthreads();
            {
                float z = 0.f;
#pragma unroll
                for (int w2 = 0; w2 < NWAVES; ++w2) z += pacc[(w2 * 8 + wave) * 64 + lane];
                LAS float* lgg = lgall + gi * (16 * 33 + 32);
                lgg[(4 * fq + (wave & 3)) * 33 + 16 * (wave >> 2) + fr] = z;
                if (wave == 0 && fq == 0) { const float rstd_ = rsqrtf(sst * (1.f / D) + RMS_EPS); lgg[16 * 33 + fr] = rstd_; lgg[16 * 33 + 16 + fr] = rstd_ * amt * (1.f / 127.f); }
            }
#pragma unroll
            for (int s_ = 0; s_ < 4; ++s_) { h0r[s_] = h1r[s_]; h1r[s_] = h2r[s_]; }
        }
        __syncthreads();
        const int m0 = chunk * 128 + wave * 16;
        if (lane < 16) {
            const int m = m0 + lane; const float rstd = lr[lane], rsa = lq[lane];
            float lv[32];
#pragma unroll
            for (int e = 0; e < 32; ++e) lv[e] = lg[lane * 33 + e] * rstd + rb[e];
            int bi[4]; float bv[4];
#pragma unroll
            for (int k = 0; k < 4; ++k) {
                float best = -INFINITY; int idx = 0;
#pragma unroll
                for (int e = 0; e < 32; ++e) if (lv[e] > best) { best = lv[e]; idx = e; }
#pragma unroll
                for (int e = 0; e < 32; ++e) if (e == idx) lv[e] = -INFINITY;
                bi[k] = idx; bv[k] = best;
            }
            const float e1 = __expf(bv[1] - bv[0]), e2 = __expf(bv[2] - bv[0]), e3 = __expf(bv[3] - bv[0]), inv = 1.f / (1.f + e1 + e2 + e3);
            RSTD[m] = rstd;
            *(f32x4*)(TOPG + (size_t)m * 4) = (f32x4){inv, e1 * inv, e2 * inv, e3 * inv};
#pragma unroll
            for (int k = 0; k < 4; ++k) { const int li = (wave * 16 + lane) * 4 + k;
                lslot[li] = __hip_atomic_fetch_add(lcnt + bi[k], 1, __ATOMIC_RELAXED, __HIP_MEMORY_SCOPE_WORKGROUP);
                ent[li] = ((m * 4 + k) << 5) | bi[k]; erst[li] = rsa; egt[li] = (k == 0 ? 1.f : k == 1 ? e1 : k == 2 ? e2 : e3) * inv; }
        }
        __syncthreads();
        if (tid < 32) lbase[tid] = __hip_atomic_fetch_add(cnt + tid, lcnt[tid], __ATOMIC_RELAXED, __HIP_MEMORY_SCOPE_AGENT);
        __syncthreads();
        { const int en = ent[tid], e = en & 31; const size_t sl = (size_t)e * M + lbase[e] + lslot[tid]; lists[sl] = en >> 5; LRS[sl] = erst[tid]; LGT[sl] = egt[tid]; }
        __syncthreads();
    }
}
constexpr int MOE_TAB_OFF = LDSCTL_OFF + 1024, MOE_PARK_OFF = LDSCTL_OFF + 2048, MOE_XM_OFF = LDSCTL_OFF + 10240  , MOE_SPARK_OFF = LDSCTL_OFF + 16384  ;
__device__ __forceinline__ void moe_table(Frame& F, const KA& A) {
    LAS int* tab = (LAS int*)(F.lds + MOE_TAB_OFF);
    if (tid_of(F.wave) == 0) {
        const int* cnt = (const int*)(A.ws() + WS_CTL) + CW_CNT; int tp = 0, bp = 0;
        for (int e = 0; e < NE; ++e) { const int c = cnt[e]; tab[e] = tp; tab[33 + e] = c; tab[65 + e] = bp; tp += (c + 255) >> 8; bp += c; }
        tab[32] = tp;
    }
    __syncthreads();
}
__device__ __forceinline__ void p8_final(Frame& F, const KA& A) {
    const int wave = F.wave, tid = tid_of(wave), lane = tid & 63;
    const bf16_t* H = (const bf16_t*)(A.ws() + WS_H); const bf16_t* Y = (const bf16_t*)(A.ws() + WS_Y); const float* g = A.in(19); float* out = A.out();
    for (int m = F.vcu * NWAVES + wave; m < M; m += F.G * NWAVES) {
        f32x4 v[4]; float ss = 0.f;
#pragma unroll
        for (int j = 0; j < 4; ++j) {
            { const u32x2 hh = __builtin_nontemporal_load((const u32x2*)(H + (size_t)m * D + 4 * lane + 256 * j)); v[j] = (f32x4){__builtin_bit_cast(float, hh.x << 16), __builtin_bit_cast(float, hh.x & 0xffff0000u), __builtin_bit_cast(float, hh.y << 16), __builtin_bit_cast(float, hh.y & 0xffff0000u)}; }
#pragma unroll
            for (int k = 0; k < 4; ++k) { const u32x2 y = __builtin_nontemporal_load((const u32x2*)(Y + ((size_t)m * 4 + k) * D + 4 * lane + 256 * j));
                v[j].x += __builtin_bit_cast(float, y.x << 16); v[j].y += __builtin_bit_cast(float, y.x & 0xffff0000u); v[j].z += __builtin_bit_cast(float, y.y << 16); v[j].w += __builtin_bit_cast(float, y.y & 0xffff0000u); }
            ss += (v[j].x * v[j].x + v[j].y * v[j].y) + (v[j].z * v[j].z + v[j].w * v[j].w);
        }
        ss = wave_sum(ss);
        const float rstd = rsqrtf(ss * (1.f / D) + RMS_EPS);
#pragma unroll
        for (int j = 0; j < 4; ++j) { const f32x4 gv = *(const f32x4*)(g + 4 * lane + 256 * j); __builtin_nontemporal_store((v[j] * rstd) * gv, (f32x4*)(out + (size_t)m * D + 4 * lane + 256 * j)); }
    }
}
constexpr int N_MEGA_PHASES = 9;
__global__ void __launch_bounds__(NWAVES * 64, 2) mega_fwd(Args args) {
    extern __shared__ __attribute__((aligned(16))) unsigned char lds[];
    Frame F;
    F.lds = (LAS unsigned char*)lds;
    F.MISC = (volatile LAS unsigned*)(F.lds + MISC_OFF);
    F.tid = threadIdx.x; F.lane = F.tid & 63; F.wave = __builtin_amdgcn_readfirstlane(F.tid >> 6);
    F.G = gridDim.x; { const int bx = blockIdx.x; F.vcu = (F.G % 8 == 0) ? (bx % 8) * (F.G / 8) + bx / 8 : bx; }
    { const KA A0 = kargs(); F.ctl = (gu32*)(A0.ws() + WS_CTL); }
    for (int u = F.tid; u < (LDS_BYTES - LDSCTL_OFF) / 4; u += NWAVES * 64) ((LAS unsigned*)(F.lds + LDSCTL_OFF))[u] = 0u;
    __syncthreads();
    XcdBarrier bar = xcd_barrier_post((unsigned*)(F.ctl + CW_BAR), F.MISC + 8);
    const int lo = args.ph_lo, hi = args.ph_hi;
#define IN(k) (lo <= (k) && (k) < hi)
#define BOTH(k) (IN(k) && IN((k) + 1))

    if (IN(0)) { const KA A = kargs(); p0_prologue(F, A); if (BOTH(0)) xcd_barrier(bar); }

    if (IN(1)) { const KA A = kargs(); unsigned char* const ws = A.ws();
        p1_scan(F, A);
        if (F.wave == 0) p1_meta(F, A);
        pg8::Gemm g{(const bf16_t*)(ws + WS_XN), (const bf16_t*)(ws + WS_WIN_T), M, 7168, D / 2}; pg8::StaticOrder S; S.init(M, 7168, F.G, (int)blockIdx.x);
        pg8::EpiInProj E{A.in(4), (const float*)(ws + WS_RSX), (const float*)(ws + WS_SBIN), (bf16_t*)(ws + WS_GLU), (bf16_t*)(ws + WS_Q), WS_QSTRIDE / 2, C2, SEQ, (float*)(ws + WS_QN2), (float*)(ws + WS_KN2)};
        pg8::gemm_phase<pg8::EpiInProj, pg8::StaticOrder, true, true, true>(F.lds + RING_OFF, g, S, E);
        if (BOTH(1)) xcd_barrier(bar);
    }

    if (IN(2)) { const KA A = kargs(); unsigned char* const ws = A.ws();
        static_assert(attn_body::ATTN_LDS_BYTES <= RING_BYTES, "attention LDS");
        const attn_body::AttnTensors AT{(const attn_body::bf16*)(ws + WS_Q), (const attn_body::bf16*)(ws + WS_K), (const attn_body::bf16*)(ws + WS_V), (attn_body::bf16*)(ws + WS_Q), (const float*)(ws + WS_KN2), (const float*)(ws + WS_QN2), (const float*)(ws + WS_KNM)};
        const attn_body::StaticOrder S((int)F.G, (int)blockIdx.x);
        attn_body::attn_phase<attn_body::StaticOrder>((char*)lds + RING_OFF, AT, (const float*)(ws + WS_BIAS), S);
        p2_conv(F, A);
        if (BOTH(2)) xcd_barrier(bar);
    }

    if (IN(3)) { const KA A = kargs(); unsigned char* const ws = A.ws();
        pg8::PairOrder S; S.init(M, D, F.G, (int)blockIdx.x);
        pg8::Gemm g{(const bf16_t*)(ws + WS_U), (const bf16_t*)(ws + WS_WCO_T), M, D, D, (const bf16_t*)(ws + WS_Q), (const bf16_t*)(ws + WS_WAO_T)};
        pg8::EpiMerge E{(const bf16_t*)(ws + WS_SGA), (const bf16_t*)(ws + WS_SGB), (bf16_t*)(ws + WS_XN)};
        pg8::gemm_phase<pg8::EpiMerge, pg8::PairOrder, true, true, false, true>(F.lds + RING_OFF, g, S, E);
        if (BOTH(3)) xcd_barrier(bar);
    }

    if (IN(4)) { const KA A = kargs(); unsigned char* const ws = A.ws();
        pg8::Gemm g{(const bf16_t*)(ws + WS_XN), (const bf16_t*)(ws + WS_WMIX_T), M, D, D}; pg8::StaticOrder S; S.init(M, D, F.G, (int)blockIdx.x);
        pg8::EpiResid E{A.in(0), (bf16_t*)(ws + WS_H)};
        pg8::gemm_phase<pg8::EpiResid, pg8::StaticOrder, true, true>(F.lds + RING_OFF, g, S, E);
        if (BOTH(4)) xcd_barrier(bar);
    }

    if (IN(5)) { const KA A = kargs(); p5_router(F, A); if (BOTH(5)) xcd_barrier(bar); }

    if (IN(6)) { const KA A = kargs(); unsigned char* const ws = A.ws();
        moe_table(F, A);
        pg8::MoeOrder S; S.init((const LAS int*)(F.lds + MOE_TAB_OFF), 8, F.G, (int)blockIdx.x);
        pg8::RowsGather RW{(const int*)(ws + WS_LISTS)};
        pg8::EpiMoeGU E{A.in(16), (const float*)(ws + WS_LRS), (const float*)(ws + WS_SBGU), ws + WS_ACT, (float*)(ws + WS_SACT), (LAS float*)(F.lds + MOE_XM_OFF)};
        pg8::gemm_phase_g<pg8::EpiMoeGU, pg8::MoeOrder, pg8::RowsGather, 512, true>(F.wave, F.lds + RING_OFF, F.lds + MOE_PARK_OFF, nullptr, nullptr, (const bf16_t*)(ws + WS_GLU), (const bf16_t*)(ws + WS_WGU_T), (size_t)2048 * 1024, S, RW, E);
        if (BOTH(6)) xcd_barrier(bar);
    }

    if (IN(7)) { const KA A = kargs(); unsigned char* const ws = A.ws();
        moe_table(F, A);
        pg8::MoeOrder S; S.init((const LAS int*)(F.lds + MOE_TAB_OFF), 4, F.G, (F.G % 8 == 0) ? (int)(blockIdx.x % 8) * (int)(F.G / 8) + (int)(blockIdx.x / 8) : (int)blockIdx.x);
        pg8::RowsDense RW{};
        pg8::EpiMoeDown E{A.in(18), (const float*)(ws + WS_SBDN), (const int*)(ws + WS_LISTS), (const float*)(ws + WS_LGT), (bf16_t*)(ws + WS_Y)};
        static_assert(MOE_SPARK_OFF - 2048 >= MOE_XM_OFF, "the down GEMM's row offsets sit in the gate-up exchange area (idle in this phase)");
        pg8::gemm_phase_g<pg8::EpiMoeDown, pg8::MoeOrder, pg8::RowsDense, 512, true, true, true>(F.wave, F.lds + RING_OFF, F.lds + MOE_PARK_OFF, F.lds + MOE_SPARK_OFF, (const float*)(ws + WS_SACT), (const bf16_t*)(ws + WS_ACT), (const bf16_t*)(ws + WS_WDN_T), (size_t)D * 1024, S, RW, E);
        if (BOTH(7)) xcd_barrier(bar);
    }

    if (IN(8)) { const KA A = kargs(); p8_final(F, A); }
#undef IN
#undef BOTH
}
extern "C" void kernel_launch(void* const* d_in, const int* in_sizes, int n_in, void* d_out, int out_size, void* d_ws, size_t ws_size, hipStream_t stream) {
    static int grid = 0;
    if (grid == 0) {
        if (n_in != 20 || in_sizes[0] != M * D || out_size != M * D || ws_size < WS_END) { fprintf(stderr, "kernel_launch: unexpected shapes (n_in %d in0 %d out %d ws %zu)\n", n_in, n_in > 0 ? in_sizes[0] : -1, out_size, ws_size); grid = -1; return; }
        int dev = 0, cus = 0, per_cu = 0;
        if (hipGetDevice(&dev) != hipSuccess || hipDeviceGetAttribute(&cus, hipDeviceAttributeMultiprocessorCount, dev) != hipSuccess) { grid = -1; return; }
        if (hipFuncSetAttribute((const void*)mega_fwd, hipFuncAttributeMaxDynamicSharedMemorySize, LDS_BYTES) != hipSuccess) { fprintf(stderr, "kernel_launch: hipFuncSetAttribute failed\n"); grid = -1; return; }
        if (hipOccupancyMaxActiveBlocksPerMultiprocessor(&per_cu, (const void*)mega_fwd, NWAVES * 64, LDS_BYTES) != hipSuccess || per_cu < 1) { fprintf(stderr, "kernel_launch: occupancy query says %d blocks per CU\n", per_cu); (void)hipGetLastError(); grid = -1; return; }
        grid = cus;
    }
    if (grid < 0) return;
    unsigned char* ws = (unsigned char*)d_ws; float* out = (float*)d_out;

    (void)hipMemsetAsync(ws + WS_CTL, 0, CTL_ZERO_BYTES, stream);
    Args a{};
    for (int i = 0; i < 20; ++i) a.in[i] = (const float*)d_in[i];
    a.out = out; a.ws = ws; a.ph_lo = 0; a.ph_hi = N_MEGA_PHASES;
    hipLaunchKernelGGL(mega_fwd, dim3(grid), dim3(NWAVES * 64), LDS_BYTES, stream, a);
    { const hipError_t le = hipPeekAtLastError(); if (le != hipSuccess) fprintf(stderr, "kernel_launch: launch failed: %s\n", hipGetErrorName(le)); }
}
```

```cpp
#include <hip/hip_runtime.h>
#include <cstdio>
#include <cstdint>

typedef unsigned short bf16_t;
typedef short bf16x8 __attribute__((ext_vector_type(8)));
typedef float f32x4 __attribute__((ext_vector_type(4)));
typedef float f32x16 __attribute__((ext_vector_type(16)));
typedef unsigned u32x4 __attribute__((ext_vector_type(4)));
typedef unsigned u32x2 __attribute__((ext_vector_type(2)));

constexpr int D = 1024, NB = 4, SEQ = 8192, NMETA = 16, M = NB * SEQ;
constexpr int NH = 16, HD = 64, NE = 32, TOPK = 4, NA = M * TOPK;
constexpr int IN_COLS = 7184, OFF_Q = 2048, OFF_K = 3072, OFF_V = 4096, OFF_F = 5120, OFF_GA = 5136, OFF_GB = 6160;
constexpr int CONVW = 31;
constexpr int KVROWS = SEQ + 64;
constexpr float LOG2E = 1.4426950408889634f;
constexpr float C2 = 0.125f * LOG2E;
constexpr float RMS_EPS = 1e-5f, LN_EPS = 1e-5f;
constexpr float NEG_BIG = -1e30f;

constexpr size_t MiB = 1u << 20;
constexpr size_t WS_CTL = 0, CTL_ZERO_BYTES = 32 * 1024;
constexpr size_t WS_LISTS = 4 * MiB;
constexpr size_t WS_TOPI = 8 * MiB;
constexpr size_t WS_TOPG = 8 * MiB + 512 * 1024;
constexpr size_t WS_LOGF = 10 * MiB;
constexpr size_t WS_LOGFM = 12 * MiB;
constexpr size_t WS_BIAS = 13 * MiB;
constexpr size_t WS_RSX = 9 * MiB + 512 * 1024;
constexpr size_t WS_RSTD = 9 * MiB;
constexpr size_t WS_WR_T = 17 * MiB;
constexpr size_t WS_LRS = 20 * MiB, WS_LGT = 24 * MiB;
constexpr size_t WS_SBIN = 18 * MiB + 512 * 1024;
constexpr size_t WS_SBDN = 19 * MiB;
constexpr size_t WS_SACT = 28 * MiB;
constexpr size_t WS_GSUM = 15 * MiB + 512 * 1024;
constexpr size_t WS_KN2 = 52 * MiB;
constexpr size_t WS_QN2 = 57 * MiB;
constexpr size_t WS_KNM = 61 * MiB + 512 * 1024;
constexpr size_t WS_SBGU = 18 * MiB;
constexpr size_t WS_XNM = 16 * MiB;
constexpr size_t WS_GLUM = 16 * MiB + 64 * 1024;
constexpr size_t WS_WIN_T = 32 * MiB, WS_WCO_T = 46 * MiB, WS_WAO_T = 48 * MiB, WS_WMIX_T = 50 * MiB;
constexpr size_t WS_WGU_T = 64 * MiB;
constexpr size_t WS_TMPA = 192 * MiB;
constexpr size_t WS_Y = 192 * MiB;
constexpr size_t WS_XN = 256 * MiB;
constexpr size_t WS_GLU = 320 * MiB;
constexpr size_t WS_Q = 384 * MiB;
constexpr size_t WS_QSTRIDE = 66 * MiB;
constexpr size_t WS_K = WS_Q + WS_QSTRIDE, WS_V = WS_Q + 2 * WS_QSTRIDE;
constexpr size_t WS_SGA = WS_Q + 3 * WS_QSTRIDE, WS_SGB = WS_Q + 4 * WS_QSTRIDE, WS_U = 714 * MiB;
constexpr size_t WS_ACT = 450 * MiB;
constexpr size_t WS_H = 778 * MiB;
constexpr size_t WS_WDN_T = 906 * MiB;
constexpr size_t WS_END = 970 * MiB;
static_assert(WS_SGB + 64 * MiB <= WS_U && WS_ACT + 256 * MiB <= WS_U && WS_ACT >= WS_K && WS_U + 64 * MiB <= WS_H && WS_H + 128 * MiB <= WS_WDN_T, "d_ws map");
constexpr int CW_CNT = 64;

__device__ __forceinline__ unsigned f2bf(float f) { unsigned u = __builtin_bit_cast(unsigned, f); return (u + 0x7fffu + ((u >> 16) & 1u)) >> 16; }
__device__ __forceinline__ float bf2f(unsigned short b) { return __builtin_bit_cast(float, (unsigned)b << 16); }
__device__ __forceinline__ unsigned pk2(float lo, float hi) { return f2bf(lo) | (f2bf(hi) << 16); }
__device__ __forceinline__ unsigned pk4_i8(float a, float b, float c, float d) {
    const int ia = (int)__builtin_rintf(a), ib = (int)__builtin_rintf(b), ic = (int)__builtin_rintf(c), id = (int)__builtin_rintf(d);
    return ((unsigned)ia & 0xffu) | (((unsigned)ib & 0xffu) << 8) | (((unsigned)ic & 0xffu) << 16) | ((unsigned)id << 24);
}
__device__ __forceinline__ float lane_max_16_32(float v) {
    float a = v, b = v; asm volatile("s_nop 1\n\tv_permlane16_swap_b32 %0, %1" : "+v"(a), "+v"(b)); v = fmaxf(a, b);
    a = v; b = v; asm volatile("s_nop 1\n\tv_permlane32_swap_b32 %0, %1" : "+v"(a), "+v"(b)); return fmaxf(a, b);
}
__device__ __forceinline__ float wave_sum(float v) {
#pragma unroll
    for (int o = 1; o < 64; o <<= 1) v += __shfl_xor(v, o);
    return v;
}
__device__ __forceinline__ float sigmoidf_(float z) { return 1.f / (1.f + __expf(-z)); }

__device__ __forceinline__ int launder(int v) { asm volatile("" : "+v"(v)); return v; }
__device__ __forceinline__ int tid_of(int wave) { return launder(wave * 64 + (int)__builtin_amdgcn_mbcnt_hi(~0u, __builtin_amdgcn_mbcnt_lo(~0u, 0u))); }
namespace pg8 {
#define PG8_LAS __attribute__((address_space(3)))
typedef unsigned short bf16_t;
typedef short bf16x8 __attribute__((ext_vector_type(8)));
typedef float f32x4 __attribute__((ext_vector_type(4)));
typedef unsigned u32x4 __attribute__((ext_vector_type(4)));
constexpr int BM = 256, BK = 64, HALF = 128, HTB = HALF * BK * 2  , STAGE_BYTES = 8 * HTB, NXCD = 8, WGM = 8;

__host__ __device__ __forceinline__ int lds_byte(int r, int c) { const int st = (r >> 4) * 2 + (c >> 5), rr = r & 15, cc = c & 31, ob = rr * 64 + cc * 2; return st * 1024 + (ob ^ (((ob >> 9) & 1) << 5)); }
__host__ __device__ __forceinline__ void stage_rc(int b, int& R, int& C) { const int st = b / 1024, sb = b % 1024, swz = sb ^ (((sb >> 9) & 1) << 5); R = (st >> 1) * 16 + swz / 64; C = (st & 1) * 32 + (swz % 64) / 2; }
__host__ __device__ __forceinline__ int perm32(int rho) { const int n = rho >> 4, i = rho & 15; return 8 * (i >> 2) + 4 * n + (i & 3); }

struct Unit { int pm, pn, part; };
struct Gemm { const bf16_t* A; const bf16_t* Bt; int M, N, K; const bf16_t* A2 = nullptr; const bf16_t* Bt2 = nullptr; };

struct StaticOrder {
    int nM, nN, nwg, G, c;
    __host__ __device__ void init(int M, int N, int G_, int c_) { nM = M / BM; nN = N / BM; nwg = nM * nN; G = G_; c = c_; }
    __host__ __device__ bool next(int i, Unit& u) const {
        const long L = (long)i * G + c; if (L >= nwg) return false;
        int wgid = (int)L; { const int q = nwg / NXCD, r = nwg % NXCD, xcd = wgid % NXCD, off = wgid / NXCD; wgid = (xcd < r ? xcd * (q + 1) : r * (q + 1) + (xcd - r) * q) + off; }
        const int nig = WGM * nN, gid = wgid / nig, fm = gid * WGM, gsz = (nM - fm) < WGM ? (nM - fm) : WGM;
        u.pm = fm + ((wgid % nig) % gsz); u.pn = (wgid % nig) / gsz; u.part = 0; return true;
    }
    __device__ __forceinline__ void a_ready(const Unit&) const {}
    __device__ __forceinline__ void done(const Unit&) const {}
};

struct PairOrder {
    StaticOrder base;
    __host__ __device__ void init(int M, int N, int G_, int c_) { base.init(M, N, G_, c_); }
    __host__ __device__ bool next(int i, Unit& u) const { if (!base.next(i >> 1, u)) return false; u.part = i & 1; return true; }
    __device__ __forceinline__ void a_ready(const Unit&) const {}
    __device__ __forceinline__ void done(const Unit&) const {}
};
__device__ __forceinline__ unsigned cvt_pk_bf16(float lo, float hi) { unsigned r; asm volatile("v_cvt_pk_bf16_f32 %0, %1, %2" : "=v"(r) : "v"(lo), "v"(hi)); return r; }
typedef float f32x2 __attribute__((ext_vector_type(2)));
typedef int i32x4 __attribute__((ext_vector_type(4)));
template <bool I8> struct AccSel { typedef f32x4 T; };
template <> struct AccSel<true> { typedef i32x4 T; };
__device__ __forceinline__ f32x4 mma16(bf16x8 b, bf16x8 a, f32x4 c) { return __builtin_amdgcn_mfma_f32_16x16x32_bf16(b, a, c, 0, 0, 0); }
__device__ __forceinline__ i32x4 mma16(bf16x8 b, bf16x8 a, i32x4 c) { return __builtin_amdgcn_mfma_i32_16x16x64_i8(__builtin_bit_cast(i32x4, b), __builtin_bit_cast(i32x4, a), c, 0, 0, 0); }
__device__ __forceinline__ float sigm(float z) { return __builtin_amdgcn_rcpf(1.0f + __expf(-z)); }
__device__ __forceinline__ f32x4 sigm4(f32x4 z) { return (f32x4){sigm(z[0]), sigm(z[1]), sigm(z[2]), sigm(z[3])}; }
__device__ __forceinline__ f32x2 sigm_pk(f32x2 z) { f32x2 e = z * (-1.4426950408889634f); e.x = __builtin_amdgcn_exp2f(e.x); e.y = __builtin_amdgcn_exp2f(e.y); e = e + 1.0f; f32x2 r; r.x = __builtin_amdgcn_rcpf(e.x); r.y = __builtin_amdgcn_rcpf(e.y); return r; }
__device__ __forceinline__ f32x2 lo2(f32x4 v) { return (f32x2){v[0], v[1]}; }
__device__ __forceinline__ f32x2 hi2(f32x4 v) { return (f32x2){v[2], v[3]}; }
__device__ __forceinline__ f32x2 cvt_lo2(i32x4 v) { return (f32x2){(float)v[0], (float)v[1]}; }
__device__ __forceinline__ f32x2 cvt_hi2(i32x4 v) { return (f32x2){(float)v[2], (float)v[3]}; }
__device__ __forceinline__ f32x2 swiglu_pk(f32x2 z1, f32x2 z2) {
    f32x2 gg, up; gg.x = fminf(z1.x, 7.f); gg.y = fminf(z1.y, 7.f); up.x = fminf(fmaxf(z2.x, -7.f), 7.f); up.y = fminf(fmaxf(z2.y, -7.f), 7.f);
    f32x2 e = gg * (-1.702f * 1.4426950408889634f); e.x = __builtin_amdgcn_exp2f(e.x); e.y = __builtin_amdgcn_exp2f(e.y); e = e + 1.0f;
    f32x2 r; r.x = __builtin_amdgcn_rcpf(e.x); r.y = __builtin_amdgcn_rcpf(e.y);
    const f32x2 t = gg * r; return t * up + t; }
__device__ __forceinline__ u32x4 pack8_pk(f32x2 a, f32x2 b, f32x2 c, f32x2 d) { u32x4 w; w.x = cvt_pk_bf16(a.x, a.y); w.y = cvt_pk_bf16(b.x, b.y); w.z = cvt_pk_bf16(c.x, c.y); w.w = cvt_pk_bf16(d.x, d.y); return w; }
__device__ __forceinline__ u32x4 pack8(f32x4 v0, f32x4 v1) { u32x4 w; w.x = cvt_pk_bf16(v0[0], v0[1]); w.y = cvt_pk_bf16(v0[2], v0[3]); w.z = cvt_pk_bf16(v1[0], v1[1]); w.w = cvt_pk_bf16(v1[2], v1[3]); return w; }
__device__ __forceinline__ void unpack8(u32x4 w, f32x4& lo, f32x4& hi) {
    lo = (f32x4){__builtin_bit_cast(float, w.x << 16), __builtin_bit_cast(float, w.x & 0xffff0000u), __builtin_bit_cast(float, w.y << 16), __builtin_bit_cast(float, w.y & 0xffff0000u)};
    hi = (f32x4){__builtin_bit_cast(float, w.z << 16), __builtin_bit_cast(float, w.z & 0xffff0000u), __builtin_bit_cast(float, w.w << 16), __builtin_bit_cast(float, w.w & 0xffff0000u)};
}
struct EpiInProj {
    static constexpr bool PERM = true, AFTER_DRAIN = false;
    const float* b_in; const float* RSX; const float* SB; bf16_t *GLU, *Q; size_t qstride; float qscale; int seq; float* QN2; float* KN2;
    __device__ __forceinline__ void operator()(const i32x4 (&acc)[2][2][4][2], const Unit& u, int wr, int wc, int fr, int fq) const {
        const int row0 = u.pm * BM + wr * 64 + fr;
        const float* sp = SB + u.pn * 256 + wc * 32 + 8 * fq;
        float rs[2][4];
#pragma unroll
        for (int ai = 0; ai < 2; ++ai)
#pragma unroll
            for (int m = 0; m < 4; ++m) rs[ai][m] = RSX[row0 + ai * HALF + m * 16];
        f32x4 sc[2][2];
#pragma unroll
        for (int bj = 0; bj < 2; ++bj)
#pragma unroll
            for (int n = 0; n < 2; ++n) sc[bj][n] = *(const f32x4*)(sp + bj * HALF + 4 * n);
        f32x4 af[2][2][4][2];
#pragma unroll
        for (int ai = 0; ai < 2; ++ai)
#pragma unroll
            for (int bj = 0; bj < 2; ++bj)
#pragma unroll
                for (int m = 0; m < 4; ++m)
#pragma unroll
                    for (int n = 0; n < 2; ++n) { af[ai][bj][m][n] = __builtin_convertvector(acc[ai][bj][m][n], f32x4); asm volatile("" : "+v"(af[ai][bj][m][n])); }
        if (u.pn < 8) {
            const int ch0 = u.pn * 128 + wc * 32 + 8 * fq;
            f32x4 ba[2], bb[2];
#pragma unroll
            for (int n = 0; n < 2; ++n) { ba[n] = *(const f32x4*)(b_in + ch0 + 4 * n); bb[n] = *(const f32x4*)(b_in + 1024 + ch0 + 4 * n); }
#pragma unroll
            for (int ai = 0; ai < 2; ++ai)
#pragma unroll
                for (int m = 0; m < 4; ++m) { const float r_ = rs[ai][m];
                    f32x2 o[4];
#pragma unroll
                    for (int n = 0; n < 2; ++n) { const f32x4 fa = sc[0][n] * r_, fb = sc[1][n] * r_;
                        o[2 * n] = (lo2(af[ai][0][m][n]) * lo2(fa) + lo2(ba[n])) * sigm_pk(lo2(af[ai][1][m][n]) * lo2(fb) + lo2(bb[n]));
                        o[2 * n + 1] = (hi2(af[ai][0][m][n]) * hi2(fa) + hi2(ba[n])) * sigm_pk(hi2(af[ai][1][m][n]) * hi2(fb) + hi2(bb[n])); }
                    __builtin_nontemporal_store(pack8_pk(o[0], o[1], o[2], o[3]), (u32x4*)(GLU + (size_t)(row0 + ai * HALF + m * 16) * 1024 + ch0));
                }
        } else if (u.pn >= 20) {
            const int ch0 = (u.pn - 20) * 128 + wc * 32 + 8 * fq;
            bf16_t* const RA = Q + (size_t)3 * qstride; bf16_t* const SB_ = Q + (size_t)4 * qstride;
            f32x4 ba[2], bb[2];
#pragma unroll
            for (int n = 0; n < 2; ++n) { ba[n] = *(const f32x4*)(b_in + OFF_GA + ch0 + 4 * n); bb[n] = *(const f32x4*)(b_in + OFF_GB + ch0 + 4 * n); }
#pragma unroll
            for (int ai = 0; ai < 2; ++ai)
#pragma unroll
                for (int m = 0; m < 4; ++m) { const float r_ = rs[ai][m];
                    f32x2 ra[4], sb2[4];
#pragma unroll
                    for (int n = 0; n < 2; ++n) { const f32x4 fa = sc[0][n] * r_, fb = sc[1][n] * r_;
#pragma unroll
                        for (int hh = 0; hh < 2; ++hh) {
                            const f32x2 za = (hh ? hi2(af[ai][0][m][n]) * hi2(fa) + hi2(ba[n]) : lo2(af[ai][0][m][n]) * lo2(fa) + lo2(ba[n])), zb = (hh ? hi2(af[ai][1][m][n]) * hi2(fb) + hi2(bb[n]) : lo2(af[ai][1][m][n]) * lo2(fb) + lo2(bb[n]));
                            f32x2 ea = za * (-1.4426950408889634f), eb = zb * (-1.4426950408889634f);
                            ea.x = __builtin_amdgcn_exp2f(ea.x); ea.y = __builtin_amdgcn_exp2f(ea.y); eb.x = __builtin_amdgcn_exp2f(eb.x); eb.y = __builtin_amdgcn_exp2f(eb.y);
                            ea = ea + 1.0f; eb = eb + 1.0f;
                            f32x2 sa, sb1; sa.x = __builtin_amdgcn_rcpf(ea.x); sa.y = __builtin_amdgcn_rcpf(ea.y); sb1.x = __builtin_amdgcn_rcpf(eb.x); sb1.y = __builtin_amdgcn_rcpf(eb.y);
                            eb.x = fminf(eb.x, 1e30f); eb.y = fminf(eb.y, 1e30f);
                            ra[2 * n + hh] = sa * eb; sb2[2 * n + hh] = sb1; } }
                    const size_t off = (size_t)(row0 + ai * HALF + m * 16) * 1024 + ch0;
                    __builtin_nontemporal_store(pack8_pk(ra[0], ra[1], ra[2], ra[3]), (u32x4*)(RA + off));
                    __builtin_nontemporal_store(pack8_pk(sb2[0], sb2[1], sb2[2], sb2[3]), (u32x4*)(SB_ + off)); }
        } else {
            int kind_ = (u.pn - 8) >> 2; asm volatile("" : "+s"(kind_));
            const int kind = kind_, ct = wc * 32 + 8 * fq, cw = (u.pn & 3) * 256 + ct, bcol = u.pn * 256 + ct;
            bf16_t* base = Q + (size_t)kind * qstride;
            const int radd = (kind == 1 || kind == 2) ? 64 * ((u.pm * BM) / seq + 1) : 0;
            f32x4 bv[2][2];
#pragma unroll
            for (int bj = 0; bj < 2; ++bj)
#pragma unroll
                for (int n = 0; n < 2; ++n) bv[bj][n] = *(const f32x4*)(b_in + bcol + bj * HALF + 4 * n);
#pragma unroll
            for (int ai = 0; ai < 2; ++ai) {
                float ssv[4][2];
#pragma unroll
                for (int m = 0; m < 4; ++m) { bf16_t* rowp = base + (size_t)(row0 + ai * HALF + m * 16 + radd) * 1024 + cw; const float r_ = rs[ai][m];
#pragma unroll
                    for (int bj = 0; bj < 2; ++bj) { const f32x4 f0 = sc[bj][0] * r_, f1 = sc[bj][1] * r_;
                        f32x2 o0 = lo2(af[ai][bj][m][0]) * lo2(f0) + lo2(bv[bj][0]), o1 = hi2(af[ai][bj][m][0]) * hi2(f0) + hi2(bv[bj][0]), o2 = lo2(af[ai][bj][m][1]) * lo2(f1) + lo2(bv[bj][1]), o3 = hi2(af[ai][bj][m][1]) * hi2(f1) + hi2(bv[bj][1]);
                        if (kind == 0) { o0 = o0 * qscale; o1 = o1 * qscale; o2 = o2 * qscale; o3 = o3 * qscale; }
                        const u32x4 w_ = pack8_pk(o0, o1, o2, o3);
                        __builtin_nontemporal_store(w_, (u32x4*)(rowp + bj * HALF));
                        if (kind <= 1) {
                            f32x4 lo, hi; unpack8(w_, lo, hi); lo = lo * lo + hi * hi; ssv[m][bj] = (lo[0] + lo[1]) + (lo[2] + lo[3]); } } }
                if (kind <= 1) {
#pragma unroll
                    for (int m = 0; m < 4; ++m)
#pragma unroll
                        for (int bj = 0; bj < 2; ++bj) ssv[m][bj] += __shfl_xor(ssv[m][bj], 16);
#pragma unroll
                    for (int m = 0; m < 4; ++m)
#pragma unroll
                        for (int bj = 0; bj < 2; ++bj) ssv[m][bj] += __shfl_xor(ssv[m][bj], 32);
                    if (fq == 0) {
#pragma unroll
                        for (int m = 0; m < 4; ++m)
#pragma unroll
                            for (int bj = 0; bj < 2; ++bj) (kind == 0 ? QN2 : KN2)[((size_t)((u.pn & 3) * 4 + bj * 2 + (wc >> 1)) * (kind == 0 ? (size_t)M : (size_t)NB * KVROWS) + (size_t)(row0 + ai * HALF + m * 16 + radd)) * 2 + (wc & 1)] = ssv[m][bj];
                    }
                }
            }
        }
    }
};
template <bool HAS_ADD> struct EpiGated {
    static constexpr bool PERM = true, AFTER_DRAIN = false;
    const bf16_t* SG; const bf16_t* ADD; bf16_t* OUT;
    __device__ __forceinline__ void operator()(const f32x4 (&acc)[2][2][4][2], const Unit& u, int wr, int wc, int fr, int fq) const {
        const int row0 = u.pm * BM + wr * 64 + fr, col0 = u.pn * BM + wc * 32 + 8 * fq;
#pragma unroll
        for (int ai = 0; ai < 2; ++ai)
#pragma unroll
            for (int m = 0; m < 4; ++m) { const size_t off = (size_t)(row0 + ai * HALF + m * 16) * 1024 + col0;
#pragma unroll
                for (int bj = 0; bj < 2; ++bj) { f32x4 g0, g1; unpack8(*(const u32x4*)(SG + off + bj * HALF), g0, g1);
                    f32x4 v0 = acc[ai][bj][m][0] * g0, v1 = acc[ai][bj][m][1] * g1;
                    if (HAS_ADD) { f32x4 t0, t1; unpack8(*(const u32x4*)(ADD + off + bj * HALF), t0, t1); v0 = v0 + t0; v1 = v1 + t1; }
                    *(u32x4*)(OUT + off + bj * HALF) = pack8(v0, v1); } }
    }
};
__device__ __forceinline__ constexpr size_t epi_step_off(int s) { return (size_t)(((s >> 3) * HALF + ((s >> 1) & 3) * 16) * 1024 + (s & 1) * HALF); }
struct EpiMerge {
    static constexpr bool PERM = true, AFTER_DRAIN = false; static constexpr int NREL = 16;
    const bf16_t* SGA; const bf16_t* SGB; bf16_t* OUT;
    __device__ __forceinline__ void mid(f32x4 (&acc)[2][2][4][2], const Unit& u, int wr, int wc, int fr, int fq) const {
        const int row0 = u.pm * BM + wr * 64 + fr, col0 = u.pn * BM + wc * 32 + 8 * fq;
#pragma unroll
        for (int ai = 0; ai < 2; ++ai) {
#pragma unroll
            for (int m = 0; m < 4; ++m) { const size_t off = (size_t)(row0 + ai * HALF + m * 16) * 1024 + col0;
#pragma unroll
                for (int bj = 0; bj < 2; ++bj) { f32x4 a0, a1; unpack8(*(const u32x4*)(SGA + off + bj * HALF), a0, a1);
                    acc[ai][bj][m][0] = acc[ai][bj][m][0] * a0; acc[ai][bj][m][1] = acc[ai][bj][m][1] * a1; } }
        }
    }
    __device__ __forceinline__ void operator()(const f32x4 (&acc)[2][2][4][2], const Unit& u, int wr, int wc, int fr, int fq) const {
        const int row0 = u.pm * BM + wr * 64 + fr, col0 = u.pn * BM + wc * 32 + 8 * fq;
        const bf16_t* gp = SGB + (size_t)row0 * 1024 + col0; bf16_t* op = OUT + (size_t)row0 * 1024 + col0;
        u32x4 gq[3];
        gq[0] = *(const u32x4*)(gp + epi_step_off(0)); gq[1] = *(const u32x4*)(gp + epi_step_off(1));
#pragma unroll
        for (int s = 0; s < 16; ++s) {
            if (s + 2 < 16) gq[(s + 2) % 3] = *(const u32x4*)(gp + epi_step_off(s + 2));
            f32x4 b0, b1; unpack8(gq[s % 3], b0, b1);
#pragma unroll
            for (int i = 0; i < 4; ++i) { b0[i] = fmaxf(b0[i], 1e-30f); b1[i] = fmaxf(b1[i], 1e-30f); }
            *(u32x4*)(op + epi_step_off(s)) = pack8(acc[s >> 3][s & 1][(s >> 1) & 3][0] * b0, acc[s >> 3][s & 1][(s >> 1) & 3][1] * b1);
        }
    }
};
struct EpiResid {
    static constexpr bool PERM = true, AFTER_DRAIN = false;
    const float* X; bf16_t* H;
    __device__ __forceinline__ void operator()(const f32x4 (&acc)[2][2][4][2], const Unit& u, int wr, int wc, int fr, int fq) const {
        const int row0 = u.pm * BM + wr * 64 + fr, col0 = u.pn * BM + wc * 32 + 8 * fq;
        const float* xp = X + (size_t)row0 * 1024 + col0; bf16_t* hp = H + (size_t)row0 * 1024 + col0;
        f32x4 xq[3][2];
        xq[0][0] = *(const f32x4*)(xp + epi_step_off(0)); xq[0][1] = *(const f32x4*)(xp + epi_step_off(0) + 4);
        xq[1][0] = *(const f32x4*)(xp + epi_step_off(1)); xq[1][1] = *(const f32x4*)(xp + epi_step_off(1) + 4);
#pragma unroll
        for (int s = 0; s < 16; ++s) {
            if (s + 2 < 16) { xq[(s + 2) % 3][0] = *(const f32x4*)(xp + epi_step_off(s + 2)); xq[(s + 2) % 3][1] = *(const f32x4*)(xp + epi_step_off(s + 2) + 4); }
            *(u32x4*)(hp + epi_step_off(s)) = pack8(xq[s % 3][0] + acc[s >> 3][s & 1][(s >> 1) & 3][0], xq[s % 3][1] + acc[s >> 3][s & 1][(s >> 1) & 3][1]);
        }
    }
};
template <class Epi, class Sched, bool ALIGN_EPI = false, bool SP2 = false, bool I8 = false, bool DUAL = false>
__device__ __forceinline__ void gemm_phase(PG8_LAS unsigned char* lds, const Gemm g, const Sched& S, const Epi& E) {
    const int tid = ::launder((int)threadIdx.x), wid = __builtin_amdgcn_readfirstlane(tid >> 6), lane = tid & 63, wr = wid >> 2, wc = wid & 3, fr = lane & 15, fq = lane >> 4;
    const int K = g.K, nt = K / BK;
    unsigned voffA[2], voffB[2];
#pragma unroll
    for (int i = 0; i < 2; ++i) { int R, C; stage_rc(tid * 16 + i * 8192, R, C); const int Rb = Epi::PERM ? ((R & ~31) + perm32(R & 31)) : R;
        voffA[i] = (unsigned)(R * K + C) * 2u; voffB[i] = (unsigned)(Rb * K + C) * 2u; }
    const size_t kstep = (size_t)(BK * 2);
    const size_t hstep = (size_t)HALF * K * 2;
    const size_t tstep = 2 * hstep;
    const unsigned ldsw = (unsigned)wid * 1024u;
    const int aoff = lds_byte(wr * 64 + fr, fq * 8), boff = lds_byte(wc * 32 + fr, fq * 8);
#define PG8_SA(b, h) (((b) * 2 + (h)) * HTB)
#define PG8_SB(b, h) ((4 + (b) * 2 + (h)) * HTB)
#define PG8_STAGE(bufoff, gbase, voff) do { _Pragma("unroll") for (int _i = 0; _i < 2; ++_i) \
        __builtin_amdgcn_global_load_lds((const unsigned*)((const char*)(gbase) + (voff)[_i]), (PG8_LAS unsigned*)(lds + (bufoff) + ldsw + _i * 8192), 16, 0, 0); } while (0)
#define PG8_LDA(dst, b, h) do { _Pragma("unroll") for (int m = 0; m < 4; ++m) _Pragma("unroll") for (int k = 0; k < 2; ++k) dst[m][k] = *(const PG8_LAS bf16x8*)(lds + PG8_SA(b, h) + aoff + m * 2048 + k * 1024); } while (0)
#define PG8_LDB(dst, b, h) do { _Pragma("unroll") for (int n = 0; n < 2; ++n) _Pragma("unroll") for (int k = 0; k < 2; ++k) dst[n][k] = *(const PG8_LAS bf16x8*)(lds + PG8_SB(b, h) + boff + n * 2048 + k * 1024); } while (0)
#define PG8_MMA(ai, bj, At, Bt) do { __builtin_amdgcn_s_setprio(1); _Pragma("unroll") for (int m = 0; m < 4; ++m) _Pragma("unroll") for (int n = 0; n < 2; ++n) _Pragma("unroll") for (int k = 0; k < 2; ++k) \
        acc[ai][bj][m][n] = mma16(Bt[n][k], At[m][k], acc[ai][bj][m][n]); __builtin_amdgcn_s_setprio(0); } while (0)
#define PG8_WAIT_V(n) asm volatile("s_waitcnt vmcnt(" #n ")" ::: "memory")
#define PG8_WAIT_L(n) asm volatile("s_waitcnt lgkmcnt(" #n ")" ::: "memory")
#define PG8_BAR __builtin_amdgcn_s_barrier()
#define PG8_SCHED __builtin_amdgcn_sched_barrier(0)
    Unit cur, nxt; int ui = 0;
    if (!S.next(0, cur)) return;
    typedef typename AccSel<I8>::T acc_t; acc_t acc[2][2][4][2];
#pragma unroll
    for (int a = 0; a < 2; ++a)
#pragma unroll
        for (int b = 0; b < 2; ++b)
#pragma unroll
            for (int m = 0; m < 4; ++m)
#pragma unroll
                for (int n = 0; n < 2; ++n) acc[a][b][m][n] = acc_t{};
    bf16x8 At[4][2], B0[2][2], B1[2][2];
    const char* cA = (const char*)((DUAL && cur.part) ? g.A2 : g.A) + (size_t)cur.pm * tstep; const char* cB = (const char*)((DUAL && cur.part) ? g.Bt2 : g.Bt) + (size_t)cur.pn * tstep;
    S.a_ready(cur);
    if constexpr (SP2) {
        PG8_STAGE(PG8_SB(0, 0), cB, voffB); PG8_STAGE(PG8_SB(0, 1), cB + hstep, voffB); PG8_STAGE(PG8_SA(0, 0), cA, voffA); PG8_STAGE(PG8_SA(0, 1), cA + hstep, voffA);
        if (wr == 1) PG8_BAR;
        PG8_WAIT_V(2); PG8_BAR;
        PG8_STAGE(PG8_SB(1, 0), cB + kstep, voffB); PG8_STAGE(PG8_SA(1, 0), cA + kstep, voffA); PG8_STAGE(PG8_SB(1, 1), cB + hstep + kstep, voffB);
        PG8_WAIT_V(6); PG8_BAR;
    } else {
        PG8_STAGE(PG8_SB(0, 0), cB, voffB); PG8_STAGE(PG8_SA(0, 0), cA, voffA); PG8_STAGE(PG8_SB(0, 1), cB + hstep, voffB); PG8_STAGE(PG8_SA(0, 1), cA + hstep, voffA);
        if (wr == 1) PG8_BAR;
        PG8_WAIT_V(4); PG8_BAR;
        PG8_STAGE(PG8_SB(1, 0), cB + kstep, voffB); PG8_STAGE(PG8_SA(1, 0), cA + kstep, voffA); PG8_STAGE(PG8_SB(1, 1), cB + hstep + kstep, voffB);
        PG8_WAIT_V(6); PG8_BAR;
    }
    for (;;) {
        const bool has_next = S.next(ui + 1, nxt);
        const char* nA = has_next ? (const char*)((DUAL && nxt.part) ? g.A2 : g.A) + (size_t)nxt.pm * tstep : cA; const char* nB = has_next ? (const char*)((DUAL && nxt.part) ? g.Bt2 : g.Bt) + (size_t)nxt.pn * tstep : cB;
        for (int t = 0; t < nt; t += 2) {
            const bool last = (t == nt - 2);
            const char* a1 = cA + (size_t)(t + 1) * kstep;
            const char* a2 = last ? nA : cA + (size_t)(t + 2) * kstep; const char* b2 = last ? nB : cB + (size_t)(t + 2) * kstep;
            const char* a3 = a2 + kstep; const char* b3 = b2 + kstep;
            if (last && has_next) S.a_ready(nxt);
            if constexpr (SP2) {
            PG8_LDB(B0, 0, 0); PG8_LDB(B1, 0, 1); PG8_SCHED; PG8_LDA(At, 0, 0); PG8_STAGE(PG8_SA(1, 1), a1 + hstep, voffA);
            PG8_WAIT_V(8); PG8_WAIT_L(0); PG8_BAR; PG8_MMA(0, 0, At, B0); PG8_MMA(0, 1, At, B1); PG8_BAR; PG8_SCHED;
            PG8_LDA(At, 0, 1); PG8_STAGE(PG8_SB(0, 0), b2, voffB); PG8_STAGE(PG8_SB(0, 1), b2 + hstep, voffB); PG8_STAGE(PG8_SA(0, 0), a2, voffA);
            PG8_WAIT_V(8); PG8_WAIT_L(0); PG8_BAR; PG8_MMA(1, 0, At, B0); PG8_MMA(1, 1, At, B1); PG8_BAR; PG8_SCHED;
            PG8_LDB(B0, 1, 0); PG8_LDB(B1, 1, 1); PG8_SCHED; PG8_LDA(At, 1, 0); PG8_STAGE(PG8_SA(0, 1), a2 + hstep, voffA);
            PG8_WAIT_V(8); PG8_WAIT_L(0); PG8_BAR; PG8_MMA(0, 0, At, B0); PG8_MMA(0, 1, At, B1); PG8_BAR; PG8_SCHED;
            PG8_LDA(At, 1, 1); PG8_STAGE(PG8_SB(1, 0), b3, voffB); PG8_STAGE(PG8_SB(1, 1), b3 + hstep, voffB); PG8_STAGE(PG8_SA(1, 0), a3, voffA);
            PG8_WAIT_V(8); PG8_WAIT_L(0); PG8_BAR; PG8_MMA(1, 0, At, B0); PG8_MMA(1, 1, At, B1); PG8_BAR; PG8_SCHED;
            } else {
            PG8_LDB(B0, 0, 0); PG8_SCHED; PG8_LDA(At, 0, 0); PG8_STAGE(PG8_SA(1, 1), a1 + hstep, voffA);
            PG8_WAIT_L(8); PG8_BAR; PG8_WAIT_L(0); PG8_MMA(0, 0, At, B0); PG8_BAR; PG8_SCHED;
            PG8_LDB(B1, 0, 1); PG8_STAGE(PG8_SB(0, 0), b2, voffB);
            PG8_BAR; PG8_WAIT_L(0); PG8_MMA(0, 1, At, B1); PG8_BAR;
            PG8_LDA(At, 0, 1); PG8_STAGE(PG8_SA(0, 0), a2, voffA);
            PG8_BAR; PG8_WAIT_L(0); PG8_MMA(1, 0, At, B0); PG8_BAR; PG8_SCHED;
            PG8_STAGE(PG8_SB(0, 1), b2 + hstep, voffB);
            PG8_WAIT_V(6); PG8_BAR; PG8_MMA(1, 1, At, B1); PG8_BAR;
            PG8_LDB(B0, 1, 0); PG8_SCHED; PG8_LDA(At, 1, 0); PG8_STAGE(PG8_SA(0, 1), a2 + hstep, voffA);
            PG8_WAIT_L(8); PG8_BAR; PG8_WAIT_L(0); PG8_MMA(0, 0, At, B0); PG8_BAR; PG8_SCHED;
            PG8_LDB(B1, 1, 1); PG8_STAGE(PG8_SB(1, 0), b3, voffB);
            PG8_BAR; PG8_WAIT_L(0); PG8_MMA(0, 1, At, B1); PG8_BAR;
            PG8_LDA(At, 1, 1); PG8_STAGE(PG8_SA(1, 0), a3, voffA);
            PG8_BAR; PG8_WAIT_L(0); PG8_MMA(1, 0, At, B0); PG8_BAR; PG8_SCHED;
            PG8_STAGE(PG8_SB(1, 1), b3 + hstep, voffB);
            PG8_WAIT_V(6); PG8_BAR; PG8_MMA(1, 1, At, B1); PG8_BAR;
            }
        }
        if constexpr (ALIGN_EPI) { if (wr == 0) PG8_BAR; }
        bool keep_acc = false;
        if constexpr (DUAL) { if (cur.part == 0) { E.mid(acc, cur, wr, wc, fr, fq); keep_acc = true; } else E(acc, cur, wr, wc, fr, fq); }
        else if constexpr (!Epi::AFTER_DRAIN) { E(acc, cur, wr, wc, fr, fq); S.done(cur); }
        if (!has_next) break;
        if (!keep_acc) {
#pragma unroll
        for (int a = 0; a < 2; ++a)
#pragma unroll
            for (int b = 0; b < 2; ++b)
#pragma unroll
                for (int m = 0; m < 4; ++m)
#pragma unroll
                    for (int n = 0; n < 2; ++n) acc[a][b][m][n] = acc_t{};
        }
        cur = nxt; cA = nA; cB = nB; ++ui;
        if constexpr (ALIGN_EPI) { if (wr == 1) PG8_BAR; }
    }
    PG8_WAIT_V(0);
    if constexpr (!ALIGN_EPI) { if (wr == 0) PG8_BAR; }
    PG8_BAR;
    if constexpr (Epi::AFTER_DRAIN) { E.fused(acc, cur, wr, wc, fr, fq, lds, wid, lane); S.done(cur); }
#undef PG8_SA
#undef PG8_SB
#undef PG8_STAGE
#undef PG8_LDA
#undef PG8_LDB
#undef PG8_MMA
#undef PG8_WAIT_V
#undef PG8_WAIT_L
#undef PG8_BAR
#undef PG8_SCHED
}
}
namespace pg8 {
struct GUnit { int e, row0, nrows, pn, cntm1, base, tau; };
struct MoeOrder {
    const PG8_LAS int* tab; int npn, G, c, total;
    __device__ __forceinline__ void init(const PG8_LAS int* t, int npn_, int G_, int c_) { tab = t; npn = npn_; G = G_; c = c_; total = __builtin_amdgcn_readfirstlane(t[32]) * npn_; }
    __device__ __forceinline__ bool next(int i, GUnit& u) const {
        const int L = i * G + c; if (L >= total) return false;
        const int tau = L / npn; u.pn = L % npn;
        int e = 0;
#pragma unroll
        for (int j = 1; j < 32; ++j) e += (__builtin_amdgcn_readfirstlane(tab[j]) <= tau) ? 1 : 0;
        const int cn = __builtin_amdgcn_readfirstlane(tab[33 + e]), t0 = __builtin_amdgcn_readfirstlane(tab[e]);
        u.e = e; u.row0 = (tau - t0) * 256; u.nrows = (cn - u.row0) < 256 ? (cn - u.row0) : 256; u.cntm1 = cn - 1; u.base = __builtin_amdgcn_readfirstlane(tab[65 + e]); u.tau = tau;
        return true;
    }
};
struct RowsGather {
    static constexpr bool LOADS = true;
    const int* lists;
    __device__ __forceinline__ int raw0(const GUnit&) const { return 0; }
    __device__ __forceinline__ const int* addr(const GUnit& u, int R) const { int s = u.row0 + R; s = s < u.cntm1 ? s : u.cntm1; return lists + (size_t)u.e * 32768 + s; }
    __device__ __forceinline__ int raw(const GUnit& u, int R) const { int s = u.row0 + R; s = s < u.cntm1 ? s : u.cntm1; return lists[(size_t)u.e * 32768 + s]; }
    static __device__ __forceinline__ unsigned row(int raw) { return (unsigned)raw >> 2; }
};
struct RowsDense {
    static constexpr bool LOADS = false;
    __device__ __forceinline__ const int* addr(const GUnit&, int) const { return nullptr; }
    __device__ __forceinline__ int raw0(const GUnit& u) const { return u.base + u.row0; }
    __device__ __forceinline__ int raw(const GUnit& u, int R) const { int s = u.row0 + R; s = s < u.cntm1 ? s : u.cntm1; return u.base + s; }
    static __device__ __forceinline__ unsigned row(int raw) { return (unsigned)raw; }
};
struct EpiMoeGU {
    static constexpr bool PERM = true, AFTER_DRAIN = false;
    const float* b_gu; const float* LRS; const float* SB; unsigned char* ACTq; float* SACT; PG8_LAS float* xm;
    __device__ __forceinline__ void operator()(const i32x4 (&acc)[2][2][4][2], const GUnit& u, int wr, int wc, int fr, int fq) const {
        const int fq_ = ::launder(fq), ch0 = u.pn * 128 + wc * 32 + 8 * fq_, rb = ::launder(wr * 64 + fr); const float* bp = b_gu + (size_t)u.e * 2048 + ch0;
        const float* sp = SB + (size_t)u.e * 2048 + u.pn * 256 + wc * 32 + 8 * fq_;
        const float* lrs = LRS + (size_t)u.e * 32768 + u.row0;
        f32x4 bg[2], bu[2], sg[2], su[2];
#pragma unroll
        for (int n = 0; n < 2; ++n) { bg[n] = *(const f32x4*)(bp + 4 * n); bu[n] = *(const f32x4*)(bp + 1024 + 4 * n); sg[n] = *(const f32x4*)(sp + 4 * n); su[n] = *(const f32x4*)(sp + HALF + 4 * n); }
        float rsv[2][4];
#pragma unroll
        for (int ai = 0; ai < 2; ++ai)
#pragma unroll
            for (int m = 0; m < 4; ++m) { int rr = ai * HALF + m * 16 + rb; rr = rr < u.nrows ? rr : u.nrows - 1; rsv[ai][m] = lrs[rr]; }
        f32x4 af[2][2][4][2];
#pragma unroll
        for (int ai = 0; ai < 2; ++ai)
#pragma unroll
            for (int bj = 0; bj < 2; ++bj)
#pragma unroll
                for (int m = 0; m < 4; ++m)
#pragma unroll
                    for (int n = 0; n < 2; ++n) { af[ai][bj][m][n] = __builtin_convertvector(acc[ai][bj][m][n], f32x4); asm volatile("" : "+v"(af[ai][bj][m][n])); }
        f32x2 av[2][4][4];
#pragma unroll
        for (int ai = 0; ai < 2; ++ai)
#pragma unroll
            for (int m = 0; m < 4; ++m) { const float rs = rsv[ai][m];
                const f32x4 sgr[2] = {sg[0] * rs, sg[1] * rs}, sur[2] = {su[0] * rs, su[1] * rs};
                f32x2 o[4];
#pragma unroll
                for (int n = 0; n < 2; ++n) {
                    o[2 * n] = swiglu_pk(lo2(af[ai][0][m][n]) * lo2(sgr[n]) + lo2(bg[n]), lo2(af[ai][1][m][n]) * lo2(sur[n]) + lo2(bu[n]));
                    o[2 * n + 1] = swiglu_pk(hi2(af[ai][0][m][n]) * hi2(sgr[n]) + hi2(bg[n]), hi2(af[ai][1][m][n]) * hi2(sur[n]) + hi2(bu[n])); }
                av[ai][m][0] = o[0]; av[ai][m][1] = o[1]; av[ai][m][2] = o[2]; av[ai][m][3] = o[3];
                float mx = fmaxf(fmaxf(fmaxf(fabsf(o[0].x), fabsf(o[0].y)), fmaxf(fabsf(o[1].x), fabsf(o[1].y))), fmaxf(fmaxf(fabsf(o[2].x), fabsf(o[2].y)), fmaxf(fabsf(o[3].x), fabsf(o[3].y))));
                mx = ::lane_max_16_32(mx);
                if (fq == 0) (xm + (ai * HALF + m * 16) * 4 + wc)[rb * 4] = mx; }
        asm volatile("s_waitcnt lgkmcnt(0)" ::: "memory"); __builtin_amdgcn_s_barrier(); asm volatile("" ::: "memory");
        unsigned char* actp = ACTq + ((size_t)u.tau * 8 + u.pn) * 32768; float* scp = SACT + (size_t)(u.base + u.row0) * 8 + u.pn;
        const unsigned loff = (unsigned)rb * 128u + (unsigned)(wc * 32 + 8 * fq_), soff = (unsigned)rb * 8u, xoff = (unsigned)rb * 4u;
        float tmx[2][4];
#pragma unroll
        for (int ai = 0; ai < 2; ++ai)
#pragma unroll
            for (int m = 0; m < 4; ++m) { const f32x4 t = *(const PG8_LAS f32x4*)(xm + (ai * HALF + m * 16) * 4 + xoff); tmx[ai][m] = fmaxf(fmaxf(t[0], t[1]), fmaxf(t[2], t[3])); }
#pragma unroll
        for (int ai = 0; ai < 2; ++ai)
#pragma unroll
            for (int m = 0; m < 4; ++m) { const int rs0 = ai * HALF + m * 16;
                const float tmax = tmx[ai][m], inv = tmax > 0.f ? 127.f * __builtin_amdgcn_rcpf(tmax) : 0.f;
                if (rb < u.nrows - rs0) { const f32x2 q0_ = av[ai][m][0] * inv, q1_ = av[ai][m][1] * inv, q2_ = av[ai][m][2] * inv, q3_ = av[ai][m][3] * inv;
                    u32x2 q; q.x = ::pk4_i8(q0_.x, q0_.y, q1_.x, q1_.y); q.y = ::pk4_i8(q2_.x, q2_.y, q3_.x, q3_.y);
                    *(u32x2*)(actp + (size_t)rs0 * 128 + loff) = q;
                    if (wc == 0 && fq == 0) (scp + (size_t)rs0 * 8)[soff] = tmax * (1.f / 127.f); } }
    }
};
struct EpiMoeDown {
    static constexpr bool PERM = true, AFTER_DRAIN = false;
    const float* b_dn; const float* SB; const int* lists; const float* LGT; bf16_t* Y;
    __device__ __forceinline__ void operator()(const f32x4 (&acc)[2][2][4][2], const GUnit& u, int wr, int wc, int fr, int fq, const PG8_LAS float* scb  ) const {
        const int col0 = u.pn * BM + wc * 32 + 8 * ::launder(fq), rb = ::launder(wr * 64 + fr); const float* bp = b_dn + (size_t)u.e * 1024 + col0;
        const int* lp = lists + (size_t)u.e * 32768 + u.row0; const float* gp = LGT + (size_t)u.e * 32768 + u.row0; const float* sp = SB + (size_t)u.e * 1024 + col0;
        f32x4 bv[2][2], sv[2][2];
#pragma unroll
        for (int bj = 0; bj < 2; ++bj)
#pragma unroll
            for (int n = 0; n < 2; ++n) { bv[bj][n] = *(const f32x4*)(bp + bj * HALF + 4 * n); sv[bj][n] = *(const f32x4*)(sp + bj * HALF + 4 * n); }
        int idv[2][4]; float gtv[2][4];
#pragma unroll
        for (int ai = 0; ai < 2; ++ai)
#pragma unroll
            for (int m = 0; m < 4; ++m) { int rr = ai * HALF + m * 16 + rb; rr = rr < u.nrows ? rr : u.nrows - 1; idv[ai][m] = lp[rr]; gtv[ai][m] = gp[rr]; }
        float offv[2][4];
#pragma unroll
        for (int ai = 0; ai < 2; ++ai)
#pragma unroll
            for (int m = 0; m < 4; ++m) offv[ai][m] = scb[ai * HALF + m * 16 + rb];
#pragma unroll
        for (int ai = 0; ai < 2; ++ai)
#pragma unroll
            for (int m = 0; m < 4; ++m) { const int rs0 = ai * HALF + m * 16;
                if (rb < u.nrows - rs0) { const float gt = gtv[ai][m]; bf16_t* yp = Y + (size_t)idv[ai][m] * 1024 + col0;
                    const float off = offv[ai][m];
#pragma unroll
                    for (int bj = 0; bj < 2; ++bj) *(u32x4*)(yp + bj * HALF) = pack8(((acc[ai][bj][m][0] - off) * sv[bj][0] + bv[bj][0]) * gt, ((acc[ai][bj][m][1] - off) * sv[bj][1] + bv[bj][1]) * gt); } }
    }
};

template <class Epi, class Sched, class Rows, int KE = 1024, bool I8 = false, bool BS = false, bool KTM = false>
__device__ __forceinline__ void gemm_phase_g(int wave_  , PG8_LAS unsigned char* lds, PG8_LAS unsigned char* park  , PG8_LAS unsigned char* spark  , const float* ASC, const bf16_t* A, const bf16_t* Bt, size_t b_estride  , const Sched& S, const Rows& RW, const Epi& E) {
    const int tid = ::tid_of(wave_), wid = wave_, lane = tid & 63, wr = wid >> 2, wc = wid & 3, fr = lane & 15, fq = lane >> 4;
    constexpr int K = KE, nt = K / BK;
    typedef typename AccSel<I8 && !BS>::T acc_t;
    unsigned voffB[2];
#pragma unroll
    for (int i = 0; i < 2; ++i) { int R, C; stage_rc(tid * 16 + i * 8192, R, C); const int Rb = Epi::PERM ? ((R & ~31) + perm32(R & 31)) : R; voffB[i] = (unsigned)(Rb * K + C) * 2u; }
#define PG8_RC(i, R, C) int R, C; stage_rc(::tid_of(wave_) * 16 + (i) * 8192, R, C)
    constexpr size_t kstep = (size_t)(BK * 2), hstep = (size_t)HALF * K * 2, tstep = 2 * hstep, kstepA = KTM ? (size_t)32768 : kstep;
    const unsigned ldsw = (unsigned)wid * 1024u;
    const int aoff = lds_byte(wr * 64 + fr, fq * 8), boff = lds_byte(wc * 32 + fr, fq * 8);
#define PG8_SA(b, h) (((b) * 2 + (h)) * HTB)
#define PG8_SB(b, h) ((4 + (b) * 2 + (h)) * HTB)
#define PG8_STAGE(bufoff, gbase, voff) do { _Pragma("unroll") for (int _i = 0; _i < 2; ++_i) \
        __builtin_amdgcn_global_load_lds((const unsigned*)((const char*)(gbase) + (voff)[_i]), (PG8_LAS unsigned*)(lds + (bufoff) + ldsw + _i * 8192), 16, 0, 0); } while (0)
#define PG8_LDA(dst, b, h) do { _Pragma("unroll") for (int m = 0; m < 4; ++m) _Pragma("unroll") for (int k = 0; k < 2; ++k) dst[m][k] = *(const PG8_LAS bf16x8*)(lds + PG8_SA(b, h) + aoff + m * 2048 + k * 1024); } while (0)
#define PG8_LDB(dst, b, h) do { _Pragma("unroll") for (int n = 0; n < 2; ++n) _Pragma("unroll") for (int k = 0; k < 2; ++k) dst[n][k] = *(const PG8_LAS bf16x8*)(lds + PG8_SB(b, h) + boff + n * 2048 + k * 1024); } while (0)
#define PG8_MMA(ai, bj, At, Bt) do { __builtin_amdgcn_s_setprio(1); _Pragma("unroll") for (int m = 0; m < 4; ++m) _Pragma("unroll") for (int n = 0; n < 2; ++n) _Pragma("unroll") for (int k = 0; k < 2; ++k) \
        acc[ai][bj][m][n] = mma16(Bt[n][k], At[m][k], acc[ai][bj][m][n]); __builtin_amdgcn_s_setprio(0); } while (0)
#define PG8_MMA_BS(ai, bj, At, Bt, sc) do { _Pragma("unroll") for (int m = 0; m < 4; ++m) { i32x4 tq_[2]; __builtin_amdgcn_s_setprio(1); \
        _Pragma("unroll") for (int n = 0; n < 2; ++n) tq_[n] = mma16(Bt[n][0], At[m][0], magic); \
        _Pragma("unroll") for (int n = 0; n < 2; ++n) tq_[n] = mma16(Bt[n][1], At[m][1], tq_[n]); \
        __builtin_amdgcn_s_setprio(0); \
        _Pragma("unroll") for (int n = 0; n < 2; ++n) acc[ai][bj][m][n] = acc[ai][bj][m][n] + __builtin_bit_cast(f32x4, tq_[n]) * sc[m]; } } while (0)
#define PG8_LDSC(sc, ai, kt) do { if constexpr (BS) { _Pragma("unroll") for (int m = 0; m < 4; ++m) sc[m] = *(const PG8_LAS float*)(spark + (ui & 1) * 8192 + (((ai) * HALF + wr * 64 + m * 16 + fr) * 8 + (kt)) * 4); } } while (0)
#define PG8_SSUM(par_) do { const int t_ = ::tid_of(wave_), row_ = t_ >> 1, hf_ = t_ & 1; \
        const f32x4 s4_ = *(const PG8_LAS f32x4*)(spark + (par_) * 8192 + row_ * 32 + hf_ * 16); \
        float sm_ = (s4_.x + s4_.y) + (s4_.z + s4_.w); sm_ += __shfl_xor(sm_, 1); \
        if (hf_ == 0) *(PG8_LAS float*)(spark - 2048 + (par_) * 1024 + row_ * 4) = sm_ * 12582912.f; } while (0)
#define PG8_MM2(ai) do { if constexpr (BS) { PG8_MMA_BS(ai, 0, At, B0, sc); PG8_MMA_BS(ai, 1, At, B1, sc); } else { PG8_MMA(ai, 0, At, B0); PG8_MMA(ai, 1, At, B1); } } while (0)
#define PG8_SPARK(u_, par_) do { if constexpr (BS) __builtin_amdgcn_global_load_lds((const unsigned*)(ASC + (size_t)((u_).base + (u_).row0) * 8 + wid * 256 + lane * 4), (PG8_LAS unsigned*)(spark + (par_) * 8192 + wid * 1024), 16, 0, 0); } while (0)
#define PG8_WAIT_V(n) asm volatile("s_waitcnt vmcnt(" #n ")" ::: "memory")
#define PG8_WAIT_L(n) asm volatile("s_waitcnt lgkmcnt(" #n ")" ::: "memory")
#define PG8_BAR __builtin_amdgcn_s_barrier()
#define PG8_SCHED __builtin_amdgcn_sched_barrier(0)
    GUnit cur, nxt, nn; int ui = 0;
    if (!S.next(0, cur)) return;
    bool has_next = S.next(1, nxt), has_nn = has_next && S.next(2, nn);
    unsigned voC[2][2], voN[2][2];
    PG8_LAS unsigned char* pk = park + wid * 1024;
#define PG8_PARK(u_) do { if constexpr (Rows::LOADS) { _Pragma("unroll") for (int i = 0; i < 2; ++i) { PG8_RC(i, R_, C_); (void)C_; _Pragma("unroll") for (int h = 0; h < 2; ++h) \
        __builtin_amdgcn_global_load_lds((const unsigned*)RW.addr(u_, h * HALF + R_), (PG8_LAS unsigned*)(pk + (h * 2 + i) * 256), 4, 0, 0); } } } while (0)
#define PG8_UNPARK(h, i) (*(const PG8_LAS int*)(pk + ((h) * 2 + (i)) * 256 + lane * 4))
#pragma unroll
    for (int i = 0; i < 2; ++i) { PG8_RC(i, R_, C_);
#pragma unroll
        for (int h = 0; h < 2; ++h) {
            if constexpr (Rows::LOADS) {
                voC[h][i] = Rows::row(RW.raw(cur, h * HALF + R_)) * (unsigned)(K * 2) + (unsigned)C_ * 2u;
                voN[h][i] = has_next ? Rows::row(RW.raw(nxt, h * HALF + R_)) * (unsigned)(K * 2) + (unsigned)C_ * 2u : voC[h][i];
            } else { voC[h][i] = (unsigned)(h * HALF + R_) * (KTM ? 128u : (unsigned)(K * 2)) + (unsigned)C_ * 2u; voN[h][i] = 0u; } } }
    if (has_nn) PG8_PARK(nn);
    acc_t acc[2][2][4][2];
#pragma unroll
    for (int a = 0; a < 2; ++a)
#pragma unroll
        for (int b = 0; b < 2; ++b)
#pragma unroll
            for (int m = 0; m < 4; ++m)
#pragma unroll
                for (int n = 0; n < 2; ++n) acc[a][b][m][n] = acc_t{};
    bf16x8 At[4][2], B0[2][2], B1[2][2]; float sc[4];
    i32x4 magic = {0x4B400000, 0x4B400000, 0x4B400000, 0x4B400000}; asm volatile("" : "+v"(magic));
    const char* cA = (const char*)A; if constexpr (!Rows::LOADS) cA += KTM ? (size_t)cur.tau * 262144 : (size_t)Rows::row(RW.raw0(cur)) * (size_t)(K * 2);
    const char* cB = (const char*)Bt + (size_t)cur.e * b_estride + (size_t)cur.pn * tstep;
    PG8_SPARK(cur, 0); if (has_next) PG8_SPARK(nxt, 1);
    PG8_STAGE(PG8_SB(0, 0), cB, voffB); PG8_STAGE(PG8_SB(0, 1), cB + hstep, voffB); PG8_STAGE(PG8_SA(0, 0), cA, voC[0]); PG8_STAGE(PG8_SA(0, 1), cA, voC[1]);
    if (wr == 1) PG8_BAR;
    PG8_WAIT_V(2); PG8_BAR;
    PG8_STAGE(PG8_SB(1, 0), cB + kstep, voffB); PG8_STAGE(PG8_SA(1, 0), cA + kstepA, voC[0]); PG8_STAGE(PG8_SB(1, 1), cB + hstep + kstep, voffB);
    PG8_WAIT_V(6); PG8_BAR;
    for (;;) {
        const char* nA = cA; if constexpr (!Rows::LOADS) { if (has_next) nA = (const char*)A + (KTM ? (size_t)nxt.tau * 262144 : (size_t)Rows::row(RW.raw0(nxt)) * (size_t)(K * 2)); }
        const char* nB = has_next ? (const char*)Bt + (size_t)nxt.e * b_estride + (size_t)nxt.pn * tstep : cB;
        for (int t = 0; t < nt; t += 2) {
            const bool last = (t == nt - 2);
            const char* a1 = cA + (size_t)(t + 1) * kstepA;
            const char* a2 = last ? nA : cA + (size_t)(t + 2) * kstepA; const char* b2 = last ? nB : cB + (size_t)(t + 2) * kstep;
            const char* a3 = a2 + kstepA; const char* b3 = b2 + kstep;
            unsigned v20[2], v21[2];
#pragma unroll
            for (int i = 0; i < 2; ++i) { if constexpr (Rows::LOADS) { v20[i] = last ? voN[0][i] : voC[0][i]; v21[i] = last ? voN[1][i] : voC[1][i]; } else { v20[i] = voC[0][i]; v21[i] = voC[1][i]; } }
            if constexpr (BS) { if (t == 2) PG8_SSUM(ui & 1); }
            PG8_LDB(B0, 0, 0); PG8_LDB(B1, 0, 1); PG8_SCHED; PG8_LDA(At, 0, 0); PG8_LDSC(sc, 0, t); PG8_STAGE(PG8_SA(1, 1), a1, voC[1]);
            PG8_WAIT_V(8); PG8_WAIT_L(0); PG8_BAR; PG8_MM2(0); PG8_BAR; PG8_SCHED;
            PG8_LDA(At, 0, 1); PG8_LDSC(sc, 1, t); PG8_STAGE(PG8_SB(0, 0), b2, voffB); PG8_STAGE(PG8_SB(0, 1), b2 + hstep, voffB); PG8_STAGE(PG8_SA(0, 0), a2, v20);
            PG8_WAIT_V(8); PG8_WAIT_L(0); PG8_BAR; PG8_MM2(1); PG8_BAR; PG8_SCHED;
            PG8_LDB(B0, 1, 0); PG8_LDB(B1, 1, 1); PG8_SCHED; PG8_LDA(At, 1, 0); PG8_LDSC(sc, 0, t + 1); PG8_STAGE(PG8_SA(0, 1), a2, v21);
            PG8_WAIT_V(8); PG8_WAIT_L(0); PG8_BAR; PG8_MM2(0); PG8_BAR; PG8_SCHED;
            PG8_LDA(At, 1, 1); PG8_LDSC(sc, 1, t + 1); PG8_STAGE(PG8_SB(1, 0), b3, voffB); PG8_STAGE(PG8_SB(1, 1), b3 + hstep, voffB); PG8_STAGE(PG8_SA(1, 0), a3, v20);
            PG8_WAIT_V(8); PG8_WAIT_L(0); PG8_BAR; PG8_MM2(1); PG8_BAR; PG8_SCHED;
        }
        if (wr == 0) PG8_BAR;
        if constexpr (BS) E(acc, cur, wr, wc, fr, fq, (const PG8_LAS float*)(spark - 2048 + (ui & 1) * 1024)); else E(acc, cur, wr, wc, fr, fq);
        if (!has_next) break;
#pragma unroll
        for (int a = 0; a < 2; ++a)
#pragma unroll
            for (int b = 0; b < 2; ++b)
#pragma unroll
                for (int m = 0; m < 4; ++m)
#pragma unroll
                    for (int n = 0; n < 2; ++n) acc[a][b][m][n] = acc_t{};
        cur = nxt; cB = nB; cA = nA; nxt = nn; has_next = has_nn; ++ui;
        has_nn = has_next && S.next(ui + 2, nn);
        if constexpr (Rows::LOADS) {
#pragma unroll
        for (int i = 0; i < 2; ++i) { PG8_RC(i, R_, C_);
#pragma unroll
            for (int h = 0; h < 2; ++h) { voC[h][i] = voN[h][i];
                if (has_next) voN[h][i] = Rows::row(PG8_UNPARK(h, i)) * (unsigned)(K * 2) + (unsigned)C_ * 2u; } }
        }
        if constexpr (Rows::LOADS) { PG8_WAIT_L(0); asm volatile("" ::: "memory"); }
        if (has_nn) PG8_PARK(nn);
        if (has_next) PG8_SPARK(nxt, (ui + 1) & 1);
        if (wr == 1) PG8_BAR;
    }
    PG8_WAIT_V(0);
    PG8_BAR;
#undef PG8_PARK
#undef PG8_MMA_BS
#undef PG8_LDSC
#undef PG8_SSUM
#undef PG8_MM2
#undef PG8_SPARK
#undef PG8_RC
#undef PG8_UNPARK
#undef PG8_SA
#undef PG8_SB
#undef PG8_STAGE
#undef PG8_LDA
#undef PG8_LDB
#undef PG8_MMA
#undef PG8_WAIT_V
#undef PG8_WAIT_L
#undef PG8_BAR
#undef PG8_SCHED
}
}
#include <hip/hip_bf16.h>
#include <cmath>
namespace attn_body {
using bf16=__hip_bfloat16;
using bf16x8=__attribute__((ext_vector_type(8)))short;
using s16x4=__attribute__((ext_vector_type(4)))short;
using f32x16=__attribute__((ext_vector_type(16)))float;
using u32x4=__attribute__((ext_vector_type(4)))unsigned;
typedef float f32x4_t __attribute__((ext_vector_type(4)));
constexpr int BATCH=4,NHEAD=16,SEQ=8192,KVR=SEQ+64,D=64,DM=NHEAD*D;
constexpr int NW=8,QBLK=32,QB=QBLK*NW,KVBLK=64,NQB=SEQ/QB;
constexpr int ATTN_PITCH=DM, ATTN_UNIT_ROWS=QB;
__device__ __forceinline__ int crow(int r,int hi){return (r&3)+8*(r>>2)+4*hi;}
#define SBAR() __builtin_amdgcn_sched_barrier(0)
__device__ __forceinline__ void cmask(f32x16&p0,f32x16&p1,int jb,int qrel,int hi){
  const float NEG=-INFINITY; int kb=64*jb+4*hi;
  #pragma unroll
  for(int r=0;r<16;++r){int kv=kb+(r&3)+8*(r>>2); if(kv>qrel)p0[r]=NEG; if(kv+32>qrel)p1[r]=NEG;}
}

constexpr int NSLOT=3, SLOTB=8192;
constexpr int LDS_K=0, LDS_V=NSLOT*SLOTB, LDS_WS=2*NSLOT*SLOTB, LDS_OST=LDS_WS+NW*64*4, LDS_BIAS=LDS_OST+NW*4096, LDS_KN=LDS_BIAS+KVR*4, LDS_QM=LDS_KN+132*4, LDS_BYTES=LDS_QM+32;
constexpr float SKIP_MASS=4.8828125e-4f;
constexpr float C2=0.125f*1.4426950408889634f;
__device__ __forceinline__ void glds16(const void*gsrc,unsigned lds_dst){unsigned keep;
  asm volatile("s_mov_b32 %0, m0\n\ts_mov_b32 m0, %2\n\ts_nop 0\n\tglobal_load_lds_dwordx4 %1, off\n\ts_mov_b32 m0, %0":"=&s"(keep):"v"(gsrc),"s"(lds_dst):"memory");}
__device__ __forceinline__ float max3f(float a,float b,float c){float r;asm("v_max3_f32 %0, %1, %2, %3":"=v"(r):"v"(a),"v"(b),"v"(c));return r;}
__device__ __forceinline__ float max2f(float a,float b){float r;asm("v_max_f32_e32 %0, %1, %2":"=v"(r):"v"(a),"v"(b));return r;}
__device__ __forceinline__ float fadd_s(float a,float b){float r;asm("v_add_f32_e32 %0, %1, %2":"=v"(r):"v"(a),"v"(b));return r;}
__device__ __forceinline__ float fsub_s(float a,float b){float r;asm("v_sub_f32_e32 %0, %1, %2":"=v"(r):"v"(a),"v"(b));return r;}
typedef float f32x2_t __attribute__((ext_vector_type(2))); typedef __bf16 bf16x2_t __attribute__((ext_vector_type(2)));
__device__ __forceinline__ unsigned cvtpk_s(float lo,float hi){f32x2_t v={lo,hi};bf16x2_t b=__builtin_convertvector(v,bf16x2_t);return __builtin_bit_cast(unsigned,b);}
#define WAIT_BAR(N) asm volatile("s_waitcnt vmcnt(" #N ") lgkmcnt(0)\n\ts_barrier":::"memory")

__device__ __forceinline__ void qkt(f32x16&p0,f32x16&p1,const char*Kslot,const bf16x8*qr,int r32,int hi){
  const char*kb=Kslot+hi*1024+r32*16;
  #pragma unroll
  for(int d0=0;d0<4;++d0){
    const bf16x8 b0=*reinterpret_cast<const bf16x8*>(kb+d0*2048);
    const bf16x8 b1=*reinterpret_cast<const bf16x8*>(kb+d0*2048+512);
    {p0=__builtin_amdgcn_mfma_f32_32x32x16_bf16(b0,qr[d0],p0,0,0,0);p1=__builtin_amdgcn_mfma_f32_32x32x16_bf16(b1,qr[d0],p1,0,0,0);}}
}
typedef __attribute__((address_space(3))) const char* lds_cptr;
typedef short v4i16_t __attribute__((ext_vector_type(4)));
__device__ __forceinline__ void kload8(bf16x8*kf,lds_cptr kp){
  kf[0]=*(const __attribute__((address_space(3))) bf16x8*)(kp);      kf[1]=*(const __attribute__((address_space(3))) bf16x8*)(kp+512);
  kf[2]=*(const __attribute__((address_space(3))) bf16x8*)(kp+2048); kf[3]=*(const __attribute__((address_space(3))) bf16x8*)(kp+2560);
  kf[4]=*(const __attribute__((address_space(3))) bf16x8*)(kp+4096); kf[5]=*(const __attribute__((address_space(3))) bf16x8*)(kp+4608);
  kf[6]=*(const __attribute__((address_space(3))) bf16x8*)(kp+6144); kf[7]=*(const __attribute__((address_space(3))) bf16x8*)(kp+6656);
}
__device__ __forceinline__ void kload2(bf16x8*kf,lds_cptr kp,int j){ kf[2*j]=*(const __attribute__((address_space(3))) bf16x8*)(kp+j*2048); kf[2*j+1]=*(const __attribute__((address_space(3))) bf16x8*)(kp+j*2048+512); }
__device__ __forceinline__ s16x4 vtr(lds_cptr p){ return __builtin_bit_cast(s16x4,__builtin_amdgcn_ds_read_tr16_b64_v4i16((__attribute__((address_space(3))) v4i16_t*)p)); }
__device__ __forceinline__ float rowmax(const f32x16&p0,const f32x16&p1){
  float a=max3f(p0[0],p0[1],p1[0]),b=max3f(p0[2],p0[3],p1[1]);a=max3f(a,p1[2],p1[3]);
  #pragma unroll
  for(int r=4;r<16;r+=4){a=max3f(a,p0[r],p0[r+1]);b=max3f(b,p0[r+2],p0[r+3]);a=max3f(a,p1[r],p1[r+1]);b=max3f(b,p1[r+2],p1[r+3]);}
  const float m=max2f(a,b);
  auto rr=__builtin_amdgcn_permlane32_swap(__float_as_uint(m),__float_as_uint(m),false,false);
  return max2f(__uint_as_float(rr[0]),__uint_as_float(rr[1]));
}
__device__ __forceinline__ void pv(f32x16*o,int vb,bf16x8 pa0,bf16x8 pa1,bf16x8 pa2,bf16x8 pa3){
  #pragma unroll
  for(int d0=0;d0<2;++d0){s16x4 lo[4],hi[4];
    #pragma unroll
    for(int ks=0;ks<4;++ks){
      asm volatile("ds_read_b64_tr_b16 %0,%1 offset:%c2":"=&v"(lo[ks]):"v"(vb),"i"(d0*4096+ks*1024):"memory");
      asm volatile("ds_read_b64_tr_b16 %0,%1 offset:%c2":"=&v"(hi[ks]):"v"(vb),"i"(d0*4096+ks*1024+512):"memory");}
    asm volatile("s_waitcnt lgkmcnt(0)":::"memory");SBAR();
    #define PK(k) (bf16x8){lo[k][0],lo[k][1],lo[k][2],lo[k][3],hi[k][0],hi[k][1],hi[k][2],hi[k][3]}
    o[d0]=__builtin_amdgcn_mfma_f32_32x32x16_bf16(pa0,PK(0),o[d0],0,0,0);
    o[d0]=__builtin_amdgcn_mfma_f32_32x32x16_bf16(pa1,PK(1),o[d0],0,0,0);
    o[d0]=__builtin_amdgcn_mfma_f32_32x32x16_bf16(pa2,PK(2),o[d0],0,0,0);
    o[d0]=__builtin_amdgcn_mfma_f32_32x32x16_bf16(pa3,PK(3),o[d0],0,0,0);
    #undef PK
  }
}

#ifndef ATTN_STORE16
#define ATTN_STORE16(p,v) (*(u32x4*)(p)=(v))
#endif
__device__ __forceinline__ int attn_jstart(lds_cptr shm3,int ui,int q0,int lane){
  int jstart;
  { const __attribute__((address_space(3))) float*bl=(const __attribute__((address_space(3))) float*)(shm3+LDS_BIAS),*KN=(const __attribute__((address_space(3))) float*)(shm3+LDS_KN),*QM=(const __attribute__((address_space(3))) float*)(shm3+LDS_QM);
    const int NTf=1+(q0+QB)/KVBLK; const float qm2=QM[ui];
    const float kd2=__builtin_fmaxf(__builtin_fmaxf(KN[NTf-4],KN[NTf-3]),__builtin_fmaxf(KN[NTf-2],KN[NTf-1]));
    const float dl=bl[64+q0]-__builtin_sqrtf(qm2*kd2);
    float ms[3];
    #pragma unroll
    for(int c=0;c<3;++c){ const int j=3*lane+c; ms[c]=0.f;
      if(j<NTf-4){ const float bm=(j==0)?bl[15]:bl[64*j+63]; ms[c]=((j==0)?16.f:64.f)*__builtin_amdgcn_exp2f(__builtin_fminf(__builtin_sqrtf(qm2*KN[j])+bm-dl,100.f)); } }
    const float s0_=ms[0], s1_=s0_+ms[1], s2_=s1_+ms[2]; float ex=s2_;
    #pragma unroll
    for(int o=1;o<64;o<<=1){ const float t_=__shfl_up(ex,o); if(lane>=o)ex+=t_; }
    ex-=s2_;
    int j0=__builtin_popcountll(__ballot(3*lane<NTf-4&&ex+s0_<=SKIP_MASS))+__builtin_popcountll(__ballot(3*lane+1<NTf-4&&ex+s1_<=SKIP_MASS))+__builtin_popcountll(__ballot(3*lane+2<NTf-4&&ex+s2_<=SKIP_MASS));
    if(j0>NTf-5)j0=NTf-5; jstart=__builtin_amdgcn_readfirstlane(j0&~1); }
  return jstart;
}
template<int THRL> __device__ __forceinline__ int attn_unit(int ui,int b,int h,int qb,const bf16*Q,const bf16*__restrict__ K,const bf16*__restrict__ V,bf16*O,char*shm,int jpre  ,int nui,int nqb  ){
  const int tid=::launder((int)threadIdx.x),lane=tid&63,r32=lane&31,hi=lane>>5; const int wid=__builtin_amdgcn_readfirstlane(tid>>6);
  const long rowbase=(long)b*SEQ, kvbase=(long)b*KVR; const int q0=qb*QB;
  const bf16*Qw=Q+(rowbase+q0+wid*QBLK)*DM+h*D;
  const lds_cptr shm3=(lds_cptr)shm;
  const bool pre=jpre>=0; const int jstart=pre?jpre:attn_jstart(shm3,ui,q0,lane);
  const bf16*Kh=K+(kvbase+(long)jstart*KVBLK)*DM+h*D,*Vh=V+(kvbase+(long)jstart*KVBLK)*DM+h*D;
  const unsigned lds0=(unsigned)(uintptr_t)shm;
  float*wsf=(float*)(shm+LDS_WS)+wid*64;
  const bf16*ksrc=Kh+(long)lane*DM+wid*8;
  const bf16*vsrc=Vh+(long)(16*(wid&3)+(lane>>2))*DM+(wid>>2)*32+(lane&3)*8;
  const unsigned kdst=lds0+LDS_K+wid*1024, vdst=lds0+LDS_V+wid*1024;
  #define DMA_K(t,slot) glds16(ksrc+(long)(t)*KVBLK*DM,(unsigned)__builtin_amdgcn_readfirstlane(kdst+(slot)))
  #define DMA_V(t,slot) glds16(vsrc+(long)(t)*KVBLK*DM,(unsigned)__builtin_amdgcn_readfirstlane(vdst+(slot)))
  const int vb0=(int)(lds0+LDS_V)+((lane>>4)&1)*32+(lane&3)*8+(4*hi+((lane&15)>>2))*64;
  const char*Kbase=shm+LDS_K; bf16x8 kf[8];
  const lds_cptr kp0=shm3+LDS_K+hi*1024+r32*16; const lds_cptr vp0=shm3+LDS_V+((lane>>4)&1)*32+(lane&3)*8+(4*hi+((lane&15)>>2))*64;
  const int NT=1+(q0+QB)/KVBLK-jstart;
  if(!pre){DMA_K(0,0);DMA_V(0,0);DMA_K(1,SLOTB);}
  bf16x8 qr[4];
  #pragma unroll
  for(int d0=0;d0<4;++d0)qr[d0]=*reinterpret_cast<const bf16x8*>(&Qw[(long)r32*DM+d0*16+hi*8]);
  const float mhat=*(const __attribute__((address_space(3))) float*)(shm3+LDS_BIAS+(64+q0+wid*QBLK+r32)*4); float l_reg=0.f;f32x16 o[2];o[0]=f32x16{};o[1]=f32x16{};
  const lds_cptr biasp=shm3+LDS_BIAS+jstart*256+hi*16;
  #define BINIT(P0,P1,tn) do{ const lds_cptr bp_=biasp+(tn)*256; _Pragma("unroll") for(int g_=0;g_<4;++g_){ \
      const f32x4_t v0_=*(const __attribute__((address_space(3))) f32x4_t*)(bp_+g_*32)-mhat, v1_=*(const __attribute__((address_space(3))) f32x4_t*)(bp_+128+g_*32)-mhat; \
      P0[4*g_]=v0_[0];P0[4*g_+1]=v0_[1];P0[4*g_+2]=v0_[2];P0[4*g_+3]=v0_[3]; P1[4*g_]=v1_[0];P1[4*g_+1]=v1_[1];P1[4*g_+2]=v1_[2];P1[4*g_+3]=v1_[3]; } }while(0)
  const int qrel=wid*QBLK+r32;
  #define CMASK(P0,P1,t) do{int jb_=(t)-(NT-4); if(jb_>=0)cmask(P0,P1,jb_,qrel,hi);}while(0)
  #define START(P0,P1) do{ _Pragma("unroll") for(int r=0;r<16;++r)P0[r]=__builtin_amdgcn_exp2f(P0[r]); }while(0)
  #define RESC() do{}while(0)
  f32x16 pA0,pA1,pB0,pB1;
  int sl_prev=0,sl_cur=0,sl_next=SLOTB;
  #define ROT() do{sl_prev=sl_cur;sl_cur=sl_next;sl_next=(sl_next==(NSLOT-1)*SLOTB)?0:sl_next+SLOTB;}while(0)
  if(!pre)DMA_K(2,2*SLOTB);
  WAIT_BAR(3);
  BINIT(pA0,pA1,0); qkt(pA0,pA1,Kbase,qr,r32,hi);asm volatile("s_nop 15\n\ts_nop 7":"+v"(pA0),"+v"(pA1));CMASK(pA0,pA1,0);
  START(pA0,pA1);
  BINIT(pB0,pB1,1);
  _Pragma("unroll") for(int r=0;r<16;++r)pA1[r]=__builtin_amdgcn_exp2f(pA1[r]);
  WAIT_BAR(0);
  DMA_K(3,0);DMA_V(1,SLOTB);
  ROT();
  kload8(kf,kp0+sl_cur);
  WAIT_BAR(2);
  s16x4 vlo[8],vhi[8]; u32x4 pw0,pw1,pw2,pw3;
  #define PKW(P,B) cvtpk_s(P[B],P[B+1])
  #define PAF(k) __builtin_bit_cast(bf16x8,pw##k)
  #define VFR(i) (bf16x8){vlo[i][0],vlo[i][1],vlo[i][2],vlo[i][3],vhi[i][0],vhi[i][1],vhi[i][2],vhi[i][3]}
  #define PIN(x) asm volatile("":"+v"(x))
  #define MX3(a,b,c) __builtin_fmaxf(__builtin_fmaxf((a),(b)),(c))
  #define GAPA(MF,A0,A1,A2,A3,W0,W1,PW) do{ MF; sacc+=A0; sacc+=A1; sacc+=A2; sacc+=A3; PIN(sacc); W0; W1; PIN(PW); SBAR(); }while(0)
  #define EX(v) __builtin_amdgcn_exp2f(v)
  #define GAPB(MF,X,B) do{ MF; X[B]=EX(X[B]); X[B+1]=EX(X[B+1]); X[B+2]=EX(X[B+2]); X[B+3]=EX(X[B+3]); PIN(X); SBAR(); }while(0)
  #define VRD(i) do{ vlo[i]=vtr(vp_+(((i)>>2)*4096+((i)&3)*1024)); vhi[i]=vtr(vp_+(((i)>>2)*4096+((i)&3)*1024+512)); }while(0)
  #define KRD(G,j) do{ if(G){ kload2(kf,kp0+sl_next,j); SBAR(); } }while(0)
  #define STEP(C0,C1,P0,P1,t,GK,GV,GL) do{ SBAR(); \
    const lds_cptr vp_=vp0+sl_prev; \
    VRD(0); SBAR(); float sacc=(P0[0]+P0[1]); \
    GAPA(C0=__builtin_amdgcn_mfma_f32_32x32x16_bf16(kf[0],qr[0],C0,0,0,0), P0[2],P0[3],P0[4],P0[5],     pw0[0]=PKW(P0,0), pw0[1]=PKW(P0,2), pw0); \
    VRD(4); SBAR(); GAPA(C1=__builtin_amdgcn_mfma_f32_32x32x16_bf16(kf[1],qr[0],C1,0,0,0), P0[6],P0[7],P0[8],P0[9],     pw0[2]=PKW(P0,4), pw0[3]=PKW(P0,6), pw0); \
    VRD(1); SBAR(); GAPA(C0=__builtin_amdgcn_mfma_f32_32x32x16_bf16(kf[2],qr[1],C0,0,0,0),   P0[10],P0[11],P0[12],P0[13], pw1[0]=PKW(P0,8), pw1[1]=PKW(P0,10), pw1); \
    VRD(5); SBAR(); GAPA(C1=__builtin_amdgcn_mfma_f32_32x32x16_bf16(kf[3],qr[1],C1,0,0,0),   P0[14],P0[15],P1[0],P1[1],   pw1[2]=PKW(P0,12),pw1[3]=PKW(P0,14), pw1); \
    VRD(2); SBAR(); GAPA(C0=__builtin_amdgcn_mfma_f32_32x32x16_bf16(kf[4],qr[2],C0,0,0,0),   P1[2],P1[3],P1[4],P1[5],     pw2[0]=PKW(P1,0), pw2[1]=PKW(P1,2), pw2); \
    VRD(6); SBAR(); GAPA(C1=__builtin_amdgcn_mfma_f32_32x32x16_bf16(kf[5],qr[2],C1,0,0,0),   P1[6],P1[7],P1[8],P1[9],     pw2[2]=PKW(P1,4), pw2[3]=PKW(P1,6), pw2); \
    VRD(3); SBAR(); GAPA(C0=__builtin_amdgcn_mfma_f32_32x32x16_bf16(kf[6],qr[3],C0,0,0,0),   P1[10],P1[11],P1[12],P1[13], pw3[0]=PKW(P1,8), pw3[1]=PKW(P1,10), pw3); \
    VRD(7); SBAR(); GAPA(C1=__builtin_amdgcn_mfma_f32_32x32x16_bf16(kf[7],qr[3],C1,0,0,0),   P1[14],P1[15],0.f,0.f,       pw3[2]=PKW(P1,12),pw3[3]=PKW(P1,14), pw3); \
    l_reg+=sacc; \
    if(GK){DMA_K((t)+3,sl_cur);} if(GV){DMA_V((t)+1,sl_next);} \
    CMASK(C0,C1,t); \
    SBAR(); \
    GAPB(o[0]=__builtin_amdgcn_mfma_f32_32x32x16_bf16(PAF(0),VFR(0),o[0],0,0,0), C0,0); \
    GAPB(o[1]=__builtin_amdgcn_mfma_f32_32x32x16_bf16(PAF(0),VFR(4),o[1],0,0,0), C0,4); \
    KRD(GL,0); GAPB(o[0]=__builtin_amdgcn_mfma_f32_32x32x16_bf16(PAF(1),VFR(1),o[0],0,0,0), C0,8); \
    KRD(GL,1); GAPB(o[1]=__builtin_amdgcn_mfma_f32_32x32x16_bf16(PAF(1),VFR(5),o[1],0,0,0), C0,12); \
    KRD(GL,2); GAPB(o[0]=__builtin_amdgcn_mfma_f32_32x32x16_bf16(PAF(2),VFR(2),o[0],0,0,0), C1,0); \
    KRD(GL,3); GAPB(o[1]=__builtin_amdgcn_mfma_f32_32x32x16_bf16(PAF(2),VFR(6),o[1],0,0,0), C1,4); \
    GAPB(o[0]=__builtin_amdgcn_mfma_f32_32x32x16_bf16(PAF(3),VFR(3),o[0],0,0,0), C1,8); \
    GAPB(o[1]=__builtin_amdgcn_mfma_f32_32x32x16_bf16(PAF(3),VFR(7),o[1],0,0,0), C1,12); \
    if(GL){ BINIT(P0,P1,(t)+1); } \
    }while(0)
  int t=1;
  #undef CMASK
  #define CMASK(P0,P1,t) do{}while(0)
  for(;t+5<NT;t+=2){
    STEP(pB0,pB1,pA0,pA1,t,true,true,true);     WAIT_BAR(2); RESC(); ROT();
    STEP(pA0,pA1,pB0,pB1,t+1,true,true,true);   WAIT_BAR(2); RESC(); ROT();
  }
  #undef CMASK
  #define CMASK(P0,P1,t) do{int jb_=(t)-(NT-4); if(jb_>=0)cmask(P0,P1,jb_,qrel,hi);}while(0)
  #define ENDW(tt) do{ if((tt)+3<NT){WAIT_BAR(2);} else if((tt)+2<NT){WAIT_BAR(1);} else {WAIT_BAR(0);} }while(0)
  for(;t+2<NT;t+=2){
    STEP(pB0,pB1,pA0,pA1,t,(t+3<NT),(t+1<NT),(t+1<NT));       ENDW(t);   RESC(); ROT();
    STEP(pA0,pA1,pB0,pB1,t+1,(t+4<NT),(t+2<NT),(t+2<NT));     ENDW(t+1); RESC(); ROT();
  }
  STEP(pB0,pB1,pA0,pA1,t,false,true,true);       ENDW(t);   RESC(); ROT();
  STEP(pA0,pA1,pB0,pB1,NT-1,false,false,false); RESC();
  { float sacc=pA0[0]+pA0[1]; _Pragma("unroll") for(int r=2;r<16;++r)sacc+=pA0[r]; _Pragma("unroll") for(int r=0;r<16;++r)sacc+=pA1[r]; l_reg+=sacc;
    pw0=(u32x4){PKW(pA0,0),PKW(pA0,2),PKW(pA0,4),PKW(pA0,6)};pw1=(u32x4){PKW(pA0,8),PKW(pA0,10),PKW(pA0,12),PKW(pA0,14)};pw2=(u32x4){PKW(pA1,0),PKW(pA1,2),PKW(pA1,4),PKW(pA1,6)};pw3=(u32x4){PKW(pA1,8),PKW(pA1,10),PKW(pA1,12),PKW(pA1,14)};
    SBAR(); pv(o,vb0+sl_cur,PAF(0),PAF(1),PAF(2),PAF(3)); }
  #undef PKW
  #undef PAF
  #undef VFR
  #undef PIN
  #undef MX3
  #undef GAPA
  #undef GAPB
  #undef EX
  #undef VRD
  #undef KRD
  #undef STEP
  #undef ENDW
  asm volatile("s_waitcnt lgkmcnt(0)\n\ts_barrier":::"memory");
  int jn=-1;
  if(nqb>=0){ jn=attn_jstart(shm3,nui,nqb*QB,lane);
    const bf16*Kn=K+(kvbase+(long)jn*KVBLK)*DM+h*D+(long)lane*DM+wid*8; const bf16*Vn=V+(kvbase+(long)jn*KVBLK)*DM+h*D+(long)(16*(wid&3)+(lane>>2))*DM+(wid>>2)*32+(lane&3)*8;
    glds16(Kn,(unsigned)__builtin_amdgcn_readfirstlane(kdst)); glds16(Vn,(unsigned)__builtin_amdgcn_readfirstlane(vdst));
    glds16(Kn+(long)KVBLK*DM,(unsigned)__builtin_amdgcn_readfirstlane(kdst+SLOTB)); glds16(Kn+2L*KVBLK*DM,(unsigned)__builtin_amdgcn_readfirstlane(kdst+2*SLOTB)); }
  {auto rr=__builtin_amdgcn_permlane32_swap(__float_as_uint(l_reg),__float_as_uint(l_reg),false,false);l_reg=__uint_as_float(rr[0])+__uint_as_float(rr[1]);}
  if(hi==0)wsf[32+r32]=l_reg;asm volatile("s_waitcnt lgkmcnt(0)":::"memory");
  float rli[16];
  #pragma unroll
  for(int r=0;r<16;++r)rli[r]=__builtin_amdgcn_rcpf(wsf[32+crow(r,hi)]);
  bf16*Ow=O+(rowbase+q0+wid*QBLK)*DM+h*D;
  { bf16*stg=(bf16*)(shm+LDS_OST)+wid*2048;
    #pragma unroll
    for(int r=0;r<16;++r){const int orow=crow(r,hi);
      #pragma unroll
      for(int d0=0;d0<2;++d0)stg[orow*64+d0*32+r32]=__float2bfloat16(o[d0][r]*rli[r]);}
    asm volatile("s_waitcnt lgkmcnt(0)":::"memory");
    #pragma unroll
    for(int i=0;i<4;++i){const int row=i*8+(lane>>3),ch=lane&7; const u32x4 v=*(const u32x4*)(stg+row*64+ch*8); ATTN_STORE16(Ow+(long)row*DM+ch*8,v);} }
  if(nqb<0)asm volatile("s_waitcnt lgkmcnt(0)\n\ts_barrier":::"memory");
  #undef DMA_K
  #undef DMA_V
  #undef CMASK
  #undef START
  #undef RESC
  #undef ROT
  #undef BINIT
  return jn;
}
constexpr int ATTN_LDS_BYTES=LDS_BYTES;
struct AttnTensors { const bf16* Q; const bf16* K; const bf16* V; bf16* O; const float* KN2; const float* QN2; const float* KNM; };
struct AttnUnit { int bh; int qb; };
struct StaticOrder {
  int vcu;
  __device__ __forceinline__ explicit StaticOrder(int grid,int block):vcu((block%8)*(grid/8)+block/8){}
  __device__ __forceinline__ bool next(int i,AttnUnit&u)const{ if(i>=8)return false; const int s=vcu&3, base=8*(i>>1); u.bh=vcu>>2; u.qb=(i&1)?base+7-s:base+s; return true; }
  __device__ __forceinline__ void a_ready(const AttnUnit&)const{}
  __device__ __forceinline__ void done(const AttnUnit&)const{}
};
template<class Sched,int THRL=8> __device__ __forceinline__ void attn_phase(char*lds,const AttnTensors&T,const float*bias,const Sched&S){
  AttnUnit u;
  if(!S.next(0,u))return;
  typedef __attribute__((address_space(3))) unsigned lds_u32;
  const int tid=::launder((int)threadIdx.x);
  { const f32x4_t*src=(const f32x4_t*)(bias+(long)u.bh*KVR); f32x4_t*dst=(f32x4_t*)(lds+LDS_BIAS);
    for(int i=tid;i<KVR/4;i+=NW*64)dst[i]=src[i];
    if(tid<140)((lds_u32*)((lds_cptr)lds+LDS_KN))[tid]=0u;
    __syncthreads(); }
  { lds_u32*KNu=(lds_u32*)((lds_cptr)lds+LDS_KN),*QMu=(lds_u32*)((lds_cptr)lds+LDS_QM);
    const int bb_=u.bh/NHEAD, hh_=u.bh%NHEAD;
    for(int row=tid;row<KVR;row+=NW*64){ float ss;
      if(row<64){ ss=0.f; if(row<16){ const f32x4_t q4=*(const f32x4_t*)(T.KNM+(row*NHEAD+hh_)*4); ss=(q4[0]+q4[1])+(q4[2]+q4[3]); } }
      else { const f32x2_t h2=*(const f32x2_t*)(T.KN2+((long)hh_*((long)::NB*KVR)+(long)bb_*KVR+row)*2); ss=h2[0]+h2[1]; }
      __hip_atomic_fetch_max(KNu+(row>>6),__float_as_uint(ss),__ATOMIC_RELAXED,__HIP_MEMORY_SCOPE_WORKGROUP); }
    for(int r=tid;r<8*QB;r+=NW*64){ AttnUnit v; if(!S.next(r>>8,v))break;
      const f32x2_t h2=*(const f32x2_t*)(T.QN2+((long)(v.bh%NHEAD)*(long)::M+(long)(v.bh/NHEAD)*SEQ+(long)v.qb*QB+(r&255))*2); const float ss=h2[0]+h2[1];
      __hip_atomic_fetch_max(QMu+(r>>8),__float_as_uint(ss),__ATOMIC_RELAXED,__HIP_MEMORY_SCOPE_WORKGROUP); }
    __syncthreads(); }
  int jp=-1;
  for(int i=0;S.next(i,u);++i){ AttnUnit un; const bool hn=S.next(i+1,un); S.a_ready(u); jp=attn_unit<THRL>(i,u.bh/NHEAD,u.bh%NHEAD,u.qb,T.Q,T.K,T.V,T.O,lds,jp,i+1,hn?un.qb:-1); S.done(u); }
}
#undef SBAR
#undef WAIT_BAR
}
constexpr int NWAVES = 8;
constexpr int RING_OFF = 0, RING_BYTES = 131072;
constexpr int LDSCTL_OFF = RING_BYTES, MISC_OFF = LDSCTL_OFF + 320;
constexpr int LDS_BYTES = 163840;
constexpr int CW_TMO = 0, CW_CODE = 1;
constexpr int CW_BAR = 4096;
#define GAS __attribute__((address_space(1)))
#define LAS __attribute__((address_space(3)))
typedef unsigned v4u __attribute__((ext_vector_type(4)));
typedef GAS unsigned gu32;
#define RLX_AGENT __ATOMIC_RELAXED, __HIP_MEMORY_SCOPE_AGENT
#define LDS_WAIT() asm volatile("s_waitcnt lgkmcnt(0)" ::: "memory")
#define VM_WAIT() asm volatile("s_waitcnt vmcnt(0)" ::: "memory")
#define XB_TMO      128
#define XB_XCNT(j)  (256  + 64 * (j))
#define XB_XSUB(j)  (1280 + 64 * (j))
#define XB_XGEN(j)  (2304 + 64 * (j))
#define XB_TOP      3328
#define XB_TOPGEN   3392
#define XCD_BAR_WORDS 3456
static_assert((size_t)(CW_BAR + XCD_BAR_WORDS) * 4 <= CTL_ZERO_BYTES && (size_t)(CW_CNT + 32) * 4 <= CTL_ZERO_BYTES, "everything that must start at zero lies inside the per-launch memset");
#define XB_SPIN_CAP (1u << 18)

__device__ __forceinline__ unsigned xb_ld(unsigned* p)              { return __hip_atomic_load(p, __ATOMIC_RELAXED, __HIP_MEMORY_SCOPE_AGENT); }
__device__ __forceinline__ unsigned xb_add(unsigned* p, unsigned v) { return __hip_atomic_fetch_add(p, v, __ATOMIC_RELAXED, __HIP_MEMORY_SCOPE_AGENT); }
__device__ __forceinline__ unsigned xb_xcc_id() { return (unsigned)__builtin_amdgcn_s_getreg((3 << 11) | 20) & 0xFu; }
#define XB_SPIN(cond, bar) do { unsigned _sp = 0; while (cond) { __builtin_amdgcn_s_sleep(1); \
    if ((++_sp & 255u) == 0u) { if (xb_ld(&(bar)[XB_TMO])) break; if (_sp > XB_SPIN_CAP) { atomicAdd(&(bar)[XB_TMO], 1u); break; } } } } while (0)

struct XcdBarrier {
    unsigned* bar; unsigned x;
    volatile LAS unsigned* st;
};

__device__ __forceinline__ XcdBarrier xcd_barrier_post(unsigned* bar, volatile LAS unsigned* st) {
    XcdBarrier b; b.bar = bar; b.x = xb_xcc_id(); b.st = st;
    if (threadIdx.x == 0) (void)xb_add(&bar[XB_XCNT(b.x)], 1u);
    return b;
}
__device__ __forceinline__ void xcd_barrier_complete(unsigned* bar, unsigned x, unsigned& nloc, unsigned& nx) {
    const unsigned G = gridDim.x * gridDim.y * gridDim.z;
    unsigned sum, cnt, mine, sp = 0u;
    for (;;) {
        sum = 0u; cnt = 0u; mine = 0u;
#pragma unroll
        for (unsigned j = 0; j < 16; ++j) { const unsigned c = xb_ld(&bar[XB_XCNT(j)]); sum += c; cnt += (c > 0u) ? 1u : 0u; mine = (j == x) ? c : mine; }
        if (sum == G) break;
        __builtin_amdgcn_s_sleep(1);
        if ((++sp & 255u) == 0u) { if (xb_ld(&bar[XB_TMO])) break; if (sp > XB_SPIN_CAP) { atomicAdd(&bar[XB_TMO], 1u); break; } }
    }
    nloc = mine > 0u ? mine : 1u; nx = cnt > 0u ? cnt : 1u;
}

__device__ __forceinline__ void xcd_barrier(const XcdBarrier& b) {
    asm volatile("s_waitcnt vmcnt(0)" ::: "memory");
    __syncthreads();
    if (threadIdx.x == 0) {
        unsigned* bar = b.bar;
        __builtin_amdgcn_s_waitcnt(0);
        unsigned nloc = b.st[0], nx = b.st[1];
        if (nloc == 0u) { xcd_barrier_complete(bar, b.x, nloc, nx); b.st[0] = nloc; b.st[1] = nx; }
        const unsigned old = xb_add(&bar[XB_XSUB(b.x)], 1u);
        const unsigned gen = old / nloc;
        if (old + 1u == (gen + 1u) * nloc) {
            __builtin_amdgcn_fence(__ATOMIC_RELEASE, "agent");
            asm volatile("s_waitcnt vmcnt(0)" ::: "memory");
            const unsigned og = xb_add(&bar[XB_TOP], 1u);
            const unsigned tg = og / nx;
            if (og + 1u == (tg + 1u) * nx) xb_add(&bar[XB_TOPGEN], 1u);
            else XB_SPIN(xb_ld(&bar[XB_TOPGEN]) == tg, bar);
            __builtin_amdgcn_fence(__ATOMIC_ACQUIRE, "agent");
            xb_add(&bar[XB_XGEN(b.x)], 1u);
            asm volatile("s_waitcnt vmcnt(0)" ::: "memory");
        } else {
            XB_SPIN(xb_ld(&bar[XB_XGEN(b.x)]) == gen, bar);
            __builtin_amdgcn_fence(__ATOMIC_ACQUIRE, "agent");
            asm volatile("s_waitcnt vmcnt(0)" ::: "memory");
        }
    }
    __syncthreads();
}

struct Frame {
    LAS unsigned char* lds;
    volatile LAS unsigned* MISC;
    gu32* ctl;
    int tid, lane, wave, vcu, G;
};
struct Args { const float* in[20]; float* out; unsigned char* ws; int ph_lo, ph_hi; };
struct KA {
    unsigned long long base;
    __device__ __forceinline__ const float* in(int i) const { return (const float*)(const __attribute__((address_space(1))) float*)((const __attribute__((address_space(4))) unsigned long long*)base)[i]; }
    __device__ __forceinline__ float* out() const { return (float*)(__attribute__((address_space(1))) float*)((const __attribute__((address_space(4))) unsigned long long*)base)[20]; }
    __device__ __forceinline__ unsigned char* ws() const { return (unsigned char*)(__attribute__((address_space(1))) unsigned char*)((const __attribute__((address_space(4))) unsigned long long*)base)[21]; }
};
__device__ __forceinline__ KA kargs() {
#if defined(__HIP_DEVICE_COMPILE__)
    unsigned long long p = (unsigned long long)__builtin_amdgcn_kernarg_segment_ptr(); asm volatile("" : "+s"(p));
    return KA{p};
#else
    return KA{0ull};
#endif
}

struct P0Item { const float* W; size_t ldw; bf16_t* WT; };
__device__ __forceinline__ void p0_item_load(const P0Item& it, int lane, f32x4 (&r)[8]) {
#pragma unroll
    for (int i = 0; i < 8; ++i) r[i] = __builtin_nontemporal_load((const f32x4*)(it.W + (size_t)(8 * i + (lane >> 3)) * it.ldw + 4 * (lane & 7)));
}
__device__ __forceinline__ void p0_item_store(const P0Item& it, int K, LAS float* scr, int lane, const f32x4 (&r)[8]) {
#pragma unroll
    for (int i = 0; i < 8; ++i) { LAS float* d = scr + (8 * i + (lane >> 3)) * 33 + 4 * (lane & 7); d[0] = r[i].x; d[1] = r[i].y; d[2] = r[i].z; d[3] = r[i].w; }
    LDS_WAIT(); asm volatile("" ::: "memory");
    const int c = lane & 7;
#pragma unroll
    for (int j = 0; j < 4; ++j) { const int n = (lane >> 3) + 8 * j; const LAS float* s = scr + (8 * c) * 33 + n;
        v4u o; o.x = pk2(s[0 * 33], s[1 * 33]); o.y = pk2(s[2 * 33], s[3 * 33]); o.z = pk2(s[4 * 33], s[5 * 33]); o.w = pk2(s[6 * 33], s[7 * 33]);
        *(GAS v4u*)(it.WT + (size_t)n * K + 8 * c) = o; }
    LDS_WAIT(); asm volatile("" ::: "memory");
}
__device__ __forceinline__ int glu_src_col(int r) { return ((r >> 7) & 1) * 1024 + (r >> 8) * 128 + (r & 127); }

__device__ __forceinline__ void p0_rows_wg(Frame& F, const KA& A, unsigned char* ws) {
    const int lane = F.lane, wave = F.wave, fr = lane & 15, fq = lane >> 4, c0 = wave * 128 + 8 * fq;
    LAS float* xs = (LAS float*)(F.lds + RING_OFF);
    LAS float* pacc = (LAS float*)(F.lds + RING_OFF + 4096);
    f32x4 gv[4][2]; u32x4 wh[4], wl[4];
    { const float* g = A.in(2); const float* wp = A.in(3) + (size_t)c0 * IN_COLS + OFF_F + fr;
#pragma unroll
      for (int s_ = 0; s_ < 4; ++s_) { gv[s_][0] = *(const f32x4*)(g + c0 + 32 * s_); gv[s_][1] = *(const f32x4*)(g + c0 + 32 * s_ + 4);
        float wv[8];
#pragma unroll
        for (int j = 0; j < 8; ++j) wv[j] = wp[(size_t)(32 * s_ + j) * IN_COLS];
        u32x4 h_; h_.x = pk2(wv[0], wv[1]); h_.y = pk2(wv[2], wv[3]); h_.z = pk2(wv[4], wv[5]); h_.w = pk2(wv[6], wv[7]);
        u32x4 l_;
        l_.x = pk2(wv[0] - __builtin_bit_cast(float, h_.x << 16), wv[1] - __builtin_bit_cast(float, h_.x & 0xffff0000u)); l_.y = pk2(wv[2] - __builtin_bit_cast(float, h_.y << 16), wv[3] - __builtin_bit_cast(float, h_.y & 0xffff0000u));
        l_.z = pk2(wv[4] - __builtin_bit_cast(float, h_.z << 16), wv[5] - __builtin_bit_cast(float, h_.z & 0xffff0000u)); l_.w = pk2(wv[6] - __builtin_bit_cast(float, h_.w << 16), wv[7] - __builtin_bit_cast(float, h_.w & 0xffff0000u));
        wh[s_] = h_; wl[s_] = l_; } }
    const float bbh = A.in(4)[OFF_F + 4 * (wave & 3) + (lane & 3)];
    constexpr int NGRP = M / 16 + 1;
    int grp = F.vcu, par = 0; f32x4 h[4][2];
    { const float* src = (grp < M / 16 ? A.in(0) + (size_t)grp * 16 * D : A.in(1)) + (size_t)fr * D + c0;
#pragma unroll
      for (int s_ = 0; s_ < 4; ++s_) { h[s_][0] = *(const f32x4*)(src + 32 * s_); h[s_][1] = *(const f32x4*)(src + 32 * s_ + 4); }
#pragma unroll
      for (int s_ = 0; s_ < 4; ++s_) asm volatile("" : "+v"(h[s_][0]), "+v"(h[s_][1])); }
    for (; grp < NGRP; grp += F.G, par ^= 1) {
        const int nx = grp + F.G < NGRP ? grp + F.G : grp; f32x4 hn[4][2];
        { const float* src = (nx < M / 16 ? A.in(0) + (size_t)nx * 16 * D : A.in(1)) + (size_t)fr * D + c0;
#pragma unroll
            for (int s_ = 0; s_ < 4; ++s_) { hn[s_][0] = *(const f32x4*)(src + 32 * s_); hn[s_][1] = *(const f32x4*)(src + 32 * s_ + 4); } }
        float ss = 0.f, amax = 0.f; f32x4 v[4][2];
#pragma unroll
        for (int s_ = 0; s_ < 4; ++s_)
#pragma unroll
            for (int t = 0; t < 2; ++t) { const f32x4 x_ = h[s_][t]; ss += (x_.x * x_.x + x_.y * x_.y) + (x_.z * x_.z + x_.w * x_.w);
                v[s_][t] = x_ * gv[s_][t]; const f32x4 a_ = __builtin_elementwise_abs(v[s_][t]); amax = fmaxf(amax, fmaxf(fmaxf(a_.x, a_.y), fmaxf(a_.z, a_.w))); }
        ss += __shfl_xor(ss, 16); ss += __shfl_xor(ss, 32);
        amax = fmaxf(amax, __shfl_xor(amax, 16)); amax = fmaxf(amax, __shfl_xor(amax, 32));
        LAS float* xp = xs + par * 256;
        if (fq == 0) { xp[(wave * 16 + fr) * 2] = ss; xp[(wave * 16 + fr) * 2 + 1] = amax; }
        __syncthreads();
        float sst = 0.f, amt = 0.f;
#pragma unroll
        for (int w2 = 0; w2 < NWAVES; ++w2) { sst += xp[(w2 * 16 + fr) * 2]; amt = fmaxf(amt, xp[(w2 * 16 + fr) * 2 + 1]); }
        const float qinv = amt > 0.f ? 127.f / amt : 0.f;
        const bool is_x = grp < M / 16;
        unsigned char* op = (is_x ? ws + WS_XN + (size_t)grp * 16 * D : ws + WS_XNM) + (size_t)fr * D + c0;
        pg8::f32x4 acc = {0.f, 0.f, 0.f, 0.f};
        u32x2 q8s[4];
#pragma unroll
        for (int s_ = 0; s_ < 4; ++s_) { const f32x4 v0 = v[s_][0], v1 = v[s_][1];
            u32x4 hi; hi.x = pk2(v0.x, v0.y); hi.y = pk2(v0.z, v0.w); hi.z = pk2(v1.x, v1.y); hi.w = pk2(v1.z, v1.w);
            { const f32x4 q0 = v0 * qinv, q1 = v1 * qinv; u32x2 q8; q8.x = pk4_i8(q0.x, q0.y, q0.z, q0.w); q8.y = pk4_i8(q1.x, q1.y, q1.z, q1.w); q8s[s_] = q8; }
            u32x4 lo;
            lo.x = pk2(v0.x - __builtin_bit_cast(float, hi.x << 16), v0.y - __builtin_bit_cast(float, hi.x & 0xffff0000u)); lo.y = pk2(v0.z - __builtin_bit_cast(float, hi.y << 16), v0.w - __builtin_bit_cast(float, hi.y & 0xffff0000u));
            lo.z = pk2(v1.x - __builtin_bit_cast(float, hi.z << 16), v1.y - __builtin_bit_cast(float, hi.z & 0xffff0000u)); lo.w = pk2(v1.z - __builtin_bit_cast(float, hi.w << 16), v1.w - __builtin_bit_cast(float, hi.w & 0xffff0000u));
            const bf16x8 ah = __builtin_bit_cast(bf16x8, hi), al = __builtin_bit_cast(bf16x8, lo), bh = __builtin_bit_cast(bf16x8, wh[s_]), bl = __builtin_bit_cast(bf16x8, wl[s_]);
            acc = __builtin_amdgcn_mfma_f32_16x16x32_bf16(ah, bh, acc, 0, 0, 0); acc = __builtin_amdgcn_mfma_f32_16x16x32_bf16(al, bh, acc, 0, 0, 0); acc = __builtin_amdgcn_mfma_f32_16x16x32_bf16(ah, bl, acc, 0, 0, 0); }
#pragma unroll
        for (int r = 0; r < 4; ++r) pacc[(wave * 4 + r) * 64 + lane] = acc[r];
#pragma unroll
        for (int s_ = 0; s_ < 4; ++s_) asm volatile("" : "+v"(hn[s_][0]), "+v"(hn[s_][1]));
#pragma unroll
        for (int s_ = 0; s_ < 4; ++s_) *(u32x2*)(op + 32 * s_) = q8s[s_];
        __syncthreads();
        if (wave < 4) {
            const int row = lane >> 2, hd = 4 * wave + (lane & 3); float z = 0.f, ssr = 0.f;
#pragma unroll
            for (int w2 = 0; w2 < NWAVES; ++w2) { z += pacc[(w2 * 4 + (row & 3)) * 64 + (row >> 2) * 16 + hd]; ssr += xp[(w2 * 16 + row) * 2]; }
            z = z * rsqrtf(ssr * (1.f / D) + RMS_EPS) + bbh;
            float lf = fminf(z, 0.f) - log1pf(expf(-fabsf(z)));
            (is_x ? (float*)(ws + WS_LOGF) + (size_t)grp * 256 : (float*)(ws + WS_LOGFM))[row * 16 + hd] = lf;
            lf += __shfl_xor(lf, 4); lf += __shfl_xor(lf, 8); lf += __shfl_xor(lf, 16); lf += __shfl_xor(lf, 32);
            if (is_x && lane < 4) ((float*)(ws + WS_GSUM))[grp * 16 + hd] = lf;
        } else if (wave == 4 && fq == 0) {
            ((float*)(ws + WS_RSX) + (is_x ? grp * 16 : M))[fr] = rsqrtf(sst * (1.f / D) + RMS_EPS) * amt * (1.f / 127.f);
        }
#pragma unroll
        for (int s_ = 0; s_ < 4; ++s_) { h[s_][0] = hn[s_][0]; h[s_][1] = hn[s_][1]; }
    }
    __syncthreads();
}

constexpr int I_SQ = 16 * 32, N_ITEMS = 3 * I_SQ, N_STRIPS = NE * 64, N_STRIPS_IN = 224, N_STRIPS_DN = NE * 32;
__device__ __forceinline__ P0Item p0_item(const KA& A, unsigned char* ws, int it) {
    int r = it;
    if (r < 3 * I_SQ) { const int w = r / I_SQ, rr = r % I_SQ, kb = rr / 32, nb = rr % 32; const float* src = w == 0 ? A.in(9) : w == 1 ? A.in(10) : A.in(11); bf16_t* dst = (bf16_t*)(ws + (w == 0 ? WS_WCO_T : w == 1 ? WS_WAO_T : WS_WMIX_T));
        return P0Item{src + (size_t)(64 * kb) * D + 32 * nb, (size_t)D, dst + (size_t)(32 * nb) * D + 64 * kb}; }
    return P0Item{nullptr, 0, nullptr};
}
struct P0Strip { const float* W0; size_t ldw; unsigned char* Wq; float* SB; };
__device__ __forceinline__ void p0_strip_load(const P0Strip& st, int wave, int lane, f32x4 (&r0)[8], f32x4 (&r1)[8]) {
    const P0Item i0{st.W0 + (size_t)(64 * (2 * wave)) * st.ldw, st.ldw, nullptr}, i1{st.W0 + (size_t)(64 * (2 * wave + 1)) * st.ldw, st.ldw, nullptr}; p0_item_load(i0, lane, r0); p0_item_load(i1, lane, r1);
}
__device__ __forceinline__ void p0_strip_finish(const P0Strip& st, LAS unsigned char* ring, int wave, int lane, int parity, const f32x4 (&r0)[8], const f32x4 (&r1)[8]) {
    LAS float* scr = (LAS float*)(ring + wave * 16384);
    f32x4 mx = {0.f, 0.f, 0.f, 0.f};
#pragma unroll
    for (int i = 0; i < 8; ++i) mx = __builtin_elementwise_max(mx, __builtin_elementwise_max(__builtin_elementwise_abs(r0[i]), __builtin_elementwise_abs(r1[i])));
#pragma unroll
    for (int o = 8; o < 64; o <<= 1) { f32x4 t; t.x = __shfl_xor(mx.x, o); t.y = __shfl_xor(mx.y, o); t.z = __shfl_xor(mx.z, o); t.w = __shfl_xor(mx.w, o); mx = __builtin_elementwise_max(mx, t); }
    const int c = lane & 7, xoff = 8448 + 64 + parity * 128;
    if (lane < 8) *(LAS f32x4*)(ring + wave * 16384 + xoff + 16 * lane) = mx;
    __syncthreads();
#pragma unroll
    for (int w2 = 0; w2 < NWAVES; ++w2) mx = __builtin_elementwise_max(mx, *(const LAS f32x4*)(ring + w2 * 16384 + xoff + 16 * c));
    f32x4 inv; inv.x = mx.x > 0.f ? 127.f / mx.x : 0.f; inv.y = mx.y > 0.f ? 127.f / mx.y : 0.f; inv.z = mx.z > 0.f ? 127.f / mx.z : 0.f; inv.w = mx.w > 0.f ? 127.f / mx.w : 0.f;
    if (wave == 0 && lane < 8) *(f32x4*)(st.SB + 4 * lane) = mx * (1.f / 127.f);
#pragma unroll
    for (int half = 0; half < 2; ++half) { const int kb = 2 * wave + half;
#pragma unroll
        for (int i = 0; i < 8; ++i) { const f32x4 q = (half ? r1[i] : r0[i]) * inv; LAS float* d = scr + (8 * i + (lane >> 3)) * 33 + 4 * c; d[0] = q.x; d[1] = q.y; d[2] = q.z; d[3] = q.w; }
        LDS_WAIT(); asm volatile("" ::: "memory");
#pragma unroll
        for (int j = 0; j < 4; ++j) { const int n = (lane >> 3) + 8 * j; const LAS float* sp = scr + (8 * c) * 33 + n;
            u32x2 o; o.x = pk4_i8(sp[0 * 33], sp[1 * 33], sp[2 * 33], sp[3 * 33]); o.y = pk4_i8(sp[4 * 33], sp[5 * 33], sp[6 * 33], sp[7 * 33]);
            *(GAS u32x2*)(st.Wq + (size_t)n * 1024 + 64 * kb + 8 * c) = o; }
        LDS_WAIT(); asm volatile("" ::: "memory");
    }
}
__device__ __forceinline__ bool p0_strip_desc(const KA& A, unsigned char* ws, int vcu, int G, int s, P0Strip& st) {
    const int n_in = (vcu < N_STRIPS_IN) ? (N_STRIPS_IN - vcu + G - 1) / G : 0, n_gu = (vcu < N_STRIPS) ? (N_STRIPS - vcu + G - 1) / G : 0;
    if (s < n_in) { const int drow = 32 * (vcu + s * G), scol = drow < 2048 ? glu_src_col(drow) : (drow < 5120 ? drow : (((drow - 5120) >> 7) & 1 ? OFF_GB : OFF_GA) + ((drow - 5120) >> 8) * 128 + ((drow - 5120) & 127));
        st = P0Strip{A.in(3) + scol, (size_t)IN_COLS, ws + WS_WIN_T + (size_t)drow * 1024, (float*)(ws + WS_SBIN) + drow}; return true; }
    s -= n_in;
    if (s < n_gu) { const int gi = (N_STRIPS % (8 * G) == 0) ? ((s >> 3) * G + vcu) * 8 + (s & 7) : vcu + s * G, e = gi >> 6, drow = 32 * (gi & 63);
        st = P0Strip{A.in(15) + (size_t)e * D * 2048 + glu_src_col(drow), (size_t)2048, ws + WS_WGU_T + ((size_t)e * 2048 + drow) * 1024, (float*)(ws + WS_SBGU) + e * 2048 + drow}; return true; }
    s -= n_gu;
    const int gi = (N_STRIPS_DN % (4 * G) == 0) ? ((s >> 2) * G + vcu) * 4 + (s & 3) : vcu + s * G; if (gi >= N_STRIPS_DN) return false;
    const int e = gi >> 5, drow = 32 * (gi & 31);
    st = P0Strip{A.in(17) + (size_t)e * D * D + drow, (size_t)D, ws + WS_WDN_T + ((size_t)e * 1024 + drow) * 1024, (float*)(ws + WS_SBDN) + e * 1024 + drow}; return true;
}
__device__ __forceinline__ void p0_prologue(Frame& F, const KA& A) {
    unsigned char* ws = A.ws();
    LAS float* scr = (LAS float*)(F.lds + RING_OFF + F.wave * 16384);
    const int gw = F.vcu * NWAVES + F.wave, NGW = F.G * NWAVES;
    {
        int it = gw; f32x4 r[8]; P0Item cur{nullptr, 0, nullptr};
        if (it < N_ITEMS) { cur = p0_item(A, ws, it); p0_item_load(cur, F.lane, r); }
        while (it < N_ITEMS) {
            const int nx = it + NGW; f32x4 rn[8]; P0Item nxt{nullptr, 0, nullptr};
            if (nx < N_ITEMS) { nxt = p0_item(A, ws, nx); p0_item_load(nxt, F.lane, rn); }
            p0_item_store(cur, D, scr, F.lane, r);
#pragma unroll
            for (int i = 0; i < 8; ++i) r[i] = rn[i];
            cur = nxt; it = nx;
        }
    }
    {
        P0Strip cur{nullptr, 0, nullptr, nullptr}, nxt{nullptr, 0, nullptr, nullptr}; f32x4 r0[8], r1[8];
        bool have = p0_strip_desc(A, ws, F.vcu, F.G, 0, cur);
        if (have) p0_strip_load(cur, F.wave, F.lane, r0, r1);
        for (int si = 0; have; ++si) {
#pragma unroll
            for (int i = 0; i < 8; ++i) asm volatile("" : "+v"(r0[i]), "+v"(r1[i]));
            f32x4 n0[8], n1[8];
            const bool hn = p0_strip_desc(A, ws, F.vcu, F.G, si + 1, nxt);
            if (hn) p0_strip_load(nxt, F.wave, F.lane, n0, n1);
            p0_strip_finish(cur, F.lds + RING_OFF, F.wave, F.lane, si & 1, r0, r1);
#pragma unroll
            for (int i = 0; i < 8; ++i) { r0[i] = n0[i]; r1[i] = n1[i]; }
            cur = nxt; have = hn;
        }
        __syncthreads();
    }
    p0_rows_wg(F, A, ws);
    for (int i = gw * 64 + F.lane; i < NE * D; i += NGW * 64) {
        const int e = i / D, k = i % D; const float w = A.in(13)[(size_t)k * NE + e]; const unsigned hi = f2bf(w);
        ((bf16_t*)(ws + WS_WR_T))[i] = (bf16_t)hi; ((bf16_t*)(ws + WS_WR_T))[NE * D + i] = (bf16_t)f2bf(w - __builtin_bit_cast(float, hi << 16));
    }
    for (int r = gw; r < 2 * NB * 48; r += NGW) {
        const int kv = r / (NB * 48), rr = r % (NB * 48), b = rr / 48, row = 16 + rr % 48;
        bf16_t* p = (bf16_t*)(ws + (kv ? WS_V : WS_K)) + ((size_t)b * KVROWS + row) * D + 16 * F.lane;
        const v4u z = {0u, 0u, 0u, 0u}; *(GAS v4u*)p = z; *(GAS v4u*)(p + 8) = z;
    }
}

__device__ __forceinline__ void p1_scan(Frame& F, const KA& A) {
    if (F.vcu >= NB * 64) return;
    const int b = F.vcu >> 6, seg = F.vcu & 63, t = F.tid, head = t & 15, pc = t >> 4;
    const float* LOGF = (const float*)(A.ws() + WS_LOGF); const float* LOGFm = (const float*)(A.ws() + WS_LOGFM); const float* GSUM = (const float*)(A.ws() + WS_GSUM);
    float* outb = (float*)(A.ws() + WS_BIAS) + (size_t)(b * NH + head) * KVROWS;
    LAS float* part = (LAS float*)(F.lds + RING_OFF);
    const float* src = LOGF + ((size_t)b * SEQ + seg * 128 + 4 * pc) * 16 + head;
    const float v0 = src[0], v1 = src[16], v2 = src[32], v3 = src[48];
    float pre = 0.f;
    { float gq[16];
#pragma unroll
      for (int i = 0; i < 16; ++i) { const int j = pc + 32 * i; gq[i] = j < seg * 8 ? GSUM[(size_t)(b * (SEQ / 16) + j) * 16 + head] : 0.f; }
#pragma unroll
      for (int i = 0; i < 16; ++i) pre += gq[i]; }
    float cm = 0.f;
    { float mq[NMETA];
#pragma unroll
      for (int j = 0; j < NMETA; ++j) mq[j] = LOGFm[j * 16 + head];
#pragma unroll
      for (int j = 0; j < NMETA; ++j) { cm += mq[j]; if (seg == 0 && pc == 0) outb[j] = -cm * LOG2E; } }
    if (seg == 0) {
#pragma unroll
      for (int i2 = 0; i2 < 2; ++i2) { const int idx = t + 512 * i2; if (idx < NH * 48) ((float*)(A.ws() + WS_BIAS) + (size_t)(b * NH + idx / 48) * KVROWS)[16 + idx % 48] = NEG_BIG; } }
    pre += __shfl_xor(pre, 16); pre += __shfl_xor(pre, 32);
    const float c0 = v0, c1 = c0 + v1, c2 = c1 + v2, c3 = c2 + v3;
    part[pc * 16 + head] = c3; if (F.lane < 16) part[512 + F.wave * 16 + head] = pre;
    __syncthreads();
    float base = cm;
#pragma unroll
    for (int w = 0; w < NWAVES; ++w) base += part[512 + w * 16 + head];
    for (int c = 0; c < pc; ++c) base += part[c * 16 + head];
    { f32x4 o; o.x = -(base + c0) * LOG2E; o.y = -(base + c1) * LOG2E; o.z = -(base + c2) * LOG2E; o.w = -(base + c3) * LOG2E; *(f32x4*)(outb + 64 + seg * 128 + 4 * pc) = o; }
    __syncthreads();
}
__device__ __forceinline__ void p1_meta(Frame& F, const KA& A) {
    if (F.vcu >= 192) return;
    const int lane = F.lane, fr = lane & 15, fq = lane >> 4;
    const unsigned char* XNm = A.ws() + WS_XNM; const unsigned char* Wq = A.ws() + WS_WIN_T; const float* b_in = A.in(4); const float* SB = (const float*)(A.ws() + WS_SBIN);
    const int kind = F.vcu >> 6, c = F.vcu & 63;
    const int ch0 = 16 * c;
    const int rowA = kind == 0 ? 256 * (ch0 >> 7) + (ch0 & 127) : (kind == 1 ? OFF_K : OFF_V) + ch0;
    const unsigned char* ap = XNm + (size_t)fr * D + 16 * fq; const unsigned char* bp = Wq + (size_t)(rowA + fr) * D + 16 * fq;
    pg8::i32x4 acc0 = {0, 0, 0, 0}, acc1 = {0, 0, 0, 0};
#pragma unroll
    for (int k0 = 0; k0 < D; k0 += 64) {
        const pg8::i32x4 af = *(const pg8::i32x4*)(ap + k0), bf = *(const pg8::i32x4*)(bp + k0);
        acc0 = __builtin_amdgcn_mfma_i32_16x16x64_i8(af, bf, acc0, 0, 0, 0);
        if (kind == 0) { const pg8::i32x4 bg = *(const pg8::i32x4*)(bp + (size_t)128 * D + k0); acc1 = __builtin_amdgcn_mfma_i32_16x16x64_i8(af, bg, acc1, 0, 0, 0); }
    }
    const int ch = ch0 + fr;
    const float* rsx = (const float*)(A.ws() + WS_RSX) + M + 4 * fq;
    const float s0 = SB[rowA + fr], s1 = kind == 0 ? SB[rowA + 128 + fr] : 0.f;
    float v0[4], v1[4];
#pragma unroll
    for (int r = 0; r < 4; ++r) { v0[r] = (float)acc0[r] * (rsx[r] * s0); v1[r] = (float)acc1[r] * (rsx[r] * s1); }
    if (kind == 0) {
        bf16_t* GLUm = (bf16_t*)(A.ws() + WS_GLUM); const float ba = b_in[ch], bb = b_in[1024 + ch];
#pragma unroll
        for (int r = 0; r < 4; ++r) { const float z1 = v0[r] + ba, z2 = v1[r] + bb; GLUm[(size_t)(4 * fq + r) * D + ch] = (bf16_t)f2bf(z1 * (1.f / (1.f + __expf(-z2)))); }
    } else {
        bf16_t* dst = (bf16_t*)(A.ws() + (kind == 1 ? WS_K : WS_V)); const float bb = b_in[(kind == 1 ? OFF_K : OFF_V) + ch];
#pragma unroll
        for (int r = 0; r < 4; ++r) { const bf16_t o = (bf16_t)f2bf(v0[r] + bb);
            if (kind == 1) { float ss = bf2f(o) * bf2f(o);
                ss += __shfl_xor(ss, 1); ss += __shfl_xor(ss, 2); ss += __shfl_xor(ss, 4); ss += __shfl_xor(ss, 8);
                if (fr == 0) ((float*)(A.ws() + WS_KNM))[((4 * fq + r) * NH + (c >> 2)) * 4 + (c & 3)] = ss; }
#pragma unroll
            for (int b2 = 0; b2 < NB; ++b2) dst[((size_t)b2 * KVROWS + 4 * fq + r) * D + ch] = o; }
    }
}

typedef float f32x2_ __attribute__((ext_vector_type(2)));
__device__ __forceinline__ f32x2_ bfpair(unsigned u) { f32x2_ r; r.x = __builtin_bit_cast(float, u << 16); r.y = __builtin_bit_cast(float, u & 0xffff0000u); return r; }
__device__ __forceinline__ float wave_sum16(float (&v)[16], int lane) {
    const bool b5 = lane & 32, b4 = lane & 16, b3 = lane & 8, b2 = lane & 4;
    float a[8];
#pragma unroll
    for (int i = 0; i < 8; ++i) { const float keep = b5 ? v[i + 8] : v[i], give = b5 ? v[i] : v[i + 8]; a[i] = keep + __shfl_xor(give, 32); }
    float c[4];
#pragma unroll
    for (int i = 0; i < 4; ++i) { const float keep = b4 ? a[i + 4] : a[i], give = b4 ? a[i] : a[i + 4]; c[i] = keep + __shfl_xor(give, 16); }
    float d[2];
#pragma unroll
    for (int i = 0; i < 2; ++i) { const float keep = b3 ? c[i + 2] : c[i], give = b3 ? c[i] : c[i + 2]; d[i] = keep + __shfl_xor(give, 8); }
    float e = (b2 ? d[1] : d[0]) + __shfl_xor(b2 ? d[0] : d[1], 4);
    e += __shfl_xor(e, 1); e += __shfl_xor(e, 2);
    return e;
}
__device__ __forceinline__ void p2_conv(Frame& F, const KA& A) {
    const int tid = launder((int)threadIdx.x), c0 = 2 * tid, lane = tid & 63, wave = __builtin_amdgcn_readfirstlane(tid >> 6);
    const bf16_t* GLU = (const bf16_t*)(A.ws() + WS_GLU); const bf16_t* GLUm = (const bf16_t*)(A.ws() + WS_GLUM); bf16_t* U = (bf16_t*)(A.ws() + WS_U);
    LAS float* red = (LAS float*)(F.lds + RING_OFF);
    f32x2_ cw[CONVW];
#pragma unroll
    for (int j = 0; j < CONVW; ++j) cw[j] = *(const f32x2_*)(A.in(5) + (size_t)j * D + c0);
    const f32x2_ cb = *(const f32x2_*)(A.in(6) + c0), lg = *(const f32x2_*)(A.in(7) + c0), lb = *(const f32x2_*)(A.in(8) + c0);
    for (int chunk = F.vcu; chunk < M / 128; chunk += F.G) {
        const int m0 = chunk * 128, b = m0 / SEQ, i0 = m0 % SEQ;
        const bf16_t* src = GLU + (size_t)m0 * D + c0; bf16_t* dst = U + (size_t)m0 * D + c0;
        unsigned raw[8];
#pragma unroll
        for (int q = 0; q < 8; ++q) raw[q] = *(const unsigned*)(src + (size_t)q * D);
        f32x2_ win[32];
#pragma unroll
        for (int s = 0; s < 32; ++s) {
            const int pp = NMETA + i0 - 32 + s;
            unsigned rw = 0u;
            if (pp >= NMETA) rw = *(const unsigned*)(GLU + ((size_t)b * SEQ + (pp - NMETA)) * D + c0);
            else if (pp >= 0) rw = *(const unsigned*)(GLUm + (size_t)pp * D + c0);
            win[s] = bfpair(rw);
        }
#pragma unroll 1
        for (int blk = 0; blk < 4; ++blk) {
#pragma unroll
            for (int s8 = 0; s8 < 4; ++s8) {
                unsigned cur[8];
#pragma unroll
                for (int q = 0; q < 8; ++q) cur[q] = raw[q];
                { const int nrow = 32 * blk + 8 * s8 + 8;
                  const bf16_t* ns = src + (size_t)(nrow < 128 ? nrow : 120) * D;
#pragma unroll
                  for (int q = 0; q < 8; ++q) raw[q] = __builtin_nontemporal_load((const unsigned*)(ns + (size_t)q * D)); }
                f32x2_ o[8]; float st[16];
#pragma unroll
                for (int q = 0; q < 8; ++q) { const int s = 8 * s8 + q; win[s] = bfpair(cur[q]);
                    f32x2_ acc = cb;
#pragma unroll
                    for (int j = 0; j < CONVW; ++j) acc = win[(s + 2 + j) & 31] * cw[j] + acc;
                    o[q] = acc; st[2 * q] = acc.x + acc.y; st[2 * q + 1] = acc.x * acc.x + acc.y * acc.y; }
                const float tot = wave_sum16(st, lane);
                LAS float* rp = red + (s8 & 1) * 128;
                if ((lane & 3) == 0) rp[wave * 16 + (lane >> 2)] = tot;
                __syncthreads();
                float tsum = 0.f;
#pragma unroll
                for (int w = 0; w < NWAVES; ++w) tsum += rp[w * 16 + ((lane >> 2) & 15)];
                bf16_t* dg = dst + (size_t)(32 * blk + 8 * s8) * D;
#pragma unroll
                for (int q = 0; q < 8; ++q) {
                    const float s1_ = __builtin_bit_cast(float, __builtin_amdgcn_readlane(__builtin_bit_cast(int, tsum), 8 * q)), s2_ = __builtin_bit_cast(float, __builtin_amdgcn_readlane(__builtin_bit_cast(int, tsum), 8 * q + 4));
                    const float mean = s1_ * (1.f / D), var = s2_ * (1.f / D) - mean * mean, rstd = rsqrtf(fmaxf(var, 0.f) + LN_EPS);
                    f32x2_ y = ((o[q] - mean) * rstd) * lg + lb;
                    y.x = y.x * __builtin_amdgcn_rcpf(1.f + __expf(-y.x)); y.y = y.y * __builtin_amdgcn_rcpf(1.f + __expf(-y.y));
                    *(unsigned*)(dg + (size_t)q * D) = pk2(y.x, y.y);
                }
            }
        }
    }
    __syncthreads();
}
__device__ __forceinline__ void p5_router(Frame& F, const KA& A) {
    const int tid = launder((int)threadIdx.x), lane = tid & 63, wave = __builtin_amdgcn_readfirstlane(tid >> 6), fr = lane & 15, fq = lane >> 4;
    const bf16_t* H = (const bf16_t*)(A.ws() + WS_H); unsigned char* HN = A.ws() + WS_GLU;
    float* TOPG = (float*)(A.ws() + WS_TOPG); float* RSTD = (float*)(A.ws() + WS_RSTD); int* lists = (int*)(A.ws() + WS_LISTS); int* cnt = (int*)(A.ws() + WS_CTL) + CW_CNT;
    const bf16_t* Wh = (const bf16_t*)(A.ws() + WS_WR_T); const bf16_t* Wl = Wh + NE * D;
    const float* g = A.in(12); const float* rb = A.in(14);
    LAS int* lcnt = (LAS int*)(F.lds + RING_OFF);
    LAS int* lbase = lcnt + 32; LAS int* ent = lcnt + 64; LAS int* lslot = ent + 512;
    LAS float* erst = (LAS float*)(lslot + 512); LAS float* egt = erst + 512;
    LAS float* lg = egt + 512 + wave * (16 * 33 + 32); LAS float* lr = lg + 16 * 33; LAS float* lq = lr + 16;
    float* LRS = (float*)(A.ws() + WS_LRS); float* LGT = (float*)(A.ws() + WS_LGT);
    const int c0 = wave * 128 + 8 * fq;
    LAS float* xs = (LAS float*)(F.lds + RING_OFF + 32768);
    LAS float* pacc = (LAS float*)(F.lds + RING_OFF + 36864);
    LAS float* lgall = egt + 512;
    f32x4 gv[4][2]; bf16x8 wh0[4], wh1[4], wl0[4], wl1[4];
#pragma unroll
    for (int s_ = 0; s_ < 4; ++s_) { gv[s_][0] = *(const f32x4*)(g + c0 + 32 * s_); gv[s_][1] = *(const f32x4*)(g + c0 + 32 * s_ + 4);
        const bf16_t* whp = Wh + (size_t)fr * D + c0 + 32 * s_; const bf16_t* wlp = Wl + (size_t)fr * D + c0 + 32 * s_;
        wh0[s_] = *(const bf16x8*)whp; wh1[s_] = *(const bf16x8*)(whp + (size_t)16 * D); wl0[s_] = *(const bf16x8*)wlp; wl1[s_] = *(const bf16x8*)(wlp + (size_t)16 * D); }
    for (int chunk = F.vcu; chunk < M / 128; chunk += F.G) {
        if (tid < 32) lcnt[tid] = 0;
        const bf16_t* hp = H + (size_t)(chunk * 128 + fr) * D + c0; unsigned char* hnp = HN + (size_t)(chunk * 128 + fr) * D + c0;
        u32x4 h0r[4], h1r[4];
#pragma unroll
        for (int s_ = 0; s_ < 4; ++s_) { h0r[s_] = *(const u32x4*)(hp + 32 * s_); h1r[s_] = *(const u32x4*)(hp + (size_t)16 * D + 32 * s_); }
        u32x2 q8p[4];
        for (int gi = 0; gi < 8; ++gi) {
            u32x4 h2r[4];
            if (gi < 6) {
#pragma unroll
                for (int s_ = 0; s_ < 4; ++s_) h2r[s_] = *(const u32x4*)(hp + (size_t)(gi + 2) * 16 * D + 32 * s_); }
            float ss = 0.f, amax = 0.f; f32x4 v[4][2];
#pragma unroll
            for (int s_ = 0; s_ < 4; ++s_) { f32x4 x0, x1; pg8::unpack8(h0r[s_], x0, x1);
                ss += (x0.x * x0.x + x0.y * x0.y) + (x0.z * x0.z + x0.w * x0.w) + (x1.x * x1.x + x1.y * x1.y) + (x1.z * x1.z + x1.w * x1.w);
                v[s_][0] = x0 * gv[s_][0]; v[s_][1] = x1 * gv[s_][1];
                const f32x4 a0 = __builtin_elementwise_abs(v[s_][0]), a1 = __builtin_elementwise_abs(v[s_][1]);
                amax = fmaxf(amax, fmaxf(fmaxf(fmaxf(a0.x, a0.y), fmaxf(a0.z, a0.w)), fmaxf(fmaxf(a1.x, a1.y), fmaxf(a1.z, a1.w)))); }
            ss += __shfl_xor(ss, 16); ss += __shfl_xor(ss, 32);
            amax = fmaxf(amax, __shfl_xor(amax, 16)); amax = fmaxf(amax, __shfl_xor(amax, 32));
            LAS float* xp = xs + (gi & 1) * 256;
            if (fq == 0) { xp[(wave * 16 + fr) * 2] = ss; xp[(wave * 16 + fr) * 2 + 1] = amax; }
            if (gi > 0) {
#pragma unroll
                for (int s_ = 0; s_ < 4; ++s_) *(u32x2*)(hnp + (size_t)(gi - 1) * 16 * D + 32 * s_) = q8p[s_]; }
            __syncthreads();
            float sst = 0.f, amt = 0.f;
#pragma unroll
            for (int w2 = 0; w2 < NWAVES; ++w2) { sst += xp[(w2 * 16 + fr) * 2]; amt = fmaxf(amt, xp[(w2 * 16 + fr) * 2 + 1]); }
            const float qinv = amt > 0.f ? 127.f / amt : 0.f;
            pg8::f32x4 acc0 = {0.f, 0.f, 0.f, 0.f}, acc1 = {0.f, 0.f, 0.f, 0.f};
#pragma unroll
            for (int s_ = 0; s_ < 4; ++s_) { const f32x4 v0 = v[s_][0], v1 = v[s_][1];
                u32x4 hi; hi.x = pk2(v0.x, v0.y); hi.y = pk2(v0.z, v0.w); hi.z = pk2(v1.x, v1.y); hi.w = pk2(v1.z, v1.w);
                { const f32x4 q0 = v0 * qinv, q1 = v1 * qinv; u32x2 q8; q8.x = pk4_i8(q0.x, q0.y, q0.z, q0.w); q8.y = pk4_i8(q1.x, q1.y, q1.z, q1.w); q8p[s_] = q8; }
                u32x4 lo;
                lo.x = pk2(v0.x - __builtin_bit_cast(float, hi.x << 16), v0.y - __builtin_bit_cast(float, hi.x & 0xffff0000u)); lo.y = pk2(v0.z - __builtin_bit_cast(float, hi.y << 16), v0.w - __builtin_bit_cast(float, hi.y & 0xffff0000u));
                lo.z = pk2(v1.x - __builtin_bit_cast(float, hi.z << 16), v1.y - __builtin_bit_cast(float, hi.z & 0xffff0000u)); lo.w = pk2(v1.z - __builtin_bit_cast(float, hi.w << 16), v1.w - __builtin_bit_cast(float, hi.w & 0xffff0000u));
                const bf16x8 ah = __builtin_bit_cast(bf16x8, hi), al = __builtin_bit_cast(bf16x8, lo);
                acc0 = __builtin_amdgcn_mfma_f32_16x16x32_bf16(ah, wh0[s_], acc0, 0, 0, 0); acc1 = __builtin_amdgcn_mfma_f32_16x16x32_bf16(ah, wh1[s_], acc1, 0, 0, 0);
                acc0 = __builtin_amdgcn_mfma_f32_16x16x32_bf16(al, wh0[s_], acc0, 0, 0, 0); acc1 = __builtin_amdgcn_mfma_f32_16x16x32_bf16(al, wh1[s_], acc1, 0, 0, 0);
                acc0 = __builtin_amdgcn_mfma_f32_16x16x32_bf16(ah, wl0[s_], acc0, 0, 0, 0); acc1 = __builtin_amdgcn_mfma_f32_16x16x32_bf16(ah, wl1[s_], acc1, 0, 0, 0); }
#pragma unroll
            for (int r = 0; r < 4; ++r) { pacc[(wave * 8 + r) * 64 + lane] = acc0[r]; pacc[(wave * 8 + 4 + r) * 64 + lane] = acc1[r]; }
            __syncthreads();
            {
                float z = 0.f;
#pragma unroll
                for (int w2 = 0; w2 < NWAVES; ++w2) z += pacc[(w2 * 8 + wave) * 64 + lane];
                LAS float* lgg = lgall + gi * (16 * 33 + 32);
                lgg[(4 * fq + (wave & 3)) * 33 + 16 * (wave >> 2) + fr] = z;
                if (wave == 0 && fq == 0) { const float rstd_ = rsqrtf(sst * (1.f / D) + RMS_EPS); lgg[16 * 33 + fr] = rstd_; lgg[16 * 33 + 16 + fr] = rstd_ * amt * (1.f / 127.f); }
            }
#pragma unroll
            for (int s_ = 0; s_ < 4; ++s_) { h0r[s_] = h1r[s_]; h1r[s_] = h2r[s_]; }
        }
#pragma unroll
        for (int s_ = 0; s_ < 4; ++s_) *(u32x2*)(hnp + (size_t)7 * 16 * D + 32 * s_) = q8p[s_];
        __syncthreads();
        const int m0 = chunk * 128 + wave * 16;
        if (lane < 16) {
            const int m = m0 + lane; const float rstd = lr[lane], rsa = lq[lane];
            float lv[32];
#pragma unroll
            for (int e = 0; e < 32; ++e) lv[e] = lg[lane * 33 + e] * rstd + rb[e];
            int bi[4]; float bv[4];
#pragma unroll
            for (int k = 0; k < 4; ++k) {
                float best = -INFINITY; int idx = 0;
#pragma unroll
                for (int e = 0; e < 32; ++e) if (lv[e] > best) { best = lv[e]; idx = e; }
#pragma unroll
                for (int e = 0; e < 32; ++e) if (e == idx) lv[e] = -INFINITY;
                bi[k] = idx; bv[k] = best;
            }
            const float e1 = __expf(bv[1] - bv[0]), e2 = __expf(bv[2] - bv[0]), e3 = __expf(bv[3] - bv[0]), inv = 1.f / (1.f + e1 + e2 + e3);
            RSTD[m] = rstd;
            *(f32x4*)(TOPG + (size_t)m * 4) = (f32x4){inv, e1 * inv, e2 * inv, e3 * inv};
#pragma unroll
            for (int k = 0; k < 4; ++k) { const int li = (wave * 16 + lane) * 4 + k;
                lslot[li] = __hip_atomic_fetch_add(lcnt + bi[k], 1, __ATOMIC_RELAXED, __HIP_MEMORY_SCOPE_WORKGROUP);
                ent[li] = ((m * 4 + k) << 5) | bi[k]; erst[li] = rsa; egt[li] = (k == 0 ? 1.f : k == 1 ? e1 : k == 2 ? e2 : e3) * inv; }
        }
        __syncthreads();
        if (tid < 32) lbase[tid] = __hip_atomic_fetch_add(cnt + tid, lcnt[tid], __ATOMIC_RELAXED, __HIP_MEMORY_SCOPE_AGENT);
        __syncthreads();
        { const int en = ent[tid], e = en & 31; const size_t sl = (size_t)e * M + lbase[e] + lslot[tid]; lists[sl] = en >> 5; LRS[sl] = erst[tid]; LGT[sl] = egt[tid]; }
        __syncthreads();
    }
}
constexpr int MOE_TAB_OFF = LDSCTL_OFF + 1024, MOE_PARK_OFF = LDSCTL_OFF + 2048, MOE_XM_OFF = LDSCTL_OFF + 10240  , MOE_SPARK_OFF = LDSCTL_OFF + 16384  ;
__device__ __forceinline__ void moe_table(Frame& F, const KA& A) {
    LAS int* tab = (LAS int*)(F.lds + MOE_TAB_OFF);
    if (tid_of(F.wave) == 0) {
        const int* cnt = (const int*)(A.ws() + WS_CTL) + CW_CNT; int tp = 0, bp = 0;
        for (int e = 0; e < NE; ++e) { const int c = cnt[e]; tab[e] = tp; tab[33 + e] = c; tab[65 + e] = bp; tp += (c + 255) >> 8; bp += c; }
        tab[32] = tp;
    }
    __syncthreads();
}
__device__ __forceinline__ void p8_final(Frame& F, const KA& A) {
    const int wave = F.wave, tid = tid_of(wave), lane = tid & 63;
    const bf16_t* H = (const bf16_t*)(A.ws() + WS_H); const bf16_t* Y = (const bf16_t*)(A.ws() + WS_Y); const float* g = A.in(19); float* out = A.out();
    f32x4 gvv[4];
#pragma unroll
    for (int j = 0; j < 4; ++j) gvv[j] = *(const f32x4*)(g + 4 * lane + 256 * j);
    for (int m = F.vcu * NWAVES + wave; m < M; m += F.G * NWAVES) {
        f32x4 v[4]; float ss = 0.f;
#pragma unroll
        for (int j = 0; j < 4; ++j) {
            { const u32x2 hh = __builtin_nontemporal_load((const u32x2*)(H + (size_t)m * D + 4 * lane + 256 * j)); v[j] = (f32x4){__builtin_bit_cast(float, hh.x << 16), __builtin_bit_cast(float, hh.x & 0xffff0000u), __builtin_bit_cast(float, hh.y << 16), __builtin_bit_cast(float, hh.y & 0xffff0000u)}; }
#pragma unroll
            for (int k = 0; k < 4; ++k) { const u32x2 y = __builtin_nontemporal_load((const u32x2*)(Y + ((size_t)m * 4 + k) * D + 4 * lane + 256 * j));
                v[j].x += __builtin_bit_cast(float, y.x << 16); v[j].y += __builtin_bit_cast(float, y.x & 0xffff0000u); v[j].z += __builtin_bit_cast(float, y.y << 16); v[j].w += __builtin_bit_cast(float, y.y & 0xffff0000u); }
            ss += (v[j].x * v[j].x + v[j].y * v[j].y) + (v[j].z * v[j].z + v[j].w * v[j].w);
        }
        ss = wave_sum(ss);
        const float rstd = rsqrtf(ss * (1.f / D) + RMS_EPS);
#pragma unroll
        for (int j = 0; j < 4; ++j) __builtin_nontemporal_store((v[j] * rstd) * gvv[j], (f32x4*)(out + (size_t)m * D + 4 * lane + 256 * j));
    }
}
constexpr int N_MEGA_PHASES = 9;
__global__ void __launch_bounds__(NWAVES * 64, 2) mega_fwd(Args args) {
    extern __shared__ __attribute__((aligned(16))) unsigned char lds[];
    Frame F;
    F.lds = (LAS unsigned char*)lds;
    F.MISC = (volatile LAS unsigned*)(F.lds + MISC_OFF);
    F.tid = threadIdx.x; F.lane = F.tid & 63; F.wave = __builtin_amdgcn_readfirstlane(F.tid >> 6);
    F.G = gridDim.x; { const int bx = blockIdx.x; F.vcu = (F.G % 8 == 0) ? (bx % 8) * (F.G / 8) + bx / 8 : bx; }
    { const KA A0 = kargs(); F.ctl = (gu32*)(A0.ws() + WS_CTL); }
    for (int u = F.tid; u < (LDS_BYTES - LDSCTL_OFF) / 4; u += NWAVES * 64) ((LAS unsigned*)(F.lds + LDSCTL_OFF))[u] = 0u;
    __syncthreads();
    XcdBarrier bar = xcd_barrier_post((unsigned*)(F.ctl + CW_BAR), F.MISC + 8);
    const int lo = args.ph_lo, hi = args.ph_hi;
#define IN(k) (lo <= (k) && (k) < hi)
#define BOTH(k) (IN(k) && IN((k) + 1))

    if (IN(0)) { const KA A = kargs(); p0_prologue(F, A); if (BOTH(0)) xcd_barrier(bar); }

    if (IN(1)) { const KA A = kargs(); unsigned char* const ws = A.ws();
        p1_scan(F, A);
        if (F.wave == 0) p1_meta(F, A);
        pg8::Gemm g{(const bf16_t*)(ws + WS_XN), (const bf16_t*)(ws + WS_WIN_T), M, 7168, D / 2}; pg8::StaticOrder S; S.init(M, 7168, F.G, (int)blockIdx.x);
        pg8::EpiInProj E{A.in(4), (const float*)(ws + WS_RSX), (const float*)(ws + WS_SBIN), (bf16_t*)(ws + WS_GLU), (bf16_t*)(ws + WS_Q), WS_QSTRIDE / 2, C2, SEQ, (float*)(ws + WS_QN2), (float*)(ws + WS_KN2)};
        pg8::gemm_phase<pg8::EpiInProj, pg8::StaticOrder, true, true, true>(F.lds + RING_OFF, g, S, E);
        if (BOTH(1)) xcd_barrier(bar);
    }

    if (IN(2)) { const KA A = kargs(); unsigned char* const ws = A.ws();
        static_assert(attn_body::ATTN_LDS_BYTES <= RING_BYTES, "attention LDS");
        const attn_body::AttnTensors AT{(const attn_body::bf16*)(ws + WS_Q), (const attn_body::bf16*)(ws + WS_K), (const attn_body::bf16*)(ws + WS_V), (attn_body::bf16*)(ws + WS_Q), (const float*)(ws + WS_KN2), (const float*)(ws + WS_QN2), (const float*)(ws + WS_KNM)};
        const attn_body::StaticOrder S((int)F.G, (int)blockIdx.x);
        attn_body::attn_phase<attn_body::StaticOrder>((char*)lds + RING_OFF, AT, (const float*)(ws + WS_BIAS), S);
        p2_conv(F, A);
        if (BOTH(2)) xcd_barrier(bar);
    }

    if (IN(3)) { const KA A = kargs(); unsigned char* const ws = A.ws();
        pg8::PairOrder S; S.init(M, D, F.G, (int)blockIdx.x);
        pg8::Gemm g{(const bf16_t*)(ws + WS_U), (const bf16_t*)(ws + WS_WCO_T), M, D, D, (const bf16_t*)(ws + WS_Q), (const bf16_t*)(ws + WS_WAO_T)};
        pg8::EpiMerge E{(const bf16_t*)(ws + WS_SGA), (const bf16_t*)(ws + WS_SGB), (bf16_t*)(ws + WS_XN)};
        pg8::gemm_phase<pg8::EpiMerge, pg8::PairOrder, true, true, false, true>(F.lds + RING_OFF, g, S, E);
        if (BOTH(3)) xcd_barrier(bar);
    }

    if (IN(4)) { const KA A = kargs(); unsigned char* const ws = A.ws();
        pg8::Gemm g{(const bf16_t*)(ws + WS_XN), (const bf16_t*)(ws + WS_WMIX_T), M, D, D}; pg8::StaticOrder S; S.init(M, D, F.G, (int)blockIdx.x);
        pg8::EpiResid E{A.in(0), (bf16_t*)(ws + WS_H)};
        pg8::gemm_phase<pg8::EpiResid, pg8::StaticOrder, true, true>(F.lds + RING_OFF, g, S, E);
        if (BOTH(4)) xcd_barrier(bar);
    }

    if (IN(5)) { const KA A = kargs(); p5_router(F, A); if (BOTH(5)) xcd_barrier(bar); }

    if (IN(6)) { const KA A = kargs(); unsigned char* const ws = A.ws();
        moe_table(F, A);
        pg8::MoeOrder S; S.init((const LAS int*)(F.lds + MOE_TAB_OFF), 8, F.G, (int)blockIdx.x);
        pg8::RowsGather RW{(const int*)(ws + WS_LISTS)};
        pg8::EpiMoeGU E{A.in(16), (const float*)(ws + WS_LRS), (const float*)(ws + WS_SBGU), ws + WS_ACT, (float*)(ws + WS_SACT), (LAS float*)(F.lds + MOE_XM_OFF)};
        pg8::gemm_phase_g<pg8::EpiMoeGU, pg8::MoeOrder, pg8::RowsGather, 512, true>(F.wave, F.lds + RING_OFF, F.lds + MOE_PARK_OFF, nullptr, nullptr, (const bf16_t*)(ws + WS_GLU), (const bf16_t*)(ws + WS_WGU_T), (size_t)2048 * 1024, S, RW, E);
        if (BOTH(6)) xcd_barrier(bar);
    }

    if (IN(7)) { const KA A = kargs(); unsigned char* const ws = A.ws();
        moe_table(F, A);
        pg8::MoeOrder S; S.init((const LAS int*)(F.lds + MOE_TAB_OFF), 4, F.G, (F.G % 8 == 0) ? (int)(blockIdx.x % 8) * (int)(F.G / 8) + (int)(blockIdx.x / 8) : (int)blockIdx.x);
        pg8::RowsDense RW{};
        pg8::EpiMoeDown E{A.in(18), (const float*)(ws + WS_SBDN), (const int*)(ws + WS_LISTS), (const float*)(ws + WS_LGT), (bf16_t*)(ws + WS_Y)};
        static_assert(MOE_SPARK_OFF - 2048 >= MOE_XM_OFF, "the down GEMM's row offsets sit in the gate-up exchange area (idle in this phase)");
        pg8::gemm_phase_g<pg8::EpiMoeDown, pg8::MoeOrder, pg8::RowsDense, 512, true, true, true>(F.wave, F.lds + RING_OFF, F.lds + MOE_PARK_OFF, F.lds + MOE_SPARK_OFF, (const float*)(ws + WS_SACT), (const bf16_t*)(ws + WS_ACT), (const bf16_t*)(ws + WS_WDN_T), (size_t)D * 1024, S, RW, E);
        if (BOTH(7)) xcd_barrier(bar);
    }

    if (IN(8)) { const KA A = kargs(); p8_final(F, A); }
#undef IN
#undef BOTH
}
extern "C" void kernel_launch(void* const* d_in, const int* in_sizes, int n_in, void* d_out, int out_size, void* d_ws, size_t ws_size, hipStream_t stream) {
    static int grid = 0;
    if (grid == 0) {
        if (n_in != 20 || in_sizes[0] != M * D || out_size != M * D || ws_size < WS_END) { fprintf(stderr, "kernel_launch: unexpected shapes (n_in %d in0 %d out %d ws %zu)\n", n_in, n_in > 0 ? in_sizes[0] : -1, out_size, ws_size); grid = -1; return; }
        int dev = 0, cus = 0, per_cu = 0;
        if (hipGetDevice(&dev) != hipSuccess || hipDeviceGetAttribute(&cus, hipDeviceAttributeMultiprocessorCount, dev) != hipSuccess) { grid = -1; return; }
        if (hipFuncSetAttribute((const void*)mega_fwd, hipFuncAttributeMaxDynamicSharedMemorySize, LDS_BYTES) != hipSuccess) { fprintf(stderr, "kernel_launch: hipFuncSetAttribute failed\n"); grid = -1; return; }
        if (hipOccupancyMaxActiveBlocksPerMultiprocessor(&per_cu, (const void*)mega_fwd, NWAVES * 64, LDS_BYTES) != hipSuccess || per_cu < 1) { fprintf(stderr, "kernel_launch: occupancy query says %d blocks per CU\n", per_cu); (void)hipGetLastError(); grid = -1; return; }
        grid = cus;
    }
    if (grid < 0) return;
    unsigned char* ws = (unsigned char*)d_ws; float* out = (float*)d_out;

    (void)hipMemsetAsync(ws + WS_CTL, 0, CTL_ZERO_BYTES, stream);
    Args a{};
    for (int i = 0; i < 20; ++i) a.in[i] = (const float*)d_in[i];
    a.out = out; a.ws = ws; a.ph_lo = 0; a.ph_hi = N_MEGA_PHASES;
    hipLaunchKernelGGL(mega_fwd, dim3(grid), dim3(NWAVES * 64), LDS_BYTES, stream, a);
    { const hipError_t le = hipPeekAtLastError(); if (le != hipSuccess) fprintf(stderr, "kernel_launch: launch failed: %s\n", hipGetErrorName(le)); }
}
```
